# Optimizing an MI355X kernel written in HIP

```python
import functools
import math
import jax
import jax.numpy as jnp
from jax import lax
import numpy as np


D_MODEL = 1024
BATCH = 1
SEQ = 16384
DEPTH = 1
DEC_BATCH = 128
DEC_SEQ = 8
PAST_LEN = 8192
PAGE_SIZE = 128

D_MIX = D_MODEL
D_ATT = D_MIX // 2
D_SSM = D_MIX - D_ATT
HEAD_DIM = 64
N_HEADS = D_ATT // HEAD_DIM
ROT_DIM = HEAD_DIM // 4
ROPE_THETA = 500000.0
DILATED_GROUPS = ((128, 1), (512, 4), (2048, 16))
WIN_MAX = 2048
Q_BLOCK = 128
SSM_GROUP = 16
N_SSM_GROUPS = D_SSM // SSM_GROUP
SSM_STATE = 64
D_FF = 2816
N_ADA = 9
EPS = 1e-6
DT_MIN = 1e-3
DT_MAX = 1e-1

kernel_name = "hymba_dilated_s5_macaron_step"


def rmsnorm(x, g):
    xf = x.astype(jnp.float32)
    y = xf * lax.rsqrt(jnp.mean(xf * xf, axis=-1, keepdims=True) + EPS)
    return (y * g.astype(jnp.float32)).astype(x.dtype)


def ada_terms(c, w_ada, b_ada):
    h = jax.nn.silu(c) @ w_ada + b_ada
    return jnp.split(h[:, None, :], N_ADA, axis=-1)


def modulate(x, shift, scale):
    return x * (1.0 + scale) + shift


def swiglu(x, w_gate, w_up, w_down):
    return (jax.nn.silu(x @ w_gate) * (x @ w_up)) @ w_down


def rope_partial(x, pos):
    half = ROT_DIM // 2
    inv = ROPE_THETA ** (-jnp.arange(half, dtype=jnp.float32) / half)
    ang = pos.astype(jnp.float32)[:, None] * inv[None, :]
    cos = jnp.cos(ang)[None, :, None, :]
    sin = jnp.sin(ang)[None, :, None, :]
    xr = x[..., :ROT_DIM].astype(jnp.float32)
    x1, x2 = xr[..., :half], xr[..., half:]
    rot = jnp.concatenate([x1 * cos - x2 * sin, x2 * cos + x1 * sin], axis=-1)
    return jnp.concatenate([rot.astype(x.dtype), x[..., ROT_DIM:]], axis=-1)


def dilated_attention(q, k_ext, v_ext, q_idx):
    qf = q.astype(jnp.float32) * (HEAD_DIM ** -0.5)
    outs, lses = [], []
    for window, dil in DILATED_GROUPS:
        offs = jnp.arange(window // dil + 1) * dil
        idx = q_idx[:, None] - offs[None, :]
        valid = idx >= 0
        idx = jnp.maximum(idx, 0)
        kg = k_ext[:, idx].astype(jnp.float32)
        vg = v_ext[:, idx].astype(jnp.float32)
        s = jnp.einsum("bqhd,bqjhd->bqhj", qf, kg)
        s = jnp.where(valid[None, :, None, :], s, -jnp.inf)
        lse = jax.nn.logsumexp(s, axis=-1)
        p = jnp.exp(s - lse[..., None])
        outs.append(jnp.einsum("bqhj,bqjhd->bqhd", p, vg))
        lses.append(lse)
    w = jax.nn.softmax(jnp.stack(lses, axis=0), axis=0)
    o = jnp.sum(w[..., None] * jnp.stack(outs, axis=0), axis=0)
    return o.astype(q.dtype)


def prompt_attend(q, k, v):
    b, s, h, hd = q.shape
    nb = s // Q_BLOCK
    qb = q.reshape(b, nb, Q_BLOCK, h, hd).transpose(1, 0, 2, 3, 4)
    starts = jnp.arange(nb) * Q_BLOCK

    def blk(args):
        qi, st = args
        return dilated_attention(qi, k, v, st + jnp.arange(Q_BLOCK))

    o = lax.map(blk, (qb, starts)).transpose(1, 0, 2, 3, 4).reshape(b, s, h, hd)
    keep = min(WIN_MAX, s)
    return o, k[:, s - keep:], v[:, s - keep:]


def buffered_attend(q, k, v, k_buf, v_buf):
    w_buf = k_buf.shape[1]
    k_ext = jnp.concatenate([k_buf.astype(k.dtype), k], axis=1)
    v_ext = jnp.concatenate([v_buf.astype(v.dtype), v], axis=1)
    o = dilated_attention(q, k_ext, v_ext, w_buf + jnp.arange(q.shape[1]))
    return o, k_ext[:, -w_buf:], v_ext[:, -w_buf:]


def s5_mixer(u, h0_re, h0_im, a_re, a_im, log_dt, b_re, b_im, c_re, c_im, d_skip):
    b, s, _ = u.shape
    uf = u.astype(jnp.float32).reshape(b, s, N_SSM_GROUPS, SSM_GROUP)
    lam = lax.complex(a_re.astype(jnp.float32), a_im.astype(jnp.float32))
    dt = jnp.exp(log_dt.astype(jnp.float32))[:, None]
    lam_bar = jnp.exp(lam * dt)
    bmat = lax.complex(b_re.astype(jnp.float32), b_im.astype(jnp.float32))
    b_bar = ((lam_bar - 1.0) / lam)[..., None] * bmat
    cmat = lax.complex(c_re.astype(jnp.float32), c_im.astype(jnp.float32))
    bu = jnp.einsum("gpc,bsgc->bsgp", b_bar, uf.astype(jnp.complex64))
    h0 = lax.complex(h0_re.astype(jnp.float32), h0_im.astype(jnp.float32))
    bu = bu.at[:, 0].add(lam_bar[None] * h0)
    a = jnp.broadcast_to(lam_bar, bu.shape)

    def combine(left, right):
        return (left[0] * right[0], right[0] * left[1] + right[1])

    _, h = lax.associative_scan(combine, (a, bu), axis=1)
    y = jnp.einsum("gcp,bsgp->bsgc", cmat, h).real \
        + d_skip.astype(jnp.float32).reshape(N_SSM_GROUPS, SSM_GROUP) * uf
    h_last = h[:, -1]
    return y.reshape(b, s, D_SSM).astype(u.dtype), jnp.real(h_last), jnp.imag(h_last)


def decoder_layer(x, c, pos, attend, h0_re, h0_im, p):
    (w_ada, b_ada, g_ffn1, w1_gate, w1_up, w1_down, g_mix, w_in, g_q, g_k,
     a_re, a_im, log_dt, b_re, b_im, c_re, c_im, d_skip, w_glu, w_out,
     g_ffn2, w2_gate, w2_up, w2_down) = p
    sh1, sc1, gt1, sh2, sc2, gt2, sh3, sc3, gt3 = ada_terms(c, w_ada, b_ada)
    b, s, _ = x.shape
    x = x + 0.5 * gt1 * swiglu(modulate(rmsnorm(x, g_ffn1), sh1, sc1), w1_gate, w1_up, w1_down)
    h = modulate(rmsnorm(x, g_mix), sh2, sc2)
    proj = h @ w_in
    q, k, v, u = jnp.split(proj, [D_ATT, 2 * D_ATT, 3 * D_ATT], axis=-1)
    q = rope_partial(rmsnorm(q.reshape(b, s, N_HEADS, HEAD_DIM), g_q), pos)
    k = rope_partial(rmsnorm(k.reshape(b, s, N_HEADS, HEAD_DIM), g_k), pos)
    v = v.reshape(b, s, N_HEADS, HEAD_DIM)
    o_att, k_state, v_state = attend(q, k, v)
    y_ssm, h_re, h_im = s5_mixer(u, h0_re, h0_im, a_re, a_im, log_dt, b_re, b_im, c_re, c_im, d_skip)
    g = jax.nn.gelu(y_ssm)
    ga, gb = jnp.split(g @ w_glu, 2, axis=-1)
    o_ssm = ga * jax.nn.sigmoid(gb)
    mix = jnp.concatenate([o_att.reshape(b, s, D_ATT), o_ssm], axis=-1) @ w_out
    x = x + gt2 * mix
    x = x + 0.5 * gt3 * swiglu(modulate(rmsnorm(x, g_ffn2), sh3, sc3), w2_gate, w2_up, w2_down)
    return x, k_state, v_state, h_re, h_im


def setup_inputs(seed: int = 0) -> dict:
    key = jax.random.key(seed)
    ks = jax.random.split(key, 40)
    f32 = jnp.float32
    nrm = lambda k, shape, sc: jax.random.normal(k, shape, f32) * sc
    w_buf = min(WIN_MAX, PAST_LEN)
    L = DEPTH
    n_idx = jnp.arange(SSM_STATE, dtype=f32)
    a_im = jnp.broadcast_to(math.pi * n_idx, (L, N_SSM_GROUPS, SSM_STATE)) \
        + nrm(ks[20], (L, N_SSM_GROUPS, SSM_STATE), 0.01)
    return {
        "x_prompt": nrm(ks[0], (BATCH, SEQ, D_MODEL), 1.0),
        "x_sample": nrm(ks[1], (DEC_BATCH, DEC_SEQ, D_MODEL), 1.0),
        "c_prompt": nrm(ks[2], (BATCH, D_MODEL), 1.0),
        "c_sample": nrm(ks[3], (DEC_BATCH, D_MODEL), 1.0),
        "cache_k_win": nrm(ks[4], (L, DEC_BATCH, w_buf, N_HEADS, HEAD_DIM), 1.0),
        "cache_v_win": nrm(ks[5], (L, DEC_BATCH, w_buf, N_HEADS, HEAD_DIM), 1.0),
        "state_ssm_re": nrm(ks[6], (L, DEC_BATCH, N_SSM_GROUPS, SSM_STATE), 0.1),
        "state_ssm_im": nrm(ks[7], (L, DEC_BATCH, N_SSM_GROUPS, SSM_STATE), 0.1),
        "w_ada": nrm(ks[8], (L, D_MODEL, N_ADA * D_MODEL), 0.5 * D_MODEL ** -0.5),
        "b_ada": nrm(ks[9], (L, N_ADA * D_MODEL), 0.02),
        "g_ffn1": 1.0 + nrm(ks[10], (L, D_MODEL), 0.02),
        "w1_gate": nrm(ks[11], (L, D_MODEL, D_FF), D_MODEL ** -0.5),
        "w1_up": nrm(ks[12], (L, D_MODEL, D_FF), D_MODEL ** -0.5),
        "w1_down": nrm(ks[13], (L, D_FF, D_MODEL), D_FF ** -0.5),
        "g_mix": 1.0 + nrm(ks[14], (L, D_MODEL), 0.02),
        "w_in": nrm(ks[15], (L, D_MODEL, 3 * D_ATT + D_SSM), D_MODEL ** -0.5),
        "g_q": 1.0 + nrm(ks[16], (L, HEAD_DIM), 0.02),
        "g_k": 1.0 + nrm(ks[17], (L, HEAD_DIM), 0.02),
        "ssm_a_re": -0.5 + nrm(ks[18], (L, N_SSM_GROUPS, SSM_STATE), 0.01),
        "ssm_a_im": a_im,
        "ssm_log_dt": jax.random.uniform(ks[19], (L, N_SSM_GROUPS), f32,
                                         math.log(DT_MIN), math.log(DT_MAX)),
        "ssm_b_re": nrm(ks[21], (L, N_SSM_GROUPS, SSM_STATE, SSM_GROUP), (2.0 * SSM_GROUP) ** -0.5),
        "ssm_b_im": nrm(ks[22], (L, N_SSM_GROUPS, SSM_STATE, SSM_GROUP), (2.0 * SSM_GROUP) ** -0.5),
        "ssm_c_re": nrm(ks[23], (L, N_SSM_GROUPS, SSM_GROUP, SSM_STATE), (2.0 * SSM_STATE) ** -0.5),
        "ssm_c_im": nrm(ks[24], (L, N_SSM_GROUPS, SSM_GROUP, SSM_STATE), (2.0 * SSM_STATE) ** -0.5),
        "ssm_d": nrm(ks[25], (L, D_SSM), 1.0),
        "w_glu": nrm(ks[26], (L, D_SSM, 2 * D_SSM), D_SSM ** -0.5),
        "w_out": nrm(ks[27], (L, D_MIX, D_MODEL), D_MIX ** -0.5),
        "g_ffn2": 1.0 + nrm(ks[28], (L, D_MODEL), 0.02),
        "w2_gate": nrm(ks[29], (L, D_MODEL, D_FF), D_MODEL ** -0.5),
        "w2_up": nrm(ks[30], (L, D_MODEL, D_FF), D_MODEL ** -0.5),
        "w2_down": nrm(ks[31], (L, D_FF, D_MODEL), D_FF ** -0.5),
    }


def reference(x_prompt, x_sample, c_prompt, c_sample, cache_k_win, cache_v_win,
              state_ssm_re, state_ssm_im, w_ada, b_ada, g_ffn1, w1_gate, w1_up, w1_down,
              g_mix, w_in, g_q, g_k, ssm_a_re, ssm_a_im, ssm_log_dt, ssm_b_re, ssm_b_im,
              ssm_c_re, ssm_c_im, ssm_d, w_glu, w_out, g_ffn2, w2_gate, w2_up, w2_down):
    pos_p = jnp.arange(x_prompt.shape[1])
    pos_s = PAST_LEN + jnp.arange(x_sample.shape[1])
    h0_p = jnp.zeros((x_prompt.shape[0], N_SSM_GROUPS, SSM_STATE), jnp.float32)
    y_p, y_s = x_prompt, x_sample
    kp_l, vp_l, hrp_l, hip_l, ks_l, vs_l, hrs_l, his_l = [], [], [], [], [], [], [], []
    for l in range(DEPTH):
        p = (w_ada[l], b_ada[l], g_ffn1[l], w1_gate[l], w1_up[l], w1_down[l], g_mix[l], w_in[l],
             g_q[l], g_k[l], ssm_a_re[l], ssm_a_im[l], ssm_log_dt[l], ssm_b_re[l], ssm_b_im[l],
             ssm_c_re[l], ssm_c_im[l], ssm_d[l], w_glu[l], w_out[l], g_ffn2[l], w2_gate[l],
             w2_up[l], w2_down[l])
        y_p, kp, vp, hrp, hip = decoder_layer(y_p, c_prompt, pos_p, prompt_attend, h0_p, h0_p, p)
        sample_attend = functools.partial(buffered_attend, k_buf=cache_k_win[l], v_buf=cache_v_win[l])
        y_s, ksm, vsm, hrs, his = decoder_layer(y_s, c_sample, pos_s, sample_attend,
                                                state_ssm_re[l], state_ssm_im[l], p)
        kp_l.append(kp); vp_l.append(vp); hrp_l.append(hrp); hip_l.append(hip)
        ks_l.append(ksm); vs_l.append(vsm); hrs_l.append(hrs); his_l.append(his)
    return (y_p, y_s,
            jnp.stack(kp_l, 0), jnp.stack(vp_l, 0), jnp.stack(hrp_l, 0), jnp.stack(hip_l, 0),
            jnp.stack(ks_l, 0), jnp.stack(vs_l, 0), jnp.stack(hrs_l, 0), jnp.stack(his_l, 0))
```

```cpp
#include <hip/hip_runtime.h>
#include <cstdio>
#include <cstdint>
namespace pg8 {
#define PG8_LAS __attribute__((address_space(3)))
typedef unsigned short bf16_t;
typedef short bf16x8 __attribute__((ext_vector_type(8)));
typedef float f32x4 __attribute__((ext_vector_type(4)));
typedef unsigned u32x4 __attribute__((ext_vector_type(4)));
constexpr int BM = 256, BK = 64, HALF = 128, HTB = HALF * BK * 2  , STAGE_BYTES = 8 * HTB, NXCD = 8, WGM = 8;

__host__ __device__ __forceinline__ int lds_byte(int r, int c) { const int st = (r >> 4) * 2 + (c >> 5), rr = r & 15, cc = c & 31, ob = rr * 64 + cc * 2; return st * 1024 + (ob ^ (((ob >> 9) & 1) << 5)); }
__host__ __device__ __forceinline__ void stage_rc(int b, int& R, int& C) { const int st = b / 1024, sb = b % 1024, swz = sb ^ (((sb >> 9) & 1) << 5); R = (st >> 1) * 16 + swz / 64; C = (st & 1) * 32 + (swz % 64) / 2; }
__host__ __device__ __forceinline__ int perm32(int rho) { const int n = rho >> 4, i = rho & 15; return 8 * (i >> 2) + 4 * n + (i & 3); }

__host__ __device__ __forceinline__ size_t blk_off(int row, int col, int K) { return ((size_t)(row >> 8) * (size_t)(K >> 6) + (size_t)(col >> 6)) * 16384 + (size_t)((row & 255) * 64 + (col & 63)); }
__host__ __device__ __forceinline__ size_t blk_byte(int row, int bcol, int Kbytes) { return ((size_t)(row >> 8) * (size_t)(Kbytes >> 7) + (size_t)(bcol >> 7)) * 32768 + (size_t)((row & 255) * 128 + (bcol & 127)); }
struct Unit { int pm, pn; };
struct Gemm { const bf16_t* A; const bf16_t* Bt; int M, N, K; };

struct StaticOrder {
    int nM, nN, nwg, G, c;
    __host__ __device__ void init(int M, int N, int G_, int c_) { nM = M / BM; nN = N / BM; nwg = nM * nN; G = G_; c = c_; }
    __host__ __device__ bool next(int i, Unit& u) const {
        const long L = (long)i * G + c; if (L >= nwg) return false;
        int wgid = (int)L; { const int q = nwg / NXCD, r = nwg % NXCD, xcd = wgid % NXCD, off = wgid / NXCD; wgid = (xcd < r ? xcd * (q + 1) : r * (q + 1) + (xcd - r) * q) + off; }
        const int nig = WGM * nN, gid = wgid / nig, fm = gid * WGM, gsz = (nM - fm) < WGM ? (nM - fm) : WGM;
        u.pm = fm + ((wgid % nig) % gsz); u.pn = (wgid % nig) / gsz; return true;
    }
    __device__ __forceinline__ void a_ready(const Unit&) const {}
    __device__ __forceinline__ void done(const Unit&) const {}
};

__device__ __forceinline__ unsigned cvt_pk_bf16(float lo, float hi) { unsigned r; asm volatile("v_cvt_pk_bf16_f32 %0, %1, %2" : "=v"(r) : "v"(lo), "v"(hi)); return r; }
typedef float f32x2 __attribute__((ext_vector_type(2)));
typedef unsigned u32x2v __attribute__((ext_vector_type(2)));
constexpr int CP_STAGE_OFF = STAGE_BYTES;
constexpr int CP_STRIDE = 8192;
struct CopyJob { const char* src; char* dst; int cur, end; unsigned* dummy; };
struct Unit2 { int pm, pn, k0, nt, split; };
typedef int i32x4 __attribute__((ext_vector_type(4)));
template <bool I8> struct AccSel { typedef f32x4 type; };
template <> struct AccSel<true> { typedef i32x4 type; };
template <class Epi, class Sched, bool ALIGN_EPI, bool COPY, bool I8 = false>
__device__ __forceinline__ void gemm_phase2(PG8_LAS unsigned char* lds, const Gemm g, const Sched& S, const Epi& E, CopyJob& C, const int wid  ) {
    const int lane = (int)__builtin_amdgcn_mbcnt_hi(~0u, __builtin_amdgcn_mbcnt_lo(~0u, 0u)), tid = wid * 64 + lane,
              wr = wid >> 2, wc = wid & 3, fr = lane & 15, fq = lane >> 4;
    const int K = g.K;
    unsigned voffA[2], voffB[2];
#pragma unroll
    for (int i = 0; i < 2; ++i) { int R, Cc; stage_rc(tid * 16 + i * 8192, R, Cc); const int Rb = Epi::PERM ? ((R & ~31) + perm32(R & 31)) : R;
        voffA[i] = (unsigned)(R * 64 + Cc) * 2u; voffB[i] = (unsigned)(Rb * 64 + Cc) * 2u; }
    const size_t kstep = (size_t)32768;
    const size_t hstep = (size_t)HALF * 64 * 2;
    const size_t tstep = (size_t)(K / BK) * kstep;
    const unsigned ldsw = (unsigned)wid * 1024u;
    const int aoff = lds_byte(wr * 64 + fr, fq * 8), boff = lds_byte(wc * 32 + fr, fq * 8);
#define PG8_SA(b, h) (((b) * 2 + (h)) * HTB)
#define PG8_SB(b, h) ((4 + (b) * 2 + (h)) * HTB)
#define PG8_STAGE(bufoff, gbase, voff) do { _Pragma("unroll") for (int _i = 0; _i < 2; ++_i) \
        __builtin_amdgcn_global_load_lds((const unsigned*)((const char*)(gbase) + (voff)[_i]), (PG8_LAS unsigned*)(lds + (bufoff) + ldsw + _i * 8192), 16, 0, 0); } while (0)
#define PG8_LDA(dst, b, h) do { _Pragma("unroll") for (int m = 0; m < 4; ++m) _Pragma("unroll") for (int k = 0; k < 2; ++k) dst[m][k] = *(const PG8_LAS bf16x8*)(lds + PG8_SA(b, h) + aoff + m * 2048 + k * 1024); } while (0)
#define PG8_LDB(dst, b, h) do { _Pragma("unroll") for (int n = 0; n < 2; ++n) _Pragma("unroll") for (int k = 0; k < 2; ++k) dst[n][k] = *(const PG8_LAS bf16x8*)(lds + PG8_SB(b, h) + boff + n * 2048 + k * 1024); } while (0)
#define PG8_MMA(ai, bj, At, Bt) do { __builtin_amdgcn_s_setprio(1); _Pragma("unroll") for (int m = 0; m < 4; ++m) _Pragma("unroll") for (int n = 0; n < 2; ++n) _Pragma("unroll") for (int k = 0; k < 2; ++k) \
        { if constexpr (I8) acc[ai][bj][m][n] = __builtin_amdgcn_mfma_i32_16x16x64_i8(__builtin_bit_cast(i32x4, Bt[n][k]), __builtin_bit_cast(i32x4, At[m][k]), acc[ai][bj][m][n], 0, 0, 0); \
          else acc[ai][bj][m][n] = __builtin_amdgcn_mfma_f32_16x16x32_bf16(Bt[n][k], At[m][k], acc[ai][bj][m][n], 0, 0, 0); } __builtin_amdgcn_s_setprio(0); } while (0)
#define PG8_WAIT_V(n) asm volatile("s_waitcnt vmcnt(" #n ")" ::: "memory")
#define PG8_WAIT_LOOP() do { if constexpr (COPY) asm volatile("s_waitcnt vmcnt(13)" ::: "memory"); else asm volatile("s_waitcnt vmcnt(8)" ::: "memory"); } while (0)
#define PG8_WAIT_L(n) asm volatile("s_waitcnt lgkmcnt(" #n ")" ::: "memory")
#define PG8_BAR __builtin_amdgcn_s_barrier()
#define PG8_SCHED __builtin_amdgcn_sched_barrier(0)
    typedef unsigned cp4 __attribute__((ext_vector_type(4)));
    const unsigned cp_voff = (unsigned)lane * 16u;
    int cp_n = 0, cp_sl = 0;
    const int cp_base = C.cur, cp_cnt = C.end - C.cur;
    const char* cp_s = C.src + (size_t)cp_base * CP_STRIDE; char* cp_d = C.dst + ((size_t)cp_base - 4) * CP_STRIDE;
    PG8_LAS unsigned char* const cp_stage = lds + CP_STAGE_OFF + wid * 3072;
    cp4 cp_r = {0u, 0u, 0u, 0u};
#define CP_STORE() do { if constexpr (COPY) { \
        if (cp_n >= 4 && cp_n - 4 < cp_cnt) __builtin_nontemporal_store(cp_r, (cp4*)(cp_d + cp_voff)); else C.dummy[lane] = cp_r.x; } } while (0)
#define CP_READ() do { if constexpr (COPY) { const unsigned la_ = (unsigned)(unsigned long)(cp_stage + cp_sl * 1024) + cp_voff; \
        asm volatile("ds_read_b128 %0, %1" : "=v"(cp_r) : "v"(la_) : "memory"); } } while (0)
#define CP_ISSUE() do { if constexpr (COPY) { asm volatile("s_waitcnt lgkmcnt(0)" ::: "memory"); \
        const char* sp_ = (cp_n < cp_cnt) ? cp_s : (const char*)C.src; \
        __builtin_amdgcn_global_load_lds((const unsigned*)(sp_ + cp_voff), (PG8_LAS unsigned*)(cp_stage + cp_sl * 1024), 16, 0, 2); \
        ++cp_n; cp_sl = (cp_sl == 2) ? 0 : cp_sl + 1; cp_s += CP_STRIDE; cp_d += CP_STRIDE; } } while (0)
    Unit2 cur, nxt; int ui = 0;
    if (!S.next(0, cur)) return;
    typedef typename AccSel<I8>::type acc_t; const acc_t acc_zero = {};
    acc_t acc[2][2][4][2];
#pragma unroll
    for (int a = 0; a < 2; ++a)
#pragma unroll
        for (int b = 0; b < 2; ++b)
#pragma unroll
            for (int m = 0; m < 4; ++m)
#pragma unroll
                for (int n = 0; n < 2; ++n) acc[a][b][m][n] = acc_zero;
    bf16x8 At[4][2], B0[2][2], B1[2][2];
    const char* cA = (const char*)g.A + (size_t)cur.pm * tstep + (size_t)cur.k0 * kstep; const char* cB = (const char*)g.Bt + (size_t)cur.pn * tstep + (size_t)cur.k0 * kstep;
    S.a_ready(cur);
    {
        PG8_STAGE(PG8_SB(0, 0), cB, voffB); PG8_STAGE(PG8_SB(0, 1), cB + hstep, voffB); PG8_STAGE(PG8_SA(0, 0), cA, voffA); PG8_STAGE(PG8_SA(0, 1), cA + hstep, voffA);
        if (wr == 1) PG8_BAR;
        PG8_WAIT_V(2); PG8_BAR;
        PG8_STAGE(PG8_SB(1, 0), cB + kstep, voffB); PG8_STAGE(PG8_SA(1, 0), cA + kstep, voffA); PG8_STAGE(PG8_SB(1, 1), cB + hstep + kstep, voffB);
        PG8_WAIT_V(6); PG8_BAR;
    }
    for (;;) {
        const bool has_next = S.next(ui + 1, nxt);
        const char* nA = has_next ? (const char*)g.A + (size_t)nxt.pm * tstep + (size_t)nxt.k0 * kstep : cA; const char* nB = has_next ? (const char*)g.Bt + (size_t)nxt.pn * tstep + (size_t)nxt.k0 * kstep : cB;
        const int nt = cur.nt;
        for (int t = 0; t < nt; t += 2) {
            const bool last = (t == nt - 2);
            const char* a1 = cA + (size_t)(t + 1) * kstep;
            const char* a2 = last ? nA : cA + (size_t)(t + 2) * kstep; const char* b2 = last ? nB : cB + (size_t)(t + 2) * kstep;
            const char* a3 = a2 + kstep; const char* b3 = b2 + kstep;
            if (last && has_next) S.a_ready(nxt);
            PG8_LDB(B0, 0, 0); PG8_LDB(B1, 0, 1); PG8_SCHED; PG8_LDA(At, 0, 0); PG8_STAGE(PG8_SA(1, 1), a1 + hstep, voffA);
            CP_STORE(); PG8_WAIT_LOOP(); PG8_WAIT_L(0); PG8_BAR; PG8_MMA(0, 0, At, B0); CP_READ(); PG8_MMA(0, 1, At, B1); CP_ISSUE(); PG8_BAR; PG8_SCHED;
            PG8_LDA(At, 0, 1); PG8_STAGE(PG8_SB(0, 0), b2, voffB); PG8_STAGE(PG8_SB(0, 1), b2 + hstep, voffB); PG8_STAGE(PG8_SA(0, 0), a2, voffA);
            CP_STORE(); PG8_WAIT_LOOP(); PG8_WAIT_L(0); PG8_BAR; PG8_MMA(1, 0, At, B0); CP_READ(); PG8_MMA(1, 1, At, B1); CP_ISSUE(); PG8_BAR; PG8_SCHED;
            PG8_LDB(B0, 1, 0); PG8_LDB(B1, 1, 1); PG8_SCHED; PG8_LDA(At, 1, 0); PG8_STAGE(PG8_SA(0, 1), a2 + hstep, voffA);
            CP_STORE(); PG8_WAIT_LOOP(); PG8_WAIT_L(0); PG8_BAR; PG8_MMA(0, 0, At, B0); CP_READ(); PG8_MMA(0, 1, At, B1); CP_ISSUE(); PG8_BAR; PG8_SCHED;
            PG8_LDA(At, 1, 1); PG8_STAGE(PG8_SB(1, 0), b3, voffB); PG8_STAGE(PG8_SB(1, 1), b3 + hstep, voffB); PG8_STAGE(PG8_SA(1, 0), a3, voffA);
            CP_STORE(); PG8_WAIT_LOOP(); PG8_WAIT_L(0); PG8_BAR; PG8_MMA(1, 0, At, B0); CP_READ(); PG8_MMA(1, 1, At, B1); CP_ISSUE(); PG8_BAR; PG8_SCHED;
        }
        if constexpr (ALIGN_EPI) { if (wr == 0) PG8_BAR; }
        { int l2_; asm volatile("v_mbcnt_lo_u32_b32 %0, -1, 0\n\tv_mbcnt_hi_u32_b32 %0, -1, %0" : "=v"(l2_)); E(acc, cur, wr, wc, l2_ & 15, l2_ >> 4); } S.done(cur);
        if (!has_next) break;
#pragma unroll
        for (int a = 0; a < 2; ++a)
#pragma unroll
            for (int b = 0; b < 2; ++b)
#pragma unroll
                for (int m = 0; m < 4; ++m)
#pragma unroll
                    for (int n = 0; n < 2; ++n) acc[a][b][m][n] = acc_zero;
        cur = nxt; cA = nA; cB = nB; ++ui;
        if constexpr (ALIGN_EPI) { if (wr == 1) PG8_BAR; }
    }
    PG8_WAIT_V(0);
    if constexpr (!ALIGN_EPI) { if (wr == 0) PG8_BAR; }
    PG8_BAR;
    if constexpr (COPY) {
        if (cp_n >= 4 && cp_n - 4 < cp_cnt) __builtin_nontemporal_store(cp_r, (cp4*)(C.dst + ((size_t)cp_base + cp_n - 4) * CP_STRIDE + cp_voff));
#pragma unroll
        for (int j = 3; j >= 1; --j) { const int k = cp_n - j;
            if (k >= 0 && k < cp_cnt) { const int sl = k % 3; const cp4 v = *(const PG8_LAS cp4*)(cp_stage + sl * 1024 + cp_voff);
                __builtin_nontemporal_store(v, (cp4*)(C.dst + ((size_t)cp_base + k) * CP_STRIDE + cp_voff)); } }
        C.cur = cp_base + (cp_n < cp_cnt ? cp_n : cp_cnt);
    }
#undef CP_ISSUE
#undef CP_READ
#undef CP_STORE
#undef PG8_SA
#undef PG8_SB
#undef PG8_STAGE
#undef PG8_LDA
#undef PG8_LDB
#undef PG8_MMA
#undef PG8_WAIT_V
#undef PG8_WAIT_LOOP
#undef PG8_WAIT_L
#undef PG8_BAR
#undef PG8_SCHED
}
struct Order2 {
    StaticOrder so; int nt;
    __device__ __forceinline__ void init(int M, int N, int K, int G, int c) { so.init(M, N, G, c); nt = K / BK; }
    __device__ __forceinline__ bool next(int i, Unit2& u) const { Unit v; if (!so.next(i, v)) return false; u.pm = v.pm; u.pn = v.pn; u.k0 = 0; u.nt = nt; u.split = 0; return true; }
    __device__ __forceinline__ void a_ready(const Unit2&) const {}
    __device__ __forceinline__ void done(const Unit2&) const {}
};
struct SplitOrder {
    StaticOrder so; int nt, nsplit, nN, npre, ntot;
    __device__ __forceinline__ void init(int Mp, int N, int K, int nsplit_, int G, int c) { so.init(Mp, N, G, c); nt = K / BK; nsplit = nsplit_; nN = N / BM; npre = so.nwg; ntot = npre + 4 * nN * nsplit; }
    __device__ __forceinline__ bool next(int i, Unit2& u) const {
        const long L = (long)i * so.G + so.c; if (L >= ntot) return false;
        Unit v; v.pm = 0; v.pn = 0; const bool pre = so.next(i, v);
        const int s = (int)L - npre, ks = s % nsplit, tile = s / nsplit, nts = nt / nsplit;
        u.pm = pre ? v.pm : so.nM + tile / nN; u.pn = pre ? v.pn : tile % nN; u.nt = pre ? nt : nts; u.k0 = pre ? 0 : ks * nts; u.split = pre ? 0 : 1; return true;
    }
    __device__ __forceinline__ void a_ready(const Unit2&) const {}
    __device__ __forceinline__ void done(const Unit2&) const {}
};
}

constexpr int NWAVES = 8;
constexpr int DM = 1024, SEQ = 16384, NBAT = 128, DSEQ = 8, MP = SEQ, MS = NBAT * DSEQ, MTOT = MP + MS;
constexpr int DFF = 2816, NH = 8, HD = 64, DATT = 512, DSSM = 512, NG = 32, NP = 64, NC = 16, WBUF = 2048, PAST = 8192;
constexpr int NADA = 9 * DM;
constexpr float EPS = 1e-6f;
constexpr float QSCALE = 0.125f * 1.44269504088896340736f;
constexpr int CHUNK = 128, NCHUNK_P = SEQ / CHUNK  , NCHUNK_S = MS / CHUNK  ;

constexpr size_t MiB = 1u << 20;
constexpr size_t WS_CTL = 0, CTL_ZERO_BYTES = 1 * MiB;
constexpr size_t WS_ADA = 1 * MiB;
constexpr size_t WS_SC = 10 * MiB;
constexpr size_t WS_ROPE = 11 * MiB;
constexpr size_t WS_SSMT = 13 * MiB;
constexpr size_t WS_WADA = 14 * MiB;
constexpr size_t WS_W1T = 32 * MiB;
constexpr size_t WS_W1D = 43 * MiB;
constexpr size_t WS_W2T = 49 * MiB;
constexpr size_t WS_W2D = 60 * MiB;
constexpr size_t WS_WIN = 66 * MiB;
constexpr size_t WS_WGLU = 70 * MiB;
constexpr size_t WS_WOUT = 71 * MiB;
constexpr size_t WS_XN = 74 * MiB;
constexpr size_t WS_H = 108 * MiB;
constexpr size_t WS_X1 = 202 * MiB;
constexpr size_t WS_X2 = 270 * MiB;
constexpr size_t WS_Q = 338 * MiB;
constexpr size_t WS_K = 355 * MiB;
constexpr size_t WS_VT = 372 * MiB;
constexpr size_t WS_U = 420 * MiB;
constexpr size_t WS_SQKV = 437 * MiB;
constexpr size_t WS_MIX = 443 * MiB;
constexpr size_t WS_GB = 477 * MiB;
constexpr size_t WS_CS = 494 * MiB;
constexpr size_t WS_SLAB = 496 * MiB;
constexpr size_t WS_OP = 540 * MiB;
constexpr size_t WS_ML = 588 * MiB;
constexpr size_t WS_XN8 = 592 * MiB;
constexpr size_t WS_W1T8 = 610 * MiB;
constexpr size_t WS_W2T8 = 616 * MiB;
constexpr size_t WS_SB = 622 * MiB;
constexpr size_t WS_SA = 623 * MiB;
constexpr size_t WS_END = 624 * MiB;
constexpr size_t ST_ABAR = 0;
constexpr size_t ST_CM = 256 * 1024;
constexpr size_t ST_PW = 384 * 1024;
constexpr size_t ST_CP = 448 * 1024;
constexpr size_t ST_CL = 704 * 1024;
constexpr size_t O_YP = 0, O_YS = 16777216, O_KP = 17825792, O_VP = 18874368, O_HRP = 19922944, O_HIP = 19924992,
                 O_KS = 19927040, O_VS = 154144768, O_HRS = 288362496, O_HIS = 288624640, O_END = 288886784;
constexpr int CW_TMO = 0, CW_BAR = 4096, CW_AMAX = 16384;

constexpr int RING_OFF = 0, RING_BYTES = 131072;
constexpr int CPSTAGE_BYTES = 24576;
constexpr int LDSCTL_OFF = RING_BYTES + CPSTAGE_BYTES, MISC_OFF = LDSCTL_OFF + 320;
constexpr int LDS_BYTES = 157696;

#define GAS __attribute__((address_space(1)))
#define LAS __attribute__((address_space(3)))
typedef unsigned short bf16;
typedef unsigned v4u __attribute__((ext_vector_type(4)));
typedef unsigned v2u __attribute__((ext_vector_type(2)));
typedef float f32x4 __attribute__((ext_vector_type(4)));
typedef float f32x2 __attribute__((ext_vector_type(2)));
typedef short bf16x8 __attribute__((ext_vector_type(8)));
typedef GAS unsigned gu32;
#define RLX_AGENT __ATOMIC_RELAXED, __HIP_MEMORY_SCOPE_AGENT
#define LDS_WAIT() asm volatile("s_waitcnt lgkmcnt(0)" ::: "memory")
#define VM_WAIT() asm volatile("s_waitcnt vmcnt(0)" ::: "memory")
__device__ __forceinline__ unsigned f2bf(float f) { unsigned u = __builtin_bit_cast(unsigned, f); return (u + 0x7fffu + ((u >> 16) & 1u)) >> 16; }
__device__ __forceinline__ unsigned pk2(float lo, float hi) { return pg8::cvt_pk_bf16(lo, hi); }
__device__ __forceinline__ float bf2f(unsigned short b) { return __builtin_bit_cast(float, (unsigned)b << 16); }
__device__ __forceinline__ float fast_sigmoid(float x) { return __builtin_amdgcn_rcpf(1.0f + __builtin_amdgcn_exp2f(-1.44269504088896f * x)); }
__device__ __forceinline__ float gelu_tanh(float x) { const float z = 1.5957691216057308f * (x + 0.044715f * x * x * x); return x * fast_sigmoid(z); }
#define XB_TMO      128
#define XB_XCNT(j)  (256  + 64 * (j))
#define XB_XSUB(j)  (1280 + 64 * (j))
#define XB_XGEN(j)  (2304 + 64 * (j))
#define XB_TOP      3328
#define XB_TOPGEN   3392
#define XCD_BAR_WORDS 3456
#define XB_SPIN_CAP (1u << 18)

__device__ __forceinline__ unsigned xb_ld(unsigned* p)              { return __hip_atomic_load(p, __ATOMIC_RELAXED, __HIP_MEMORY_SCOPE_AGENT); }
__device__ __forceinline__ unsigned xb_add(unsigned* p, unsigned v) { return __hip_atomic_fetch_add(p, v, __ATOMIC_RELAXED, __HIP_MEMORY_SCOPE_AGENT); }
__device__ __forceinline__ unsigned xb_xcc_id() { return (unsigned)__builtin_amdgcn_s_getreg((3 << 11) | 20) & 0xFu; }
#define XB_SPIN(cond, bar) do { unsigned _sp = 0; while (cond) { __builtin_amdgcn_s_sleep(1); \
    if ((++_sp & 255u) == 0u) { if (xb_ld(&(bar)[XB_TMO])) break; if (_sp > XB_SPIN_CAP) { atomicAdd(&(bar)[XB_TMO], 1u); break; } } } } while (0)

struct XcdBarrier {
    unsigned* bar; unsigned x;
    volatile LAS unsigned* st;
};

__device__ __forceinline__ XcdBarrier xcd_barrier_post(unsigned* bar, volatile LAS unsigned* st) {
    XcdBarrier b; b.bar = bar; b.x = xb_xcc_id(); b.st = st;
    if (threadIdx.x == 0) (void)xb_add(&bar[XB_XCNT(b.x)], 1u);
    return b;
}
__device__ __forceinline__ void xcd_barrier_complete(unsigned* bar, unsigned x, unsigned& nloc, unsigned& nx) {
    const unsigned G = gridDim.x * gridDim.y * gridDim.z;
    unsigned sum, cnt, mine, sp = 0u;
    for (;;) {
        sum = 0u; cnt = 0u; mine = 0u;
#pragma unroll
        for (unsigned j = 0; j < 16; ++j) { const unsigned c = xb_ld(&bar[XB_XCNT(j)]); sum += c; cnt += (c > 0u) ? 1u : 0u; mine = (j == x) ? c : mine; }
        if (sum == G) break;
        __builtin_amdgcn_s_sleep(1);
        if ((++sp & 255u) == 0u) { if (xb_ld(&bar[XB_TMO])) break; if (sp > XB_SPIN_CAP) { atomicAdd(&bar[XB_TMO], 1u); break; } }
    }
    nloc = mine > 0u ? mine : 1u; nx = cnt > 0u ? cnt : 1u;
}

__device__ __forceinline__ void xcd_barrier(const XcdBarrier& b) {
    asm volatile("s_waitcnt vmcnt(0)" ::: "memory");
    __syncthreads();
    if (threadIdx.x == 0) {
        unsigned* bar = b.bar;
        __builtin_amdgcn_s_waitcnt(0);
        unsigned nloc = b.st[0], nx = b.st[1];
        if (nloc == 0u) { xcd_barrier_complete(bar, b.x, nloc, nx); b.st[0] = nloc; b.st[1] = nx; }
        const unsigned old = xb_add(&bar[XB_XSUB(b.x)], 1u);
        const unsigned gen = old / nloc;
        if (old + 1u == (gen + 1u) * nloc) {
            __builtin_amdgcn_fence(__ATOMIC_RELEASE, "agent");
            asm volatile("s_waitcnt vmcnt(0)" ::: "memory");
            const unsigned og = xb_add(&bar[XB_TOP], 1u);
            if (og + 1u == (gen + 1u) * nx) xb_add(&bar[XB_TOPGEN], 1u);
        }
        XB_SPIN(xb_ld(&bar[XB_TOPGEN]) == gen, bar);
        __builtin_amdgcn_fence(__ATOMIC_ACQUIRE, "agent");
        asm volatile("s_waitcnt vmcnt(0)" ::: "memory");
    }
    __syncthreads();
}


struct Args { const float* in[32]; float* out; unsigned char* ws; int ph_lo, ph_hi, nocopy, pad; };
enum { I_XP = 0, I_XS, I_CP, I_CS, I_CK, I_CV, I_SRE, I_SIM, I_WADA, I_BADA, I_GF1, I_W1G, I_W1U, I_W1D, I_GMIX, I_WIN, I_GQ, I_GK,
       I_ARE, I_AIM, I_LDT, I_BRE, I_BIM, I_CRE, I_CIM, I_SD, I_WGLU, I_WOUT, I_GF2, I_W2G, I_W2U, I_W2D };
struct Frame {
    LAS unsigned char* lds;
    volatile LAS unsigned* MISC;
    gu32* ctl;
    int tid, lane, wave;
    int vcu, G;
};
__device__ __forceinline__ int ada_row(int m) { return m < MP ? 0 : 1 + ((m - MP) >> 3); }
__device__ __forceinline__ float wave_sum(float v) {
#pragma unroll
    for (int o = 1; o < 64; o <<= 1) v += __shfl_xor(v, o);
    return v;
}
__device__ __forceinline__ float wave_max(float v) {
#pragma unroll
    for (int o = 1; o < 64; o <<= 1) v = fmaxf(v, __shfl_xor(v, o));
    return v;
}

namespace pg8 {
struct EpiF32 {
    static constexpr bool PERM = false, AFTER_DRAIN = false;
    float* C; int ldc; const float* bias;
    __device__ __forceinline__ void operator()(const f32x4 (&acc)[2][2][4][2], const Unit2& u, int wr, int wc, int fr, int fq) const {
        const int row0 = u.pm * BM + wr * 64 + fr, col0 = u.pn * BM + wc * 32 + 4 * fq;
        f32x4 bv[2][2];
#pragma unroll
        for (int bj = 0; bj < 2; ++bj)
#pragma unroll
            for (int n = 0; n < 2; ++n) bv[bj][n] = *(const f32x4*)(bias + col0 + bj * HALF + n * 16);
#pragma unroll
        for (int ai = 0; ai < 2; ++ai)
#pragma unroll
            for (int m = 0; m < 4; ++m) { float* rowp = C + (size_t)(row0 + ai * HALF + m * 16) * ldc + col0;
#pragma unroll
                for (int bj = 0; bj < 2; ++bj)
#pragma unroll
                    for (int n = 0; n < 2; ++n) *(f32x4*)(rowp + bj * HALF + n * 16) = acc[ai][bj][m][n] + bv[bj][n]; }
    }
};
template <int ACT  > struct EpiGated {
    static constexpr bool PERM = true, AFTER_DRAIN = false;
    bf16_t* O; int ldo; int col_off;
    __device__ __forceinline__ void operator()(const f32x4 (&acc)[2][2][4][2], const Unit2& u, int wr, int wc, int fr, int fq) const {
        const int row0 = u.pm * BM + wr * 64 + fr, col = col_off + u.pn * HALF + wc * 32 + 8 * fq;
#pragma unroll
        for (int ai = 0; ai < 2; ++ai)
#pragma unroll
            for (int m = 0; m < 4; ++m) {
                float r[8];
#pragma unroll
                for (int n = 0; n < 2; ++n)
#pragma unroll
                    for (int e = 0; e < 4; ++e) { const float a = acc[ai][0][m][n][e], b = acc[ai][1][m][n][e];
                        r[n * 4 + e] = (ACT == 0) ? a * b * fast_sigmoid(a) : a * fast_sigmoid(b); }
                u32x4 w; w.x = cvt_pk_bf16(r[0], r[1]); w.y = cvt_pk_bf16(r[2], r[3]); w.z = cvt_pk_bf16(r[4], r[5]); w.w = cvt_pk_bf16(r[6], r[7]);
                *(u32x4*)(O + blk_off(row0 + ai * HALF + m * 16, col, ldo)) = w;
            }
    }
};
struct EpiGated8 {
    static constexpr bool PERM = true, AFTER_DRAIN = false;
    bf16_t* O; int ldo; const float* sA; const unsigned* amax;
    __device__ __forceinline__ void operator()(const i32x4 (&acc)[2][2][4][2], const Unit2& u, int wr, int wc, int fr, int fq) const {
        const int row0 = u.pm * BM + wr * 64 + fr, col = u.pn * HALF + wc * 32 + 8 * fq;
        const float sg = __builtin_bit_cast(float, amax[0]) * (1.0f / 127.0f), su = __builtin_bit_cast(float, amax[1]) * (1.0f / 127.0f);
        float ras[2][4];
#pragma unroll
        for (int ai = 0; ai < 2; ++ai)
#pragma unroll
            for (int m = 0; m < 4; ++m) ras[ai][m] = sA[row0 + ai * HALF + m * 16];
#pragma unroll
        for (int ai = 0; ai < 2; ++ai)
#pragma unroll
            for (int m = 0; m < 4; ++m) { const int row = row0 + ai * HALF + m * 16; const float ra = ras[ai][m]; const float fg = ra * sg, fu = ra * su;
                float r[8];
#pragma unroll
                for (int n = 0; n < 2; ++n)
#pragma unroll
                    for (int e = 0; e < 4; ++e) { const float a = (float)acc[ai][0][m][n][e] * fg, b = (float)acc[ai][1][m][n][e] * fu;
                        r[n * 4 + e] = a * b * fast_sigmoid(a); }
                u32x4 w; w.x = cvt_pk_bf16(r[0], r[1]); w.y = cvt_pk_bf16(r[2], r[3]); w.z = cvt_pk_bf16(r[4], r[5]); w.w = cvt_pk_bf16(r[6], r[7]);
                *(u32x4*)(O + blk_off(row, col, ldo)) = w;
                __builtin_amdgcn_sched_barrier(0);
            }
    }
};
template <bool BIN, bool BOUT>
struct EpiResid {
    static constexpr bool PERM = false, AFTER_DRAIN = false;
    const float* baseP; const float* baseS; float* out; const float* ada; int gate_off; float coef; float* slab;
    __device__ __forceinline__ void operator()(f32x4 (&acc)[2][2][4][2], const Unit2& u, int wr, int wc, int fr, int fq) const {
        const int row0 = u.pm * BM + wr * 64 + fr, col0 = u.pn * BM + wc * 32 + 4 * fq;
        if (u.split) {
#pragma unroll
            for (int ai = 0; ai < 2; ++ai)
#pragma unroll
                for (int m = 0; m < 4; ++m) { const int row = row0 + ai * HALF + m * 16;
                    unsigned short* sl = (unsigned short*)slab + ((size_t)(u.k0 / u.nt) * MS + (size_t)(row - MP)) * DM;
#pragma unroll
                    for (int bj = 0; bj < 2; ++bj)
#pragma unroll
                        for (int n = 0; n < 2; ++n) { const int c = col0 + bj * HALF + n * 16; const f32x4 a_ = acc[ai][bj][m][n];
                            *(u32x2v*)(sl + c) = (u32x2v){cvt_pk_bf16(a_.x, a_.y), cvt_pk_bf16(a_.z, a_.w)}; } }
        } else {
            f32x4 g00, g01, g10, g11;
#define RES_LDP(D0, D1, D2, D3, PTR) do { const float* p_ = (PTR); \
                asm volatile("global_load_dwordx4 %0, %4, off\n\tglobal_load_dwordx4 %1, %4, off offset:64\n\tglobal_load_dwordx4 %2, %4, off offset:512\n\tglobal_load_dwordx4 %3, %4, off offset:576" \
                             : "=&v"(D0), "=&v"(D1), "=&v"(D2), "=&v"(D3) : "v"(p_) : "memory"); } while (0)
#define RES_LDB(D0, D1, D2, D3, PTR) do { const unsigned short* p_ = (PTR); \
                asm volatile("global_load_dwordx2 %0, %4, off\n\tglobal_load_dwordx2 %1, %4, off offset:32\n\tglobal_load_dwordx2 %2, %4, off offset:256\n\tglobal_load_dwordx2 %3, %4, off offset:288" \
                             : "=&v"(D0), "=&v"(D1), "=&v"(D2), "=&v"(D3) : "v"(p_) : "memory"); } while (0)
#define RES_WAIT(N, C0, C1, C2, C3) asm volatile("s_waitcnt vmcnt(" #N ")" : "+v"(C0), "+v"(C1), "+v"(C2), "+v"(C3), "+v"(g00), "+v"(g01), "+v"(g10), "+v"(g11) :: "memory")
#define RES_FMA(Q, V0, V1, V2, V3) do { constexpr int ai_ = (Q) >> 2, m_ = (Q) & 3; \
                acc[ai_][0][m_][0] = (V0) + (g00 * coef) * acc[ai_][0][m_][0]; acc[ai_][0][m_][1] = (V1) + (g01 * coef) * acc[ai_][0][m_][1]; \
                acc[ai_][1][m_][0] = (V2) + (g10 * coef) * acc[ai_][1][m_][0]; acc[ai_][1][m_][1] = (V3) + (g11 * coef) * acc[ai_][1][m_][1]; } while (0)
            RES_LDP(g00, g01, g10, g11, ada + gate_off + col0);
            if constexpr (!BIN) {
                f32x4 b0, b1, b2, b3, n0, n1, n2, n3;
#define RES_LD(D0, D1, D2, D3, ROWOFF) RES_LDP(D0, D1, D2, D3, baseP + (ROWOFF))
                RES_LD(b0, b1, b2, b3, (size_t)row0 * DM + col0);
#define RES_STEP(Q, C0, C1, C2, C3, N0, N1, N2, N3) do { \
                    if ((Q) < 7) { constexpr int ai2_ = ((Q) + 1) >> 2, m2_ = ((Q) + 1) & 3; RES_LD(N0, N1, N2, N3, (size_t)(row0 + ai2_ * HALF + m2_ * 16) * DM + col0); RES_WAIT(4, C0, C1, C2, C3); } \
                    else RES_WAIT(0, C0, C1, C2, C3); \
                    RES_FMA(Q, C0, C1, C2, C3); } while (0)
                RES_STEP(0, b0, b1, b2, b3, n0, n1, n2, n3); RES_STEP(1, n0, n1, n2, n3, b0, b1, b2, b3); RES_STEP(2, b0, b1, b2, b3, n0, n1, n2, n3); RES_STEP(3, n0, n1, n2, n3, b0, b1, b2, b3);
                RES_STEP(4, b0, b1, b2, b3, n0, n1, n2, n3); RES_STEP(5, n0, n1, n2, n3, b0, b1, b2, b3); RES_STEP(6, b0, b1, b2, b3, n0, n1, n2, n3); RES_STEP(7, n0, n1, n2, n3, b0, b1, b2, b3);
#undef RES_STEP
#undef RES_LD
            } else {
                const unsigned short* bp = (const unsigned short*)baseP;
                u32x2v b0, b1, b2, b3, n0, n1, n2, n3;
#define RES_BF(W) ((f32x4){__builtin_bit_cast(float, (W).x << 16), __builtin_bit_cast(float, (W).x & 0xffff0000u), __builtin_bit_cast(float, (W).y << 16), __builtin_bit_cast(float, (W).y & 0xffff0000u)})
#define RES_LD(D0, D1, D2, D3, ROWOFF) RES_LDB(D0, D1, D2, D3, bp + (ROWOFF))
                RES_LD(b0, b1, b2, b3, (size_t)row0 * DM + col0);
#define RES_STEP(Q, C0, C1, C2, C3, N0, N1, N2, N3) do { \
                    if ((Q) < 7) { constexpr int ai2_ = ((Q) + 1) >> 2, m2_ = ((Q) + 1) & 3; RES_LD(N0, N1, N2, N3, (size_t)(row0 + ai2_ * HALF + m2_ * 16) * DM + col0); RES_WAIT(4, C0, C1, C2, C3); } \
                    else RES_WAIT(0, C0, C1, C2, C3); \
                    RES_FMA(Q, RES_BF(C0), RES_BF(C1), RES_BF(C2), RES_BF(C3)); } while (0)
                RES_STEP(0, b0, b1, b2, b3, n0, n1, n2, n3); RES_STEP(1, n0, n1, n2, n3, b0, b1, b2, b3); RES_STEP(2, b0, b1, b2, b3, n0, n1, n2, n3); RES_STEP(3, n0, n1, n2, n3, b0, b1, b2, b3);
                RES_STEP(4, b0, b1, b2, b3, n0, n1, n2, n3); RES_STEP(5, n0, n1, n2, n3, b0, b1, b2, b3); RES_STEP(6, b0, b1, b2, b3, n0, n1, n2, n3); RES_STEP(7, n0, n1, n2, n3, b0, b1, b2, b3);
#undef RES_STEP
#undef RES_LD
#undef RES_BF
            }
#undef RES_FMA
#undef RES_WAIT
#undef RES_LDB
#undef RES_LDP
            asm volatile("" ::: "memory");
            if constexpr (!BOUT) {
#pragma unroll
                for (int q = 0; q < 8; ++q) { const int ai = q >> 2, m = q & 3; const size_t ro = (size_t)(row0 + ai * HALF + m * 16) * DM + col0;
                    *(f32x4*)(out + ro) = acc[ai][0][m][0]; *(f32x4*)(out + ro + 16) = acc[ai][0][m][1]; *(f32x4*)(out + ro + HALF) = acc[ai][1][m][0]; *(f32x4*)(out + ro + HALF + 16) = acc[ai][1][m][1]; }
            } else {
                unsigned short* ob = (unsigned short*)out;
#define RES_PK(V) ((u32x2v){cvt_pk_bf16((V).x, (V).y), cvt_pk_bf16((V).z, (V).w)})
#pragma unroll
                for (int q = 0; q < 8; ++q) { const int ai = q >> 2, m = q & 3; const size_t ro = (size_t)(row0 + ai * HALF + m * 16) * DM + col0;
                    *(u32x2v*)(ob + ro) = RES_PK(acc[ai][0][m][0]); *(u32x2v*)(ob + ro + 16) = RES_PK(acc[ai][0][m][1]); *(u32x2v*)(ob + ro + HALF) = RES_PK(acc[ai][1][m][0]); *(u32x2v*)(ob + ro + HALF + 16) = RES_PK(acc[ai][1][m][1]); }
#undef RES_PK
            }
        }
    }
};
struct EpiInProj {
    static constexpr bool PERM = false, AFTER_DRAIN = false;
    bf16_t *Q, *K, *VT, *U; float* SQKV; float* out; const _Float16* rope16; const float* gq; const float* gk;
    __device__ __forceinline__ void operator()(const f32x4 (&acc)[2][2][4][2], const Unit2& u, int wr, int wc, int fr, int fq) const {
        const int row0 = u.pm * BM + wr * 64 + fr; const int pn = u.pn;
        if (pn < 4) {
            const bool isq = pn < 2; const int hh = 4 * (pn & 1) + wc; const float* gw = isq ? gq : gk;
            f32x4 gv[2][2];
#pragma unroll
            for (int bj = 0; bj < 2; ++bj)
#pragma unroll
                for (int n = 0; n < 2; ++n) gv[bj][n] = *(const f32x4*)(gw + 32 * bj + 16 * n + 4 * fq);
            typedef _Float16 h16x4 __attribute__((ext_vector_type(4)));
            h16x4 rcs[2][4], rsn[2][4];
#pragma unroll
            for (int ai = 0; ai < 2; ++ai)
#pragma unroll
                for (int m = 0; m < 4; ++m) { const size_t ro = (size_t)(row0 + ai * HALF + m * 16) * 16 + 4 * (fq & 1); rcs[ai][m] = *(const h16x4*)(rope16 + ro); rsn[ai][m] = *(const h16x4*)(rope16 + ro + 8); }
#pragma unroll
            for (int ai = 0; ai < 2; ++ai)
#pragma unroll
                for (int m = 0; m < 4; ++m) { const int row = row0 + ai * HALF + m * 16;
                    const f32x4 cs = {(float)rcs[ai][m][0], (float)rcs[ai][m][1], (float)rcs[ai][m][2], (float)rcs[ai][m][3]}, sn = {(float)rsn[ai][m][0], (float)rsn[ai][m][1], (float)rsn[ai][m][2], (float)rsn[ai][m][3]};
                    float ss = 0.f;
#pragma unroll
                    for (int bj = 0; bj < 2; ++bj)
#pragma unroll
                        for (int n = 0; n < 2; ++n) { const f32x4 x = acc[ai][bj][m][n]; ss += (x[0] * x[0] + x[1] * x[1]) + (x[2] * x[2] + x[3] * x[3]); }
                    ss += __shfl_xor(ss, 16); ss += __shfl_xor(ss, 32);
                    const float rs = 1.0f / sqrtf(ss * (1.0f / 64.0f) + EPS);
                    f32x4 y[2][2];
#pragma unroll
                    for (int bj = 0; bj < 2; ++bj)
#pragma unroll
                        for (int n = 0; n < 2; ++n) y[bj][n] = acc[ai][bj][m][n] * rs * gv[bj][n];
                    {

                        f32x4 w;
#pragma unroll
                        for (int e = 0; e < 4; ++e) w[e] = __shfl_xor(y[0][0][e], 32);
                        y[0][0] = (fq < 2) ? (y[0][0] * cs - w * sn) : (y[0][0] * cs + w * sn);
                    }
                    if (isq) {
#pragma unroll
                        for (int bj = 0; bj < 2; ++bj)
#pragma unroll
                            for (int n = 0; n < 2; ++n) { const f32x4 v = y[bj][n] * QSCALE; const int c = hh * 64 + 32 * bj + 16 * n + 4 * fq;
                                u32x2v w2; w2.x = cvt_pk_bf16(v[0], v[1]); w2.y = cvt_pk_bf16(v[2], v[3]); *(u32x2v*)(Q + (size_t)row * DATT + c) = w2;
                                if (row >= MP) *(f32x4*)(SQKV + (size_t)(row - MP) * 1536 + c) = v; }
                    } else {
#pragma unroll
                        for (int bj = 0; bj < 2; ++bj)
#pragma unroll
                            for (int n = 0; n < 2; ++n) { const f32x4 v = y[bj][n]; const int c = hh * 64 + 32 * bj + 16 * n + 4 * fq;
                                u32x2v w2; w2.x = cvt_pk_bf16(v[0], v[1]); w2.y = cvt_pk_bf16(v[2], v[3]); *(u32x2v*)(K + (size_t)row * DATT + c) = w2;
                                if (row >= MP) { const int rs_ = row - MP, b = rs_ >> 3, s = rs_ & 7;
                                    *(f32x4*)(SQKV + (size_t)rs_ * 1536 + 512 + c) = v;
                                    *(f32x4*)(out + O_KS + ((size_t)b * WBUF + (WBUF - DSEQ) + s) * DATT + c) = v; }
                                else if (row >= MP - WBUF) *(f32x4*)(out + O_KP + (size_t)(row - (MP - WBUF)) * DATT + c) = v; }
                    }
                }
        } else if (pn < 6) {
#pragma unroll
            for (int ai = 0; ai < 2; ++ai)
#pragma unroll
                for (int m = 0; m < 4; ++m) { const int row = row0 + ai * HALF + m * 16;
#pragma unroll
                    for (int bj = 0; bj < 2; ++bj)
#pragma unroll
                        for (int n = 0; n < 2; ++n) { const f32x4 v = acc[ai][bj][m][n]; const int c = (pn - 4) * 256 + bj * HALF + wc * 32 + n * 16 + 4 * fq;
                            if (row >= MP) { const int rs_ = row - MP, b = rs_ >> 3, s = rs_ & 7;
                                *(f32x4*)(SQKV + (size_t)rs_ * 1536 + 1024 + c) = v;
                                *(f32x4*)(out + O_VS + ((size_t)b * WBUF + (WBUF - DSEQ) + s) * DATT + c) = v; }
                            else {
                                if (row >= MP - WBUF) *(f32x4*)(out + O_VP + (size_t)(row - (MP - WBUF)) * DATT + c) = v;
                                u32x2v w2; w2.x = cvt_pk_bf16(v[0], v[1]); w2.y = cvt_pk_bf16(v[2], v[3]); *(u32x2v*)(VT + (size_t)row * DATT + c) = w2;
                            } }
                }
        } else {
#pragma unroll
            for (int ai = 0; ai < 2; ++ai)
#pragma unroll
                for (int m = 0; m < 4; ++m) { const int row = row0 + ai * HALF + m * 16;
#pragma unroll
                    for (int bj = 0; bj < 2; ++bj)
#pragma unroll
                        for (int n = 0; n < 2; ++n) { const f32x4 v = acc[ai][bj][m][n]; const int c = (pn - 6) * 256 + bj * HALF + wc * 32 + n * 16 + 4 * fq;
                            u32x2v w2; w2.x = cvt_pk_bf16(v[0], v[1]); w2.y = cvt_pk_bf16(v[2], v[3]); *(u32x2v*)(U + (size_t)row * DSSM + c) = w2; }
                }
        }
    }
};
}

__device__ __forceinline__ void p0_transpose_item(const float* W, int K, int N, bf16* WT, int k0, int n0, int dest_row0, LAS float* scr, int lane) {
    float tv[32];
#pragma unroll
    for (int i = 0; i < 32; ++i) tv[i] = __builtin_nontemporal_load(W + (size_t)(k0 + 2 * i + (lane >> 5)) * N + n0 + (lane & 31));
#pragma unroll
    for (int i = 0; i < 32; ++i) scr[(2 * i + (lane >> 5)) * 33 + (lane & 31)] = tv[i];
    LDS_WAIT(); asm volatile("" ::: "memory");
    const int c = lane & 7;
#pragma unroll
    for (int j = 0; j < 4; ++j) { const int n = (lane >> 3) + 8 * j; const LAS float* s = scr + (8 * c) * 33 + n;
        v4u o; o.x = pk2(s[0 * 33], s[1 * 33]); o.y = pk2(s[2 * 33], s[3 * 33]); o.z = pk2(s[4 * 33], s[5 * 33]); o.w = pk2(s[6 * 33], s[7 * 33]);
        *(GAS v4u*)(WT + pg8::blk_off(dest_row0 + n, k0 + 8 * c, K)) = o; }
    LDS_WAIT(); asm volatile("" ::: "memory");
}
__device__ __forceinline__ int dest_row_of(int mode, int half, int n0);
__device__ __forceinline__ void p0_transpose_item8(const float* W, int K, int N, unsigned char* WT8, int k0, int n0, int dest_row0, const unsigned* amax, LAS float* scr, int lane) {
    float tv[32];
#pragma unroll
    for (int i = 0; i < 32; ++i) tv[i] = __builtin_nontemporal_load(W + (size_t)(k0 + 2 * i + (lane >> 5)) * N + n0 + (lane & 31));
#pragma unroll
    for (int i = 0; i < 32; ++i) scr[(2 * i + (lane >> 5)) * 33 + (lane & 31)] = tv[i];
    LDS_WAIT(); asm volatile("" ::: "memory");
    const int c = lane & 7; const float am = __builtin_bit_cast(float, amax[0]); const float qs = am > 0.f ? 127.0f / am : 0.f;
#pragma unroll
    for (int j = 0; j < 4; ++j) { const int n = (lane >> 3) + 8 * j; const LAS float* s = scr + (8 * c) * 33 + n;
        unsigned lo = 0u, hi = 0u;
#pragma unroll
        for (int q = 0; q < 4; ++q) { const int a = (int)__builtin_rintf(s[q * 33] * qs), b = (int)__builtin_rintf(s[(q + 4) * 33] * qs); lo |= ((unsigned)a & 0xffu) << (8 * q); hi |= ((unsigned)b & 0xffu) << (8 * q); }
        *(GAS v2u*)(WT8 + pg8::blk_byte(dest_row0 + n, k0 + 8 * c, K)) = (v2u){lo, hi}; }
    LDS_WAIT(); asm volatile("" ::: "memory");
}
__device__ __forceinline__ bool p0_mat8(const float* W, int K, int N, unsigned char* WT8, int half, const unsigned* amax, int& r, LAS float* scr, int lane) {
    const int nblk = N / 32, items = (K / 64) * nblk;
    if (r < items) { const int kb = r / nblk, nb = r % nblk; p0_transpose_item8(W, K, N, WT8, 64 * kb, 32 * nb, dest_row_of(1, half, 32 * nb), amax, scr, lane); return true; }
    r -= items; return false;
}
__device__ __forceinline__ int dest_row_of(int mode, int half, int n0) {
    if (mode == 1) return 256 * (n0 >> 7) + 128 * half + (n0 & 127);
    if (mode == 3) { const int hf = n0 >> 9, n = n0 & 511; return 256 * (n >> 7) + 128 * hf + (n & 127); }
    if (mode == 2 && n0 < 1024) { const int tile = n0 >> 8, hd = (n0 & 255) >> 6, e = n0 & 63; return 256 * tile + 128 * (e >> 5) + 32 * hd + (e & 31); }
    return n0;
}
__device__ __forceinline__ bool p0_mat(const float* W, int K, int N, bf16* WT, int mode, int half, int& r, LAS float* scr, int lane) {
    const int nblk = N / 32, items = (K / 64) * nblk;
    if (r < items) { const int kb = r / nblk, nb = r % nblk; p0_transpose_item(W, K, N, WT, 64 * kb, 32 * nb, dest_row_of(mode, half, 32 * nb), scr, lane); return true; }
    r -= items; return false;
}
__device__ __forceinline__ void p1_weights(Frame& F, const Args& A, int widx, int nworker) {
    LAS float* scr = (LAS float*)(F.lds + RING_OFF + F.wave * 16384);
    unsigned char* ws = A.ws;
    constexpr int NITEMS = 6 * 1408 + 1024 + 256 + 512;
    const unsigned* amax = (const unsigned*)(ws + WS_CTL) + CW_AMAX;
    for (int it = widx; it < NITEMS; it += nworker) {
        int r = it;
        if (p0_mat8(A.in[I_W1G], DM, DFF, ws + WS_W1T8, 0, amax + 0, r, scr, F.lane)) continue;
        if (p0_mat8(A.in[I_W1U], DM, DFF, ws + WS_W1T8, 1, amax + 1, r, scr, F.lane)) continue;
        if (p0_mat(A.in[I_W1D], DFF, DM, (bf16*)(ws + WS_W1D), 0, 0, r, scr, F.lane)) continue;
        if (p0_mat(A.in[I_WIN], DM, 2048, (bf16*)(ws + WS_WIN), 2, 0, r, scr, F.lane)) continue;
        if (p0_mat(A.in[I_WGLU], DSSM, 1024, (bf16*)(ws + WS_WGLU), 3, 0, r, scr, F.lane)) continue;
        if (p0_mat(A.in[I_WOUT], DM, DM, (bf16*)(ws + WS_WOUT), 0, 0, r, scr, F.lane)) continue;
        if (p0_mat8(A.in[I_W2G], DM, DFF, ws + WS_W2T8, 0, amax + 2, r, scr, F.lane)) continue;
        if (p0_mat8(A.in[I_W2U], DM, DFF, ws + WS_W2T8, 1, amax + 3, r, scr, F.lane)) continue;
        p0_mat(A.in[I_W2D], DFF, DM, (bf16*)(ws + WS_W2D), 0, 0, r, scr, F.lane);
    }
}
__device__ __forceinline__ void p0_prologue(Frame& F, const Args& A) {
    LAS float* scr = (LAS float*)(F.lds + RING_OFF + F.wave * 16384);
    const int gw = F.vcu * NWAVES + F.wave, NGW = F.G * NWAVES;
    unsigned char* ws = A.ws;
    for (int it = gw; it < 4608; it += NGW) { int r = it; p0_mat(A.in[I_WADA], DM, NADA, (bf16*)(ws + WS_WADA), 0, 0, r, scr, F.lane); }
    { unsigned* amax = (unsigned*)(ws + WS_CTL) + CW_AMAX;
      for (int it = gw; it < 4 * 44 * 8; it += NGW) { const int mat = it / 352, rem = it % 352, cb = rem >> 3, kb = rem & 7;
          const float* W = A.in[mat == 0 ? I_W1G : (mat == 1 ? I_W1U : (mat == 2 ? I_W2G : I_W2U))] + (size_t)(128 * kb) * DFF + 64 * cb + F.lane;
          float mx = 0.f;
#pragma unroll 16
          for (int k = 0; k < 128; ++k) mx = fmaxf(mx, fabsf(W[(size_t)k * DFF]));
          mx = wave_max(mx); if (F.lane == 0) atomicMax(amax + mat, __builtin_bit_cast(unsigned, mx)); } }
    const int gt = gw * 64 + F.lane, NGT = NGW * 64;
    { bf16* SC = (bf16*)(ws + WS_SC);
      for (int i = gt; i < 256 * DM / 2; i += NGT) { const int row = (2 * i) / DM, col = (2 * i) % DM; unsigned w = 0u;
          if (row < 129) { const float* c = row == 0 ? A.in[I_CP] : A.in[I_CS] + (size_t)(row - 1) * DM; const float a = c[col], b = c[col + 1]; w = pk2(a * fast_sigmoid(a), b * fast_sigmoid(b)); }
          *(GAS unsigned*)(SC + pg8::blk_off(row, col, DM)) = w; } }
    { _Float16* R = (_Float16*)(ws + WS_ROPE);
      for (int i = gt; i < MTOT * 8; i += NGT) { const int m = i >> 3, j = i & 7; const int pos = m < MP ? m : PAST + ((m - MP) & 7);
          const double inv = exp(-(double)j * (1.0 / 8.0) * 13.122363377404328  ); const double ang = (double)((float)pos * (float)inv);
          R[(size_t)m * 16 + j] = (_Float16)(float)cos(ang); R[(size_t)m * 16 + 8 + j] = (_Float16)(float)sin(ang); } }
    { unsigned char* T = ws + WS_SSMT;
      for (int id = gt; id < 83968; id += NGT) {
          if (id < 43008) {
              int gp, n; float* dst;
              if (id < 32768) { gp = id >> 4; n = (id & 15) + 1; dst = (float*)(T + ST_CP) + (size_t)gp * 32 + 2 * (id & 15); }
              else if (id < 40960) { const int i = id - 32768; gp = i >> 2; n = 1 << (i & 3); dst = (float*)(T + ST_PW) + (size_t)gp * 8 + 2 * (i & 3); }
              else { gp = id - 40960; n = CHUNK; dst = (float*)(T + ST_CL) + (size_t)gp * 2; }
              const double dt = exp((double)A.in[I_LDT][gp >> 6]); const double zr = (double)A.in[I_ARE][gp] * dt, zi = (double)A.in[I_AIM][gp] * dt;
              const double mg = exp((double)n * zr); dst[0] = (float)(mg * cos((double)n * zi)); dst[1] = (float)(mg * sin((double)n * zi));
          } else if (id < 75776) {
              const int i = id - 43008, gp = i >> 4, c = i & 15, grp = gp >> 6, p = gp & 63, pr = p >> 4, rho = p & 15;
              const double dt = exp((double)A.in[I_LDT][grp]); const double lre = (double)A.in[I_ARE][gp], lim = (double)A.in[I_AIM][gp];
              const double zr = lre * dt, zi = lim * dt; const double mg1 = exp(zr), br = mg1 * cos(zi) - 1.0, bi = mg1 * sin(zi); const double den = lre * lre + lim * lim;
              const double fr_ = (br * lre + bi * lim) / den, fi_ = (bi * lre - br * lim) / den;
              const double b_r = (double)A.in[I_BRE][(size_t)gp * 16 + c], b_i = (double)A.in[I_BIM][(size_t)gp * 16 + c];
              bf16* AB = (bf16*)(T + ST_ABAR) + (size_t)grp * 8 * 64 * 8; const int gq = c >> 3, j = c & 7;
              AB[((size_t)(2 * pr + 0) * 64 + rho + 16 * gq) * 8 + j] = (bf16)f2bf((float)(fr_ * b_r - fi_ * b_i));
              AB[((size_t)(2 * pr + 1) * 64 + rho + 16 * gq) * 8 + j] = (bf16)f2bf((float)(fr_ * b_i + fi_ * b_r));
              AB[((size_t)(2 * pr + 0) * 64 + rho + 16 * (gq + 2)) * 8 + j] = 0; AB[((size_t)(2 * pr + 1) * 64 + rho + 16 * (gq + 2)) * 8 + j] = 0;
          } else {
              const int i = id - 75776, grp = i >> 8, prc = (i >> 6) & 3, ln = i & 63, c = ln & 15, gq = ln >> 4;
              bf16* CMt = (bf16*)(T + ST_CM) + ((size_t)(grp * 4 + prc) * 64 + ln) * 8;
#pragma unroll
              for (int j = 0; j < 8; ++j) { const int ps = 16 * prc + 4 * gq + (j & 3);
                  const float v = (j < 4) ? A.in[I_CRE][((size_t)grp * 16 + c) * 64 + ps] : -A.in[I_CIM][((size_t)grp * 16 + c) * 64 + ps];
                  CMt[j] = (bf16)f2bf(v); }
          }
      } }
}

__device__ __forceinline__ void copy_tiles(const Args& A, int widx, int nworker, int lane) {
    constexpr int TPB = 255, NT = 2 * NBAT * TPB;
    for (int t = widx; t < NT; t += nworker) {
        const int kv = t / (NBAT * TPB), r = t % (NBAT * TPB), b = r / TPB, tl = r % TPB;
        const f32x4* src = (const f32x4*)(A.in[kv ? I_CV : I_CK] + (size_t)b * (WBUF * DATT) + DSEQ * DATT) + (size_t)tl * 1024 + lane;
        f32x4* dst = (f32x4*)(A.out + (kv ? O_VS : O_KS) + (size_t)b * (WBUF * DATT)) + (size_t)tl * 1024 + lane;
        f32x4 v[16];
#pragma unroll
        for (int j = 0; j < 16; ++j) v[j] = __builtin_nontemporal_load(src + 64 * j);
#pragma unroll
        for (int j = 0; j < 16; ++j) __builtin_nontemporal_store(v[j], dst + 64 * j);
    }
}

struct Combine { const float* slab; int nsl; const float* cbase; int gate_off; float ccoef; float* cres; };
__device__ __forceinline__ f32x4 bf4(const v2u w) { return (f32x4){__builtin_bit_cast(float, w.x << 16), __builtin_bit_cast(float, w.x & 0xffff0000u), __builtin_bit_cast(float, w.y << 16), __builtin_bit_cast(float, w.y & 0xffff0000u)}; }
template <int NSL>
__device__ __forceinline__ f32x4 combine_chunk(const Combine& C, const float* ar, int ms, int lane, int j) {
    v2u sl[NSL];
#pragma unroll
    for (int k = 0; k < NSL; ++k) sl[k] = ((const v2u*)((const bf16*)C.slab + ((size_t)k * MS + ms) * DM))[lane + 64 * j];
    const f32x4 gv = ((const f32x4*)(ar + C.gate_off))[lane + 64 * j], bv = ((const f32x4*)(C.cbase + (size_t)ms * DM))[lane + 64 * j];
    f32x4 acc = bf4(sl[0]);
#pragma unroll
    for (int k = 1; k < NSL; ++k) acc += bf4(sl[k]);
    const f32x4 r = bv + C.ccoef * gv * acc;
    ((f32x4*)(C.cres + (size_t)ms * DM))[lane + 64 * j] = r;
    return r;
}
template <int NSL>
__device__ __forceinline__ void combine_row(const Combine& C, const float* ar, int ms, int lane, f32x4 (&v)[4]) {
#pragma unroll
    for (int j = 0; j < 4; ++j) v[j] = combine_chunk<NSL>(C, ar, ms, lane, j);
}
template <bool PBF>
__device__ __forceinline__ f32x4 ld_prow(const float* srcP, const int m, const int i) {
    if constexpr (!PBF) return ((const f32x4*)(srcP + (size_t)m * DM))[i];
    else { const v2u w = ((const v2u*)((const bf16*)srcP + (size_t)m * DM))[i];
        return (f32x4){__builtin_bit_cast(float, w.x << 16), __builtin_bit_cast(float, w.x & 0xffff0000u), __builtin_bit_cast(float, w.y << 16), __builtin_bit_cast(float, w.y & 0xffff0000u)}; }
}
template <bool Q8>
__device__ __forceinline__ void norm_row(const f32x4 (&v)[4], const f32x4 (&gv)[4], const f32x4 (&sh)[4], const f32x4 (&sc)[4], const int m, const int lane, bf16* XN, unsigned char* XN8, float* sA) {
    float s = 0.f;
#pragma unroll
    for (int j = 0; j < 4; ++j) s += (v[j].x * v[j].x + v[j].y * v[j].y) + (v[j].z * v[j].z + v[j].w * v[j].w);
    const float rstd = 1.f / sqrtf(wave_sum(s) * (1.f / DM) + EPS);
    f32x4 y[4]; float am = 0.f;
#pragma unroll
    for (int j = 0; j < 4; ++j) { y[j] = (v[j] * rstd * gv[j]) * (1.0f + sc[j]) + sh[j];
        am = fmaxf(am, fmaxf(fmaxf(fabsf(y[j].x), fabsf(y[j].y)), fmaxf(fabsf(y[j].z), fabsf(y[j].w)))); }
    if constexpr (Q8) {
        am = wave_max(am); const float qs = am > 0.f ? 127.0f / am : 0.f;
#pragma unroll
        for (int j = 0; j < 4; ++j) { const int a = (int)__builtin_rintf(y[j].x * qs), b = (int)__builtin_rintf(y[j].y * qs), c = (int)__builtin_rintf(y[j].z * qs), d = (int)__builtin_rintf(y[j].w * qs);
            *(GAS unsigned*)(XN8 + pg8::blk_byte(m, 4 * lane + 256 * j, DM)) = ((unsigned)a & 0xffu) | (((unsigned)b & 0xffu) << 8) | (((unsigned)c & 0xffu) << 16) | (((unsigned)d & 0xffu) << 24); }
        if (lane == 0) sA[m] = am * (1.0f / 127.0f);
    } else {
#pragma unroll
        for (int j = 0; j < 4; ++j) *(GAS unsigned long long*)(XN + pg8::blk_off(m, 4 * lane + 256 * j, DM)) = (unsigned long long)pk2(y[j].x, y[j].y) | ((unsigned long long)pk2(y[j].z, y[j].w) << 32);
    }
}
template <bool Q8, int NSL, int PE, bool PBF>
__device__ __forceinline__ void norm_mod_rows(Frame& F, const float* srcP, const float* srcS, const float* g, const float* ada, int sh_off, int sc_off, bf16* XN, const Combine C, unsigned char* XN8, float* sA) {
    f32x4 gv[4];
#pragma unroll
    for (int j = 0; j < 4; ++j) gv[j] = ((const f32x4*)g)[F.lane + 64 * j];
    if (F.G == 256) {
        const int pair = F.wave >> 1, odd = F.wave & 1;
        const int np = odd ? 16 - PE : PE, p0 = F.vcu * 64 + pair * 16 + (odd ? PE : 0);
        f32x4 vn[4], sh[4], sc[4];
#pragma unroll
        for (int j = 0; j < 4; ++j) vn[j] = ld_prow<PBF>(srcP, p0, F.lane + 64 * j);
        if (!odd) {
            const int ms = F.vcu * 4 + pair, m = MP + ms; const float* ar = ada + (size_t)ada_row(m) * NADA;
            f32x4 v[4];
#pragma unroll
            for (int j = 0; j < 4; ++j) { sh[j] = ((const f32x4*)(ar + sh_off))[F.lane + 64 * j]; sc[j] = ((const f32x4*)(ar + sc_off))[F.lane + 64 * j]; }
            if constexpr (NSL > 0) combine_row<NSL>(C, ar, ms, F.lane, v);
            else {
#pragma unroll
                for (int j = 0; j < 4; ++j) v[j] = ((const f32x4*)(srcS + (size_t)ms * DM))[F.lane + 64 * j]; }
            norm_row<Q8>(v, gv, sh, sc, m, F.lane, XN, XN8, sA);
        }
#pragma unroll
        for (int j = 0; j < 4; ++j) { sh[j] = ((const f32x4*)(ada + sh_off))[F.lane + 64 * j]; sc[j] = ((const f32x4*)(ada + sc_off))[F.lane + 64 * j]; }
#pragma unroll 1
        for (int i = 0; i < np; ++i) {
            f32x4 v[4];
#pragma unroll
            for (int j = 0; j < 4; ++j) v[j] = vn[j];
            const int nx = p0 + (i + 1 < np ? i + 1 : i);
#pragma unroll
            for (int j = 0; j < 4; ++j) vn[j] = ld_prow<PBF>(srcP, nx, F.lane + 64 * j);
            norm_row<Q8>(v, gv, sh, sc, p0 + i, F.lane, XN, XN8, sA);
        }
        return;
    }
    const int gw = F.vcu * NWAVES + F.wave, NGW = F.G * NWAVES;
    for (int m = gw; m < MTOT; m += NGW) {
        const float* ar = ada + (size_t)ada_row(m) * NADA;
        f32x4 v[4], sh[4], sc[4];
#pragma unroll
        for (int j = 0; j < 4; ++j) { sh[j] = ((const f32x4*)(ar + sh_off))[F.lane + 64 * j]; sc[j] = ((const f32x4*)(ar + sc_off))[F.lane + 64 * j]; }
        bool done = false;
        if constexpr (NSL > 0) { if (m >= MP) { combine_row<NSL>(C, ar, m - MP, F.lane, v); done = true; } }
        if (!done) {
#pragma unroll
            for (int j = 0; j < 4; ++j) v[j] = m < MP ? ld_prow<PBF>(srcP, m, F.lane + 64 * j) : ((const f32x4*)(srcS + (size_t)(m - MP) * DM))[F.lane + 64 * j]; }
        norm_row<Q8>(v, gv, sh, sc, m, F.lane, XN, XN8, sA);
    }
}

__device__ __forceinline__ void copy_back(pg8::CopyJob& C, int nops, const int lane) {
    while (nops > 0 && C.end > C.cur) {
        int nb = C.end - C.cur; nb = nb < 8 ? nb : 8; nb = nb < nops ? nb : nops;
        v4u v[8];
#pragma unroll
        for (int j = 0; j < 8; ++j) if (j < nb) v[j] = __builtin_nontemporal_load((const v4u*)(C.src + (size_t)(C.end - 1 - j) * pg8::CP_STRIDE) + lane);
#pragma unroll
        for (int j = 0; j < 8; ++j) if (j < nb) __builtin_nontemporal_store(v[j], (v4u*)(C.dst + (size_t)(C.end - 1 - j) * pg8::CP_STRIDE) + lane);
        C.end -= nb; nops -= nb;
    }
}

__device__ __forceinline__ bf16x8 ld8(const bf16* p) { return *(const bf16x8*)p; }
#define MFMA16(a, b, c) __builtin_amdgcn_mfma_f32_16x16x32_bf16((a), (b), (c), 0, 0, 0)

constexpr int AT_ROWB = 144, AT_VOFF = 384 * AT_ROWB;
typedef short s16x4 __attribute__((ext_vector_type(4)));
__device__ __forceinline__ s16x4 lds_tr(const LAS unsigned char* p) { return __builtin_amdgcn_ds_read_tr16_b64_v4i16((LAS s16x4*)p); }
__device__ __forceinline__ void attn_unit(unsigned char* ws, LAS unsigned char* lds, const int unit, const int tid, const int wave, const int lane) {
    const int G = unit >> 9, u = unit & 511, h = u >> 6;
    int r, sb, d, L;
    if (G == 0) { d = 1; L = 16384; r = 0; sb = u & 63; } else if (G == 1) { d = 4; L = 4096; r = (u >> 4) & 3; sb = u & 15; } else { d = 16; L = 1024; r = (u >> 2) & 15; sb = u & 3; }
    const int q0 = sb * 256, k0 = q0 - 128;
    const bf16* Q = (const bf16*)(ws + WS_Q); const bf16* Kb = (const bf16*)(ws + WS_K) + h * 64; const bf16* Vb = (const bf16*)(ws + WS_VT) + h * 64;
#pragma unroll
    for (int i = 0; i < 6; ++i) { const int c = tid + 512 * i, row = c >> 3, ch = c & 7; int kk = k0 + row; kk = kk < 0 ? 0 : (kk > L - 1 ? L - 1 : kk);
        const size_t off = (size_t)(r + d * kk) * DATT + ch * 8;
        const v4u kv = *(const v4u*)(Kb + off), vv = *(const v4u*)(Vb + off);
        *(LAS v4u*)(lds + row * AT_ROWB + ch * 16) = kv; *(LAS v4u*)(lds + AT_VOFF + row * AT_ROWB + ch * 16) = vv; }
    __syncthreads();
    const int l15 = lane & 15, g = lane >> 4, kb0 = 32 * wave;
    bf16x8 qf[2][2];
#pragma unroll
    for (int cb = 0; cb < 2; ++cb) { const size_t tq = (size_t)r + (size_t)d * (q0 + 32 * wave + 16 * cb + l15); const bf16* qp = Q + tq * DATT + h * 64 + 8 * g; qf[cb][0] = ld8(qp); qf[cb][1] = ld8(qp + 32); }
    f32x4 s[2][10];
#pragma unroll
    for (int pp = 0; pp < 5; ++pp)
#pragma unroll
        for (int hb = 0; hb < 2; ++hb) {
            const int kw = kb0 + 32 * pp + 8 * (l15 >> 2) + 4 * hb + (l15 & 3);
            const LAS unsigned char* kp = lds + kw * AT_ROWB + 16 * g;
            const bf16x8 a0 = *(const LAS bf16x8*)kp, a1 = *(const LAS bf16x8*)(kp + 64);
#pragma unroll
            for (int cb = 0; cb < 2; ++cb) { f32x4 z = {0.f, 0.f, 0.f, 0.f}; z = MFMA16(a0, qf[cb][0], z); z = MFMA16(a1, qf[cb][1], z); s[cb][2 * pp + hb] = z; }
        }
    float mx[2], ls[2];
#pragma unroll
    for (int cb = 0; cb < 2; ++cb) {
        const int qi = 32 * wave + 16 * cb + l15; float m = -1e30f;
#pragma unroll
        for (int i = 0; i < 10; ++i)
#pragma unroll
            for (int e = 0; e < 4; ++e) { const int kw = kb0 + 32 * (i >> 1) + 8 * g + 4 * (i & 1) + e; const bool valid = (kw >= qi) && (kw <= qi + 128) && (k0 + kw >= 0);
                const float v = valid ? s[cb][i][e] : -1e30f; s[cb][i][e] = v; m = fmaxf(m, v); }
        m = fmaxf(m, __shfl_xor(m, 16)); m = fmaxf(m, __shfl_xor(m, 32));
        float l = 0.f;
#pragma unroll
        for (int i = 0; i < 10; ++i)
#pragma unroll
            for (int e = 0; e < 4; ++e) { const float p = __builtin_amdgcn_exp2f(s[cb][i][e] - m); s[cb][i][e] = p; l += p; }
        l += __shfl_xor(l, 16); l += __shfl_xor(l, 32);
        mx[cb] = m; ls[cb] = l;
    }
    f32x4 o[2][4];
#pragma unroll
    for (int cb = 0; cb < 2; ++cb)
#pragma unroll
        for (int nb = 0; nb < 4; ++nb) o[cb][nb] = (f32x4){0.f, 0.f, 0.f, 0.f};
#pragma unroll
    for (int pp = 0; pp < 5; ++pp) {
        bf16x8 pb[2];
#pragma unroll
        for (int cb = 0; cb < 2; ++cb) { v4u pw; pw.x = pk2(s[cb][2 * pp][0], s[cb][2 * pp][1]); pw.y = pk2(s[cb][2 * pp][2], s[cb][2 * pp][3]); pw.z = pk2(s[cb][2 * pp + 1][0], s[cb][2 * pp + 1][1]); pw.w = pk2(s[cb][2 * pp + 1][2], s[cb][2 * pp + 1][3]);
            pb[cb] = __builtin_bit_cast(bf16x8, pw); }
        const LAS unsigned char* vp = lds + AT_VOFF + (kb0 + 32 * pp + 8 * g + (l15 >> 2)) * AT_ROWB + 8 * (l15 & 3);
#pragma unroll
        for (int nb = 0; nb < 4; ++nb) { const s16x4 t0 = lds_tr(vp + 32 * nb), t1 = lds_tr(vp + 4 * AT_ROWB + 32 * nb);
            const bf16x8 av = {t0[0], t0[1], t0[2], t0[3], t1[0], t1[1], t1[2], t1[3]};
#pragma unroll
            for (int cb = 0; cb < 2; ++cb) o[cb][nb] = MFMA16(av, pb[cb], o[cb][nb]); }
    }
    bf16* OP = (bf16*)(ws + WS_OP); float* ML = (float*)(ws + WS_ML);
#pragma unroll
    for (int cb = 0; cb < 2; ++cb) { const size_t tq = (size_t)r + (size_t)d * (q0 + 32 * wave + 16 * cb + l15); const size_t rowi = ((size_t)G * SEQ + tq) * NH + h; const float inv = 1.0f / ls[cb];
#pragma unroll
        for (int nb = 0; nb < 4; ++nb) { const f32x4 v = o[cb][nb] * inv; v2u w; w.x = pk2(v[0], v[1]); w.y = pk2(v[2], v[3]); *(v2u*)(OP + rowi * 64 + 16 * nb + 4 * g) = w; }
        if (g == 0) *(f32x2*)(ML + rowi * 2) = (f32x2){mx[cb], ls[cb]}; }
    __syncthreads();
}
constexpr int AT4_VOFF = 256 * AT_ROWB;
__device__ __forceinline__ void sync4(LAS unsigned* cnt, unsigned& epoch, const int lane) {
    asm volatile("s_waitcnt vmcnt(0) lgkmcnt(0)" ::: "memory");
    epoch += 4u;
    if (lane == 0) __hip_atomic_fetch_add(cnt, 1u, __ATOMIC_RELAXED, __HIP_MEMORY_SCOPE_WORKGROUP);
    for (unsigned sp = 0; __hip_atomic_load(cnt, __ATOMIC_RELAXED, __HIP_MEMORY_SCOPE_WORKGROUP) < epoch && sp < (1u << 22); ++sp) __builtin_amdgcn_s_sleep(1);
    asm volatile("s_waitcnt lgkmcnt(0)" ::: "memory");
}
struct AttU { int G, h, r, d, q0, k0, edge; };
__device__ __forceinline__ AttU att_decode(const int unit) {
    AttU a; a.G = unit >> 10; const int u = unit & 1023, rest = u & 127; a.h = u >> 7; int sb;
    if (a.G == 0) { a.d = 1; a.r = 0; sb = rest; } else if (a.G == 1) { a.d = 4; a.r = rest >> 5; sb = rest & 31; } else { a.d = 16; a.r = rest >> 3; sb = rest & 7; }
    a.q0 = sb * 128; a.k0 = a.q0 - 128; a.edge = (sb == 0); return a;
}
__device__ __forceinline__ void att_load(unsigned char* ws, const AttU& a, const int tid4, v4u (&kv)[8], v4u (&vv)[8]) {
    const bf16* Kb = (const bf16*)(ws + WS_K) + a.h * 64; const bf16* Vb = (const bf16*)(ws + WS_VT) + a.h * 64;
#pragma unroll
    for (int i = 0; i < 8; ++i) { const int c = tid4 + 256 * i, row = c >> 3, ch = c & 7; int kk = a.k0 + row; kk = kk < 0 ? 0 : kk;
        const size_t off = (size_t)(a.r + a.d * kk) * DATT + ch * 8; kv[i] = *(const v4u*)(Kb + off); vv[i] = *(const v4u*)(Vb + off); }
}
__device__ __forceinline__ void att_store(LAS unsigned char* lds, const int tid4, const v4u (&kv)[8], const v4u (&vv)[8]) {
#pragma unroll
    for (int i = 0; i < 8; ++i) { const int c = tid4 + 256 * i, row = c >> 3, ch = c & 7;
        *(LAS v4u*)(lds + row * AT_ROWB + ch * 16) = kv[i]; *(LAS v4u*)(lds + AT4_VOFF + row * AT_ROWB + ch * 16) = vv[i]; }
}
__device__ __forceinline__ void attn_unit4_compute(unsigned char* ws, LAS unsigned char* lds, const AttU& au, const int wave, const int lane, const bool pf, const AttU& nxt, const int tid4, v4u (&kv)[8], v4u (&vv)[8]) {
    const int G = au.G, h = au.h, r = au.r, d = au.d, q0 = au.q0, k0 = au.k0; const bool edge = au.edge != 0;
    const bf16* Q = (const bf16*)(ws + WS_Q);
    const int l15 = lane & 15, g = lane >> 4, kb0 = 32 * wave;
    bf16x8 qf[2][2];
#pragma unroll
    for (int cb = 0; cb < 2; ++cb) { const size_t tq = (size_t)r + (size_t)d * (q0 + 32 * wave + 16 * cb + l15); const bf16* qp = Q + tq * DATT + h * 64 + 8 * g; qf[cb][0] = ld8(qp); qf[cb][1] = ld8(qp + 32); }
    float mx[2], ls[2]; bf16x8 pb[2][5];
#pragma unroll
    for (int cb = 0; cb < 2; ++cb) {
        f32x4 s[10];
#pragma unroll
        for (int pp = 0; pp < 5; ++pp)
#pragma unroll
            for (int hb = 0; hb < 2; ++hb) {
                const int kw = kb0 + 32 * pp + 8 * (l15 >> 2) + 4 * hb + (l15 & 3);
                const LAS unsigned char* kp = lds + kw * AT_ROWB + 16 * g;
                const bf16x8 a0 = *(const LAS bf16x8*)kp, a1 = *(const LAS bf16x8*)(kp + 64);
                f32x4 z = {0.f, 0.f, 0.f, 0.f}; z = MFMA16(a0, qf[cb][0], z); z = MFMA16(a1, qf[cb][1], z); s[2 * pp + hb] = z;
            }
        const int qi = 32 * wave + 16 * cb + l15; float m = -1e30f;
#pragma unroll
        for (int i = 0; i < 10; ++i) {
            const bool interior = (i >= 2 && i < 8);
            if (!interior || edge) {
#pragma unroll
                for (int e = 0; e < 4; ++e) { const int kw = kb0 + 32 * (i >> 1) + 8 * g + 4 * (i & 1) + e; const bool valid = (kw >= qi) && (kw <= qi + 128) && (k0 + kw >= 0);
                    s[i][e] = valid ? s[i][e] : -1e30f; }
            }
#pragma unroll
            for (int e = 0; e < 4; ++e) m = fmaxf(m, s[i][e]);
        }
        m = fmaxf(m, __shfl_xor(m, 16)); m = fmaxf(m, __shfl_xor(m, 32));
        float l = 0.f;
#pragma unroll
        for (int i = 0; i < 10; ++i)
#pragma unroll
            for (int e = 0; e < 4; ++e) { const float p = __builtin_amdgcn_exp2f(s[i][e] - m); s[i][e] = p; l += p; }
        l += __shfl_xor(l, 16); l += __shfl_xor(l, 32);
        mx[cb] = m; ls[cb] = l;
#pragma unroll
        for (int pp = 0; pp < 5; ++pp) { v4u pw; pw.x = pk2(s[2 * pp][0], s[2 * pp][1]); pw.y = pk2(s[2 * pp][2], s[2 * pp][3]); pw.z = pk2(s[2 * pp + 1][0], s[2 * pp + 1][1]); pw.w = pk2(s[2 * pp + 1][2], s[2 * pp + 1][3]);
            pb[cb][pp] = __builtin_bit_cast(bf16x8, pw); }
    }
    if (pf) att_load(ws, nxt, tid4, kv, vv);
    f32x4 o[2][4];
#pragma unroll
    for (int cb = 0; cb < 2; ++cb)
#pragma unroll
        for (int nb = 0; nb < 4; ++nb) o[cb][nb] = (f32x4){0.f, 0.f, 0.f, 0.f};
#pragma unroll
    for (int pp = 0; pp < 5; ++pp) {
        const LAS unsigned char* vp = lds + AT4_VOFF + (kb0 + 32 * pp + 8 * g + (l15 >> 2)) * AT_ROWB + 8 * (l15 & 3);
#pragma unroll
        for (int nb = 0; nb < 4; ++nb) { const s16x4 t0 = lds_tr(vp + 32 * nb), t1 = lds_tr(vp + 4 * AT_ROWB + 32 * nb);
            const bf16x8 av = {t0[0], t0[1], t0[2], t0[3], t1[0], t1[1], t1[2], t1[3]};
#pragma unroll
            for (int cb = 0; cb < 2; ++cb) o[cb][nb] = MFMA16(av, pb[cb][pp], o[cb][nb]); }
    }
    bf16* OP = (bf16*)(ws + WS_OP); float* ML = (float*)(ws + WS_ML);
#pragma unroll
    for (int cb = 0; cb < 2; ++cb) { const size_t tq = (size_t)r + (size_t)d * (q0 + 32 * wave + 16 * cb + l15); const size_t rowi = ((size_t)G * SEQ + tq) * NH + h; const float inv = 1.0f / ls[cb];
#pragma unroll
        for (int nb = 0; nb < 4; ++nb) { const f32x4 v = o[cb][nb] * inv; v2u w; w.x = pk2(v[0], v[1]); w.y = pk2(v[2], v[3]); *(v2u*)(OP + rowi * 64 + 16 * nb + 4 * g) = w; }
        if (g == 0) *(f32x2*)(ML + rowi * 2) = (f32x2){mx[cb], ls[cb]}; }
}
__device__ __forceinline__ void attn_units4(unsigned char* ws, LAS unsigned char* lds, LAS unsigned* cnt, unsigned& epoch, const int u0, const int ustride, const int nunits, const int tid4, const int wave, const int lane) {
    if (u0 >= nunits) return;
    v4u kv[8], vv[8];
    AttU cur = att_decode(u0 % 3072); att_load(ws, cur, tid4, kv, vv);
    for (int u = u0; u < nunits; u += ustride) {
        sync4(cnt, epoch, lane);
        att_store(lds, tid4, kv, vv);
        sync4(cnt, epoch, lane);
        const int un = u + ustride; AttU nxt = cur; const bool pf = un < nunits;
        if (pf) nxt = att_decode(un % 3072);
        attn_unit4_compute(ws, lds, cur, wave, lane, pf, nxt, tid4, kv, vv);
        cur = nxt;
    }
}
struct AcIn { f32x2 ml[3]; v4u ov[3]; };
__device__ __forceinline__ void attn_combine_load(unsigned char* ws, const int t, const int lane, AcIn& a) {
    const bf16* OP = (const bf16*)(ws + WS_OP); const float* ML = (const float*)(ws + WS_ML);
    const int h = lane >> 3, dg = lane & 7;
#pragma unroll
    for (int G = 0; G < 3; ++G) { const size_t rowi = ((size_t)G * SEQ + t) * NH + h; a.ml[G] = *(const f32x2*)(ML + rowi * 2); a.ov[G] = *(const v4u*)(OP + rowi * 64 + 8 * dg); }
}
__device__ __forceinline__ void attn_combine_finish(unsigned char* ws, const int t, const int lane, const AcIn& a) {
    bf16* MIX = (bf16*)(ws + WS_MIX);
    const int h = lane >> 3, dg = lane & 7;
    const float M = fmaxf(a.ml[0].x, fmaxf(a.ml[1].x, a.ml[2].x));
    float w[3], ws_ = 0.f;
#pragma unroll
    for (int G = 0; G < 3; ++G) { w[G] = a.ml[G].y * __builtin_amdgcn_exp2f(a.ml[G].x - M); ws_ += w[G]; }
    const float inv = 1.0f / ws_;
    float acc[8];
#pragma unroll
    for (int i = 0; i < 8; ++i) acc[i] = 0.f;
#pragma unroll
    for (int G = 0; G < 3; ++G) { const float wg = w[G] * inv;
#pragma unroll
        for (int i = 0; i < 4; ++i) { const unsigned x = a.ov[G][i]; acc[2 * i] += wg * __builtin_bit_cast(float, x << 16); acc[2 * i + 1] += wg * __builtin_bit_cast(float, x & 0xffff0000u); } }
    v4u o; o.x = pk2(acc[0], acc[1]); o.y = pk2(acc[2], acc[3]); o.z = pk2(acc[4], acc[5]); o.w = pk2(acc[6], acc[7]);
    *(v4u*)(MIX + pg8::blk_off(t, h * 64 + 8 * dg, DM)) = o;
}
__device__ __forceinline__ void attn_combine_all(unsigned char* ws, const int gw, const int ngw, const int lane) {
    for (int t = gw; t < SEQ; t += 4 * ngw) {
        const int t1 = t + ngw < SEQ ? t + ngw : t, t2 = t + 2 * ngw < SEQ ? t + 2 * ngw : t, t3 = t + 3 * ngw < SEQ ? t + 3 * ngw : t;
        AcIn a0, a1, a2, a3;
        attn_combine_load(ws, t, lane, a0); attn_combine_load(ws, t1, lane, a1); attn_combine_load(ws, t2, lane, a2); attn_combine_load(ws, t3, lane, a3);
        attn_combine_finish(ws, t, lane, a0); attn_combine_finish(ws, t1, lane, a1); attn_combine_finish(ws, t2, lane, a2); attn_combine_finish(ws, t3, lane, a3);
    }
}
__device__ __forceinline__ void attn_sample_item(const Args& A, unsigned char* ws, const int item, const int lane) {
    const int s = item & 7, h = (item >> 3) & 7, b = item >> 6; const int part = lane & 3, ks = lane >> 2;
    const float* SQ = (const float*)(ws + WS_SQKV); bf16* MIX = (bf16*)(ws + WS_MIX);
    f32x4 qv[4];
#pragma unroll
    for (int i = 0; i < 4; ++i) qv[i] = *(const f32x4*)(SQ + (size_t)(b * 8 + s) * 1536 + h * 64 + 16 * i + 4 * part);
    float m = -1e30f, l = 0.f; f32x4 o[4];
#pragma unroll
    for (int i = 0; i < 4; ++i) o[i] = (f32x4){0.f, 0.f, 0.f, 0.f};
#define SMP_LOAD(RND, KV, VV) do { const int e_ = 16 * (RND) + ks; const int ec_ = e_ < 387 ? e_ : 0; const int G_ = ec_ / 129, j_ = ec_ - 129 * G_; const int idx_ = WBUF + s - (j_ << (2 * G_)); \
        const bool inb_ = idx_ < WBUF; \
        const size_t coff_ = (((size_t)b * WBUF + (inb_ ? idx_ : 0)) * NH + h) * HD + 4 * part, noff_ = (size_t)(b * 8 + (inb_ ? 0 : idx_ - WBUF)) * 1536 + h * 64 + 4 * part; \
        const float* kp_ = inb_ ? A.in[I_CK] + coff_ : SQ + noff_ + 512; const float* vp_ = inb_ ? A.in[I_CV] + coff_ : SQ + noff_ + 1024; \
        if ((RND) >= 17) { _Pragma("unroll") for (int i = 0; i < 4; ++i) { KV[i] = __builtin_nontemporal_load((const f32x4*)(kp_ + 16 * i)); VV[i] = __builtin_nontemporal_load((const f32x4*)(vp_ + 16 * i)); } }     \
        else { _Pragma("unroll") for (int i = 0; i < 4; ++i) { KV[i] = *(const f32x4*)(kp_ + 16 * i); VV[i] = *(const f32x4*)(vp_ + 16 * i); } } } while (0)
    f32x4 kc[4], vc[4], kn[4], vn[4];
    SMP_LOAD(0, kc, vc);
#pragma unroll 1
    for (int rnd = 0; rnd < 25; ++rnd) {
        const int rn = rnd + 1 < 25 ? rnd + 1 : 24;
        SMP_LOAD(rn, kn, vn);
        const bool valid = 16 * rnd + ks < 387;
        float d = 0.f;
#pragma unroll
        for (int i = 0; i < 4; ++i) d += (qv[i].x * kc[i].x + qv[i].y * kc[i].y) + (qv[i].z * kc[i].z + qv[i].w * kc[i].w);
        d += __shfl_xor(d, 1); d += __shfl_xor(d, 2);
        d = valid ? d : -1e30f;
        const float mn = fmaxf(m, d), alpha = __builtin_amdgcn_exp2f(m - mn), p = __builtin_amdgcn_exp2f(d - mn);
        l = l * alpha + p; m = mn;
#pragma unroll
        for (int i = 0; i < 4; ++i) { o[i] = o[i] * alpha + p * vc[i]; kc[i] = kn[i]; vc[i] = vn[i]; }
    }
#undef SMP_LOAD
    float M = m;
#pragma unroll
    for (int off = 4; off < 64; off <<= 1) M = fmaxf(M, __shfl_xor(M, off));
    const float scl = __builtin_amdgcn_exp2f(m - M); l *= scl;
#pragma unroll
    for (int off = 4; off < 64; off <<= 1) l += __shfl_xor(l, off);
    const float inv = 1.0f / l;
#pragma unroll
    for (int i = 0; i < 4; ++i) { f32x4 v = o[i] * scl;
#pragma unroll
        for (int off = 4; off < 64; off <<= 1)
#pragma unroll
            for (int e = 0; e < 4; ++e) v[e] += __shfl_xor(v[e], off);
        if (ks == 0) { v2u w; w.x = pk2(v[0] * inv, v[1] * inv); w.y = pk2(v[2] * inv, v[3] * inv);
            *(v2u*)(MIX + pg8::blk_off(MP + b * 8 + s, h * 64 + 16 * i + 4 * part, DM)) = w; } }
}


template <int SH> __device__ __forceinline__ float dpp_shr_t(float v) {
    return __builtin_bit_cast(float, __builtin_amdgcn_update_dpp(0, __builtin_bit_cast(int, v), 0x110 + SH, 0xf, 0xf, true));
}
template <int ROT> __device__ __forceinline__ float dpp_ror_t(float v) {
    return __builtin_bit_cast(float, __builtin_amdgcn_update_dpp(0, __builtin_bit_cast(int, v), 0x120 + ROT, 0xf, 0xf, false));
}
__device__ __forceinline__ void ssm_pass1_unit(unsigned char* ws, const int grp, const int chunk, const int lane) {
    const int t = lane & 15, g = lane >> 4; const int m0 = chunk * CHUNK;
    const bf16* U = (const bf16*)(ws + WS_U); const unsigned char* T = ws + WS_SSMT;
    const bf16* ABAR = (const bf16*)(T + ST_ABAR); const float* CP = (const float*)(T + ST_CP);
    bf16x8 ub[8];
#pragma unroll
    for (int blk = 0; blk < 8; ++blk) { bf16x8 z = {0, 0, 0, 0, 0, 0, 0, 0}; if (g < 2) z = ld8(U + (size_t)(m0 + 16 * blk + t) * DSSM + 16 * grp + 8 * g); ub[blk] = z; }
#pragma unroll 1
    for (int pr = 0; pr < 4; ++pr) {
        const bf16x8 are = ld8(ABAR + ((size_t)(grp * 8 + 2 * pr) * 64 + lane) * 8), aim = ld8(ABAR + ((size_t)(grp * 8 + 2 * pr + 1) * 64 + lane) * 8);
        const int p0 = 16 * pr + 4 * g;
        float wr_[4], wi_[4], l16r[4], l16i[4], sr[4], si[4];
#pragma unroll
        for (int i = 0; i < 4; ++i) { const float* cp = CP + (size_t)(grp * 64 + p0 + i) * 32;
            const f32x2 w = *(const f32x2*)(cp + 2 * (t == 15 ? 0 : 14 - t)); wr_[i] = (t == 15) ? 1.0f : w.x; wi_[i] = (t == 15) ? 0.0f : w.y;
            const f32x2 l = *(const f32x2*)(cp + 30); l16r[i] = l.x; l16i[i] = l.y; sr[i] = 0.f; si[i] = 0.f; }
#pragma unroll
        for (int blk = 0; blk < 8; ++blk) {
            const f32x4 z4 = {0.f, 0.f, 0.f, 0.f};
            const f32x4 hre = MFMA16(are, ub[blk], z4), him = MFMA16(aim, ub[blk], z4);
#pragma unroll
            for (int i = 0; i < 4; ++i) {
                float pr_ = wr_[i] * hre[i] - wi_[i] * him[i], pi_ = wr_[i] * him[i] + wi_[i] * hre[i];
                pr_ += dpp_ror_t<8>(pr_); pi_ += dpp_ror_t<8>(pi_); pr_ += dpp_ror_t<4>(pr_); pi_ += dpp_ror_t<4>(pi_);
                pr_ += dpp_ror_t<2>(pr_); pi_ += dpp_ror_t<2>(pi_); pr_ += dpp_ror_t<1>(pr_); pi_ += dpp_ror_t<1>(pi_);
                const float nr = l16r[i] * sr[i] - l16i[i] * si[i] + pr_, ni = l16r[i] * si[i] + l16i[i] * sr[i] + pi_; sr[i] = nr; si[i] = ni;
            }
        }
        if (t == 0) { float* CS = (float*)(ws + WS_CS) + ((size_t)(chunk * NG + grp) * NP + p0) * 2;
            *(f32x4*)CS = (f32x4){sr[0], si[0], sr[1], si[1]}; *(f32x4*)(CS + 4) = (f32x4){sr[2], si[2], sr[3], si[3]}; }
    }
}
template <bool PASS2, bool SAMPLE, int NBLK>
__device__ __forceinline__ void ssm_unit(const Args& A, unsigned char* ws, const int grp, const int chunk, const LAS float* carr, const int lane) {
    const int t = lane & 15, g = lane >> 4, tt = SAMPLE ? (t & 7) : t;
    const int m0 = SAMPLE ? MP + chunk * (16 * NBLK) : chunk * (16 * NBLK);
    const bf16* U = (const bf16*)(ws + WS_U); bf16* GB = (bf16*)(ws + WS_GB);
    const unsigned char* T = ws + WS_SSMT;
    const bf16* ABAR = (const bf16*)(T + ST_ABAR); const bf16* CMt = (const bf16*)(T + ST_CM);
    const float* PW = (const float*)(T + ST_PW); const float* CP = (const float*)(T + ST_CP);
    bf16x8 ub[NBLK];
#pragma unroll
    for (int blk = 0; blk < NBLK; ++blk) { bf16x8 z = {0, 0, 0, 0, 0, 0, 0, 0}; if (g < 2) z = ld8(U + (size_t)(m0 + 16 * blk + t) * DSSM + 16 * grp + 8 * g); ub[blk] = z; }
    f32x4 yacc[NBLK];
#pragma unroll
    for (int blk = 0; blk < NBLK; ++blk) yacc[blk] = (f32x4){0.f, 0.f, 0.f, 0.f};
#pragma unroll 1
    for (int pr = 0; pr < 4; ++pr) {
        const bf16x8 are = ld8(ABAR + ((size_t)(grp * 8 + 2 * pr) * 64 + lane) * 8), aim = ld8(ABAR + ((size_t)(grp * 8 + 2 * pr + 1) * 64 + lane) * 8);
        bf16x8 cm = {0, 0, 0, 0, 0, 0, 0, 0}; if (PASS2) cm = ld8(CMt + ((size_t)(grp * 4 + pr) * 64 + lane) * 8);
        const int p0 = 16 * pr + 4 * g;
        float pwr[4][4], pwi[4][4], cpr[4], cpi[4];
#pragma unroll
        for (int i = 0; i < 4; ++i) { const f32x4 a = *(const f32x4*)(PW + (size_t)(grp * 64 + p0 + i) * 8), b = *(const f32x4*)(PW + (size_t)(grp * 64 + p0 + i) * 8 + 4);
            pwr[i][0] = a.x; pwi[i][0] = a.y; pwr[i][1] = a.z; pwi[i][1] = a.w; pwr[i][2] = b.x; pwi[i][2] = b.y; pwr[i][3] = b.z; pwi[i][3] = b.w;
            const f32x2 c = *(const f32x2*)(CP + (size_t)(grp * 64 + p0 + i) * 32 + 2 * tt); cpr[i] = c.x; cpi[i] = c.y; }
        float cre[4], cim[4];
#pragma unroll
        for (int i = 0; i < 4; ++i) { cre[i] = 0.f; cim[i] = 0.f; }
        if (!SAMPLE && PASS2) {
#pragma unroll
            for (int i = 0; i < 4; ++i) { const f32x2 c = *(const LAS f32x2*)(carr + (size_t)(chunk * 64 + p0 + i) * 2); cre[i] = c.x; cim[i] = c.y; }
        }
#pragma unroll
        for (int blk = 0; blk < NBLK; ++blk) {
            int bsm = 0;
            if (SAMPLE) { bsm = ((m0 - MP + 16 * blk) >> 3) + (t >> 3);
                const f32x4 hr = *(const f32x4*)(A.in[I_SRE] + (size_t)(bsm * NG + grp) * NP + p0), hi = *(const f32x4*)(A.in[I_SIM] + (size_t)(bsm * NG + grp) * NP + p0);
#pragma unroll
                for (int i = 0; i < 4; ++i) { cre[i] = hr[i]; cim[i] = hi[i]; } }
            const f32x4 z4 = {0.f, 0.f, 0.f, 0.f};
            f32x4 hre = MFMA16(are, ub[blk], z4), him = MFMA16(aim, ub[blk], z4);
#define SSM_STEP(K_, SH_) { const bool keep = !SAMPLE || (tt >= SH_); \
                _Pragma("unroll") for (int i = 0; i < 4; ++i) { float sr = dpp_shr_t<SH_>(hre[i]), si = dpp_shr_t<SH_>(him[i]); if (!keep) { sr = 0.f; si = 0.f; } \
                    const float nr = hre[i] + pwr[i][K_] * sr - pwi[i][K_] * si, ni = him[i] + pwr[i][K_] * si + pwi[i][K_] * sr; hre[i] = nr; him[i] = ni; } }
            SSM_STEP(0, 1) SSM_STEP(1, 2) SSM_STEP(2, 4)
            if (!SAMPLE) SSM_STEP(3, 8)
#undef SSM_STEP
#pragma unroll
            for (int i = 0; i < 4; ++i) { const float nr = hre[i] + cpr[i] * cre[i] - cpi[i] * cim[i], ni = him[i] + cpr[i] * cim[i] + cpi[i] * cre[i]; hre[i] = nr; him[i] = ni; }
            if (!SAMPLE) {
#pragma unroll
                for (int i = 0; i < 4; ++i) { cre[i] = __shfl(hre[i], (lane & 48) | 15); cim[i] = __shfl(him[i], (lane & 48) | 15); }
            } else if (tt == 7) {
                *(f32x4*)(A.out + O_HRS + (size_t)(bsm * NG + grp) * NP + p0) = hre; *(f32x4*)(A.out + O_HIS + (size_t)(bsm * NG + grp) * NP + p0) = him;
            }
            if (PASS2) { v4u hw; hw.x = pk2(hre[0], hre[1]); hw.y = pk2(hre[2], hre[3]); hw.z = pk2(him[0], him[1]); hw.w = pk2(him[2], him[3]);
                yacc[blk] = MFMA16(cm, __builtin_bit_cast(bf16x8, hw), yacc[blk]); }
        }
        if (!PASS2 && !SAMPLE && t == 15) {
            float* CS = (float*)(ws + WS_CS) + ((size_t)(chunk * NG + grp) * NP + p0) * 2;
            *(f32x4*)CS = (f32x4){cre[0], cim[0], cre[1], cim[1]}; *(f32x4*)(CS + 4) = (f32x4){cre[2], cim[2], cre[3], cim[3]};
        }
    }
    if (PASS2) {
        const f32x4 dv = *(const f32x4*)(A.in[I_SD] + 16 * grp + 4 * g);
#pragma unroll
        for (int blk = 0; blk < NBLK; ++blk) { const size_t off = (size_t)(m0 + 16 * blk + t) * DSSM + 16 * grp + 4 * g;
            const v2u uw = *(const v2u*)(U + off);
            const float u0 = __builtin_bit_cast(float, uw.x << 16), u1 = __builtin_bit_cast(float, uw.x & 0xffff0000u), u2 = __builtin_bit_cast(float, uw.y << 16), u3 = __builtin_bit_cast(float, uw.y & 0xffff0000u);
            const float y0 = gelu_tanh(yacc[blk][0] + dv[0] * u0), y1 = gelu_tanh(yacc[blk][1] + dv[1] * u1), y2 = gelu_tanh(yacc[blk][2] + dv[2] * u2), y3 = gelu_tanh(yacc[blk][3] + dv[3] * u3);
            v2u w; w.x = pk2(y0, y1); w.y = pk2(y2, y3); *(v2u*)(GB + pg8::blk_off(m0 + 16 * blk + t, 16 * grp + 4 * g, DSSM)) = w; }
    }
}

constexpr int N_PHASES = 15;
__global__ void __launch_bounds__(NWAVES * 64, 2) hymba_fwd(Args args) {
    extern __shared__ __attribute__((aligned(16))) unsigned char lds[];
    Frame F;
    F.lds = (LAS unsigned char*)lds;
    F.MISC = (volatile LAS unsigned*)(F.lds + MISC_OFF);
    F.tid = threadIdx.x; F.lane = F.tid & 63; F.wave = __builtin_amdgcn_readfirstlane(F.tid >> 6);
    F.G = gridDim.x; { const int bx = blockIdx.x; F.vcu = (F.G % 8 == 0) ? (bx % 8) * (F.G / 8) + bx / 8 : bx; }
    unsigned char* ws = args.ws;
    F.ctl = (gu32*)(ws + WS_CTL);
    for (int u = F.tid; u < (LDS_BYTES - LDSCTL_OFF) / 4; u += NWAVES * 64) ((LAS unsigned*)(F.lds + LDSCTL_OFF))[u] = 0u;
    __syncthreads();
    XcdBarrier bar = xcd_barrier_post((unsigned*)(F.ctl + CW_BAR), F.MISC + 8);
    const int lo = args.ph_lo, hi = args.ph_hi;
#ifndef PHASE_MASK
#define PHASE_MASK 0x7fff
#endif
#define IN(k) (((PHASE_MASK >> (k)) & 1) && lo <= (k) && (k) < hi)
#define SEAM(k) do { if (IN(k) && IN((k) + 1)) xcd_barrier(bar); } while (0)
#ifndef REPEAT_MASK
#define REPEAT_MASK 0
#endif
#define REP(k) for (int rep_ = 0; rep_ <= ((REPEAT_MASK >> (k)) & 1); ++rep_, ((rep_ <= ((REPEAT_MASK >> (k)) & 1)) ? xcd_barrier(bar) : (void)0))
    bf16* XN = (bf16*)(ws + WS_XN); bf16* HB = (bf16*)(ws + WS_H); float* X1 = (float*)(ws + WS_X1); float* X2 = (float*)(ws + WS_X2);
    float* ADA = (float*)(ws + WS_ADA); float* SLAB = (float*)(ws + WS_SLAB);
    const int gw = F.vcu * NWAVES + F.wave, NGW = F.G * NWAVES;
    const bool fastcopy = (F.G == 256);
    pg8::CopyJob CJ; { const int seg = (int)blockIdx.x & 255, kv = seg >> 7, b = seg & 127; const size_t eo = ((size_t)b * (WBUF * DATT)) * 4 + (size_t)F.wave * 1024;
        CJ.src = (const char*)args.in[kv ? I_CV : I_CK] + (size_t)DSEQ * DATT * 4 + eo; CJ.dst = (char*)(args.out + (kv ? O_VS : O_KS)) + eo; CJ.cur = 0; CJ.end = (fastcopy && !args.nocopy) ? 510 : 0; CJ.dummy = (unsigned*)(F.ctl + 2048 + 64 * F.wave); }

    if (IN(0)) REP(0) if ((F.lane = (int)__builtin_amdgcn_mbcnt_hi(~0u, __builtin_amdgcn_mbcnt_lo(~0u, 0u)), F.tid = F.wave * 64 + F.lane, true)) { p0_prologue(F, args); }
    SEAM(0);
    if (IN(1)) REP(1) if ((F.lane = (int)__builtin_amdgcn_mbcnt_hi(~0u, __builtin_amdgcn_mbcnt_lo(~0u, 0u)), F.tid = F.wave * 64 + F.lane, true)) {
        pg8::Gemm g{(const bf16*)(ws + WS_SC), (const bf16*)(ws + WS_WADA), 256, NADA, DM}; pg8::Order2 S; S.init(256, NADA, DM, F.G, (int)blockIdx.x);
        pg8::EpiF32 E{ADA, NADA, args.in[I_BADA]};
        pg8::gemm_phase2<pg8::EpiF32, pg8::Order2, true, false>(F.lds + RING_OFF, g, S, E, CJ, F.wave);
        const int nun = NADA / 256;
        const int nworker = (F.G > nun) ? (F.G - nun) : F.G, widx = (F.G > nun) ? ((int)blockIdx.x - nun) : (int)blockIdx.x;
        if (widx >= 0) p1_weights(F, args, widx * NWAVES + F.wave, nworker * NWAVES);
        if (!fastcopy && widx >= 0) copy_tiles(args, widx * NWAVES + F.wave, nworker * NWAVES, F.lane);
    }
    SEAM(1);
    if (IN(2)) REP(2) if ((F.lane = (int)__builtin_amdgcn_mbcnt_hi(~0u, __builtin_amdgcn_mbcnt_lo(~0u, 0u)), F.tid = F.wave * 64 + F.lane, true)) norm_mod_rows<true, 0, 8, false>(F, args.in[I_XP], args.in[I_XS], args.in[I_GF1], ADA, 0 * DM, 1 * DM, XN, Combine{nullptr, 0, nullptr, 0, 0.f, nullptr}, ws + WS_XN8, (float*)(ws + WS_SA));
    SEAM(2);
    if (IN(3)) REP(3) if ((F.lane = (int)__builtin_amdgcn_mbcnt_hi(~0u, __builtin_amdgcn_mbcnt_lo(~0u, 0u)), F.tid = F.wave * 64 + F.lane, true)) {
        pg8::Gemm g{(const bf16*)(ws + WS_XN8), (const bf16*)(ws + WS_W1T8), MTOT, 2 * DFF, DM / 2}; pg8::Order2 S; S.init(MTOT, 2 * DFF, DM / 2, F.G, (int)blockIdx.x);
        pg8::EpiGated8 E{HB, DFF, (const float*)(ws + WS_SA), (const unsigned*)(ws + WS_CTL) + CW_AMAX};
        pg8::gemm_phase2<pg8::EpiGated8, pg8::Order2, true, true, true>(F.lds + RING_OFF, g, S, E, CJ, F.wave);
    }
    SEAM(3);
    if (IN(4)) REP(4) if ((F.lane = (int)__builtin_amdgcn_mbcnt_hi(~0u, __builtin_amdgcn_mbcnt_lo(~0u, 0u)), F.tid = F.wave * 64 + F.lane, true)) {
        pg8::Gemm g{HB, (const bf16*)(ws + WS_W1D), MTOT, DM, DFF}; pg8::SplitOrder S; S.init(MP, DM, DFF, 11, F.G, (int)blockIdx.x);
        pg8::EpiResid<false, true> E{args.in[I_XP], args.in[I_XS], X1, ADA, 2 * DM, 0.5f, SLAB};
        pg8::gemm_phase2<pg8::EpiResid<false, true>, pg8::SplitOrder, true, true>(F.lds + RING_OFF, g, S, E, CJ, F.wave);
    }
    SEAM(4);
    if (IN(5)) REP(5) if ((F.lane = (int)__builtin_amdgcn_mbcnt_hi(~0u, __builtin_amdgcn_mbcnt_lo(~0u, 0u)), F.tid = F.wave * 64 + F.lane, true)) norm_mod_rows<false, 11, 4, true>(F, X1, X1 + (size_t)MP * DM, args.in[I_GMIX], ADA, 3 * DM, 4 * DM, XN, Combine{SLAB, 11, args.in[I_XS], 2 * DM, 0.5f, X1 + (size_t)MP * DM}, nullptr, nullptr);
    SEAM(5);
    if (IN(6)) REP(6) if ((F.lane = (int)__builtin_amdgcn_mbcnt_hi(~0u, __builtin_amdgcn_mbcnt_lo(~0u, 0u)), F.tid = F.wave * 64 + F.lane, true)) {
        pg8::Gemm g{XN, (const bf16*)(ws + WS_WIN), MTOT, 2048, DM}; pg8::Order2 S; S.init(MTOT, 2048, DM, F.G, (int)blockIdx.x);
        pg8::EpiInProj E{(bf16*)(ws + WS_Q), (bf16*)(ws + WS_K), (bf16*)(ws + WS_VT), (bf16*)(ws + WS_U), (float*)(ws + WS_SQKV), args.out, (const _Float16*)(ws + WS_ROPE), args.in[I_GQ], args.in[I_GK]};
        pg8::gemm_phase2<pg8::EpiInProj, pg8::Order2, true, true>(F.lds + RING_OFF, g, S, E, CJ, F.wave);
    }
    SEAM(6);
    if (IN(7)) REP(7) if ((F.lane = (int)__builtin_amdgcn_mbcnt_hi(~0u, __builtin_amdgcn_mbcnt_lo(~0u, 0u)), F.tid = F.wave * 64 + F.lane, true)) {
#ifndef P7R1
#define P7R1 0
#endif
#ifndef P7R2
#define P7R2 0
#endif
#ifndef P7R3
#define P7R3 0
#endif
#ifndef P7_PARTS
#define P7_PARTS 7
#endif
        const int p7m = args.pad ? args.pad : P7_PARTS;
        { const int hw = F.vcu * 4 + (F.wave & 3), NHW = F.G * 4;
          if (F.wave < 4) {
              unsigned epoch = 0u; LAS unsigned* cnt = (LAS unsigned*)(F.MISC + 16);
              if (p7m & 1) attn_units4(ws, F.lds + RING_OFF, cnt, epoch, F.vcu, F.G, 3072 * (1 + P7R1), F.tid, F.wave, F.lane);
              if (p7m & 2) for (int u = hw; u < NCHUNK_P * NG * (1 + P7R2); u += NHW) ssm_pass1_unit(ws, u & 31, (u >> 5) & 127, F.lane);
          } else { __builtin_amdgcn_s_setprio(3);
              if (p7m & 4) for (int a = hw; a < NBAT * NH * DSEQ * (1 + P7R3); a += NHW) attn_sample_item(args, ws, a & 8191, F.lane);
              __builtin_amdgcn_s_setprio(0); } }
    }
    SEAM(7);
    if (IN(8)) REP(8) if ((F.lane = (int)__builtin_amdgcn_mbcnt_hi(~0u, __builtin_amdgcn_mbcnt_lo(~0u, 0u)), F.tid = F.wave * 64 + F.lane, true)) {
        attn_combine_all(ws, gw, NGW, F.lane);
        LAS float* carr = (LAS float*)(F.lds + RING_OFF);
        LAS float* segE = carr + NCHUNK_P * 64 * 2;
        for (int item = F.vcu; item < 256; item += F.G) {
            const int grp = item & 31, sub = item >> 5;
            {
                const float* CS = (const float*)(ws + WS_CS); const float* CL = (const float*)(ws + WS_SSMT + ST_CL);
                const f32x2 lam = *(const f32x2*)(CL + (size_t)(grp * 64 + F.lane) * 2);
                f32x2 sv[16];
#pragma unroll
                for (int j = 0; j < 16; ++j) sv[j] = *(const f32x2*)(CS + ((size_t)((16 * F.wave + j) * NG + grp) * NP + F.lane) * 2);
                float lr[16], li[16]; float cr = 0.f, ci = 0.f;
#pragma unroll
                for (int j = 0; j < 16; ++j) { lr[j] = cr; li[j] = ci; const float nr = lam.x * cr - lam.y * ci + sv[j].x, ni = lam.x * ci + lam.y * cr + sv[j].y; cr = nr; ci = ni; }
                *(LAS f32x2*)(segE + (size_t)(F.wave * 64 + F.lane) * 2) = (f32x2){cr, ci};
                float sr = lam.x, si = lam.y;
#pragma unroll
                for (int q = 0; q < 4; ++q) { const float nr = sr * sr - si * si, ni = 2.f * sr * si; sr = nr; si = ni; }
                LDS_WAIT(); __syncthreads();
                float Cr = 0.f, Ci = 0.f;
                float Tr = 0.f, Ti = 0.f;
#pragma unroll
                for (int w = 0; w < 8; ++w) { const f32x2 e = *(const LAS f32x2*)(segE + (size_t)(w * 64 + F.lane) * 2);
                    if (w == F.wave) { Cr = Tr; Ci = Ti; }
                    const float nr = sr * Tr - si * Ti + e.x, ni = sr * Ti + si * Tr + e.y; Tr = nr; Ti = ni; }
                float pr_ = 1.f, pi_ = 0.f;
#pragma unroll
                for (int j = 0; j < 16; ++j) { const float ar_ = lr[j] + pr_ * Cr - pi_ * Ci, ai_ = li[j] + pr_ * Ci + pi_ * Cr;
                    *(LAS f32x2*)(carr + (size_t)((16 * F.wave + j) * 64 + F.lane) * 2) = (f32x2){ar_, ai_};
                    const float nr = pr_ * lam.x - pi_ * lam.y, ni = pr_ * lam.y + pi_ * lam.x; pr_ = nr; pi_ = ni; }
                if (sub == 0 && F.wave == 0) { args.out[O_HRP + grp * 64 + F.lane] = Tr; args.out[O_HIP + grp * 64 + F.lane] = Ti; }
                LDS_WAIT(); __syncthreads();
            }
            for (int k = F.wave; k < 16; k += NWAVES) { ssm_unit<true, false, 8>(args, ws, grp, sub + 8 * k, carr, F.lane); copy_back(CJ, 32, F.lane); }
            ssm_unit<true, true, 1>(args, ws, grp, sub + 8 * F.wave, nullptr, F.lane);
            copy_back(CJ, 24, F.lane);
            __syncthreads();
        }
    }
    SEAM(8);
    if (IN(9)) REP(9) if ((F.lane = (int)__builtin_amdgcn_mbcnt_hi(~0u, __builtin_amdgcn_mbcnt_lo(~0u, 0u)), F.tid = F.wave * 64 + F.lane, true)) {
        pg8::Gemm g{(const bf16*)(ws + WS_GB), (const bf16*)(ws + WS_WGLU), MTOT, 1024, DSSM}; pg8::Order2 S; S.init(MTOT, 1024, DSSM, F.G, (int)blockIdx.x);
        pg8::EpiGated<1> E{(bf16*)(ws + WS_MIX), DM, DATT};
        pg8::gemm_phase2<pg8::EpiGated<1>, pg8::Order2, true, false>(F.lds + RING_OFF, g, S, E, CJ, F.wave);
    }
    SEAM(9);
    if (IN(10)) REP(10) if ((F.lane = (int)__builtin_amdgcn_mbcnt_hi(~0u, __builtin_amdgcn_mbcnt_lo(~0u, 0u)), F.tid = F.wave * 64 + F.lane, true)) {
        pg8::Gemm g{(const bf16*)(ws + WS_MIX), (const bf16*)(ws + WS_WOUT), MTOT, DM, DM}; pg8::SplitOrder S; S.init(MP, DM, DM, 4, F.G, (int)blockIdx.x);
        pg8::EpiResid<true, true> E{X1, X1 + (size_t)MP * DM, X2, ADA, 5 * DM, 1.0f, SLAB};
        pg8::gemm_phase2<pg8::EpiResid<true, true>, pg8::SplitOrder, true, true>(F.lds + RING_OFF, g, S, E, CJ, F.wave);
    }
    SEAM(10);
    if (IN(11)) REP(11) if ((F.lane = (int)__builtin_amdgcn_mbcnt_hi(~0u, __builtin_amdgcn_mbcnt_lo(~0u, 0u)), F.tid = F.wave * 64 + F.lane, true)) norm_mod_rows<true, 4, 5, true>(F, X2, X2 + (size_t)MP * DM, args.in[I_GF2], ADA, 6 * DM, 7 * DM, XN, Combine{SLAB, 4, X1 + (size_t)MP * DM, 5 * DM, 1.0f, X2 + (size_t)MP * DM}, ws + WS_XN8, (float*)(ws + WS_SA));
    SEAM(11);
    if (IN(12)) REP(12) if ((F.lane = (int)__builtin_amdgcn_mbcnt_hi(~0u, __builtin_amdgcn_mbcnt_lo(~0u, 0u)), F.tid = F.wave * 64 + F.lane, true)) {
        pg8::Gemm g{(const bf16*)(ws + WS_XN8), (const bf16*)(ws + WS_W2T8), MTOT, 2 * DFF, DM / 2}; pg8::Order2 S; S.init(MTOT, 2 * DFF, DM / 2, F.G, (int)blockIdx.x);
        pg8::EpiGated8 E{HB, DFF, (const float*)(ws + WS_SA), (const unsigned*)(ws + WS_CTL) + CW_AMAX + 2};
        pg8::gemm_phase2<pg8::EpiGated8, pg8::Order2, true, false, true>(F.lds + RING_OFF, g, S, E, CJ, F.wave);
    }
    SEAM(12);
    if (IN(13)) REP(13) if ((F.lane = (int)__builtin_amdgcn_mbcnt_hi(~0u, __builtin_amdgcn_mbcnt_lo(~0u, 0u)), F.tid = F.wave * 64 + F.lane, true)) {
        pg8::Gemm g{HB, (const bf16*)(ws + WS_W2D), MTOT, DM, DFF}; pg8::SplitOrder S; S.init(MP, DM, DFF, 11, F.G, (int)blockIdx.x);
        pg8::EpiResid<true, false> E{X2, X2 + (size_t)MP * DM, args.out, ADA, 8 * DM, 0.5f, SLAB};
        pg8::gemm_phase2<pg8::EpiResid<true, false>, pg8::SplitOrder, true, true>(F.lds + RING_OFF, g, S, E, CJ, F.wave);
        copy_back(CJ, 1 << 20, F.lane);
    }
    SEAM(13);
    if (IN(14)) { F.lane = (int)__builtin_amdgcn_mbcnt_hi(~0u, __builtin_amdgcn_mbcnt_lo(~0u, 0u)); F.tid = F.wave * 64 + F.lane;
        const Combine C{SLAB, 11, X2 + (size_t)MP * DM, 8 * DM, 0.5f, args.out + O_YS};
        for (int u = gw; u < 2 * MS; u += NGW) { const int ms = u >> 1, j0 = (u & 1) * 2; const float* ar = ADA + (size_t)ada_row(MP + ms) * NADA;
            (void)combine_chunk<11>(C, ar, ms, F.lane, j0); (void)combine_chunk<11>(C, ar, ms, F.lane, j0 + 1); }
    }
#undef IN
#undef SEAM
}

#ifndef MK_N_LAUNCHES
#define MK_N_LAUNCHES 1
#endif
extern "C" void kernel_launch(void* const* d_in, const int* in_sizes, int n_in, void* d_out, int out_size, void* d_ws, size_t ws_size, hipStream_t stream) {
    static int grid = 0;
    if (grid == 0) {
        if (n_in != 32 || (size_t)out_size != O_END || ws_size < WS_END) { fprintf(stderr, "kernel_launch: unexpected shapes (n_in %d out %d ws %zu)\n", n_in, out_size, ws_size); grid = -1; return; }
        int dev = 0, cus = 0, per_cu = 0;
        if (hipGetDevice(&dev) != hipSuccess || hipDeviceGetAttribute(&cus, hipDeviceAttributeMultiprocessorCount, dev) != hipSuccess) { grid = -1; return; }
        if (hipFuncSetAttribute((const void*)hymba_fwd, hipFuncAttributeMaxDynamicSharedMemorySize, LDS_BYTES) != hipSuccess) { fprintf(stderr, "kernel_launch: hipFuncSetAttribute failed\n"); grid = -1; return; }
        if (hipOccupancyMaxActiveBlocksPerMultiprocessor(&per_cu, (const void*)hymba_fwd, NWAVES * 64, LDS_BYTES) != hipSuccess || per_cu < 1)
            fprintf(stderr, "kernel_launch: note: occupancy query reports %d workgroups per CU\n", per_cu);
        (void)hipGetLastError();
        grid = cus;
    }
    if (grid < 0) return;
    if (hipMemsetAsync((char*)d_ws + WS_CTL, 0, CTL_ZERO_BYTES, stream) != hipSuccess) return;
    Args a{};
    for (int i = 0; i < 32; ++i) a.in[i] = (const float*)d_in[i];
    a.out = (float*)d_out; a.ws = (unsigned char*)d_ws;
#if MK_N_LAUNCHES == 1
    a.ph_lo = 0; a.ph_hi = N_PHASES;
    hipLaunchKernelGGL(hymba_fwd, dim3(grid), dim3(NWAVES * 64), LDS_BYTES, stream, a);
#ifdef PROBE_LIST
    { const int pl[] = PROBE_LIST; for (int p : pl) { a.ph_lo = p % 100; a.ph_hi = p % 100 + 1; a.nocopy = (p % 1000) >= 100; a.pad = p / 1000; hipLaunchKernelGGL(hymba_fwd, dim3(grid), dim3(NWAVES * 64), LDS_BYTES, stream, a); } }
#endif
#else
    for (int p = 0; p < N_PHASES; ++p) { a.ph_lo = p; a.ph_hi = p + 1; hipLaunchKernelGGL(hymba_fwd, dim3(grid), dim3(NWAVES * 64), LDS_BYTES, stream, a); }
#endif
}
```

```cpp
#include <hip/hip_runtime.h>
#include <cstdio>
#include <cstdint>
namespace pg8 {
#define PG8_LAS __attribute__((address_space(3)))
typedef unsigned short bf16_t;
typedef short bf16x8 __attribute__((ext_vector_type(8)));
typedef float f32x4 __attribute__((ext_vector_type(4)));
typedef unsigned u32x4 __attribute__((ext_vector_type(4)));
constexpr int BM = 256, BK = 64, HALF = 128, HTB = HALF * BK * 2  , STAGE_BYTES = 8 * HTB, NXCD = 8, WGM = 8;

__host__ __device__ __forceinline__ int lds_byte(int r, int c) { const int st = (r >> 4) * 2 + (c >> 5), rr = r & 15, cc = c & 31, ob = rr * 64 + cc * 2; return st * 1024 + (ob ^ (((ob >> 9) & 1) << 5)); }
__host__ __device__ __forceinline__ void stage_rc(int b, int& R, int& C) { const int st = b / 1024, sb = b % 1024, swz = sb ^ (((sb >> 9) & 1) << 5); R = (st >> 1) * 16 + swz / 64; C = (st & 1) * 32 + (swz % 64) / 2; }
__host__ __device__ __forceinline__ int perm32(int rho) { const int n = rho >> 4, i = rho & 15; return 8 * (i >> 2) + 4 * n + (i & 3); }

__host__ __device__ __forceinline__ size_t blk_off(int row, int col, int K) { return ((size_t)(row >> 8) * (size_t)(K >> 6) + (size_t)(col >> 6)) * 16384 + (size_t)((row & 255) * 64 + (col & 63)); }
__host__ __device__ __forceinline__ size_t blk_byte(int row, int bcol, int Kbytes) { return ((size_t)(row >> 8) * (size_t)(Kbytes >> 7) + (size_t)(bcol >> 7)) * 32768 + (size_t)((row & 255) * 128 + (bcol & 127)); }
struct Unit { int pm, pn; };
struct Gemm { const bf16_t* A; const bf16_t* Bt; int M, N, K; };

struct StaticOrder {
    int nM, nN, nwg, G, c;
    __host__ __device__ void init(int M, int N, int G_, int c_) { nM = M / BM; nN = N / BM; nwg = nM * nN; G = G_; c = c_; }
    __host__ __device__ bool next(int i, Unit& u) const {
        const long L = (long)i * G + c; if (L >= nwg) return false;
        int wgid = (int)L; { const int q = nwg / NXCD, r = nwg % NXCD, xcd = wgid % NXCD, off = wgid / NXCD; wgid = (xcd < r ? xcd * (q + 1) : r * (q + 1) + (xcd - r) * q) + off; }
        const int nig = WGM * nN, gid = wgid / nig, fm = gid * WGM, gsz = (nM - fm) < WGM ? (nM - fm) : WGM;
        u.pm = fm + ((wgid % nig) % gsz); u.pn = (wgid % nig) / gsz; return true;
    }
    __device__ __forceinline__ void a_ready(const Unit&) const {}
    __device__ __forceinline__ void done(const Unit&) const {}
};

__device__ __forceinline__ unsigned cvt_pk_bf16(float lo, float hi) { unsigned r; asm volatile("v_cvt_pk_bf16_f32 %0, %1, %2" : "=v"(r) : "v"(lo), "v"(hi)); return r; }
typedef float f32x2 __attribute__((ext_vector_type(2)));
typedef unsigned u32x2v __attribute__((ext_vector_type(2)));
constexpr int CP_STAGE_OFF = STAGE_BYTES;
constexpr int CP_STRIDE = 8192;
struct CopyJob { const char* src; char* dst; int cur, end; unsigned* dummy; };
struct Unit2 { int pm, pn, k0, nt, split; };
typedef int i32x4 __attribute__((ext_vector_type(4)));
template <bool I8> struct AccSel { typedef f32x4 type; };
template <> struct AccSel<true> { typedef i32x4 type; };
template <class Epi, class Sched, bool ALIGN_EPI, bool COPY, bool I8 = false>
__device__ __forceinline__ void gemm_phase2(PG8_LAS unsigned char* lds, const Gemm g, const Sched& S, const Epi& E, CopyJob& C, const int wid  ) {
    const int lane = (int)__builtin_amdgcn_mbcnt_hi(~0u, __builtin_amdgcn_mbcnt_lo(~0u, 0u)), tid = wid * 64 + lane,
              wr = wid >> 2, wc = wid & 3, fr = lane & 15, fq = lane >> 4;
    const int K = g.K;
    unsigned voffA[2], voffB[2];
#pragma unroll
    for (int i = 0; i < 2; ++i) { int R, Cc; stage_rc(tid * 16 + i * 8192, R, Cc); const int Rb = Epi::PERM ? ((R & ~31) + perm32(R & 31)) : R;
        voffA[i] = (unsigned)(R * 64 + Cc) * 2u; voffB[i] = (unsigned)(Rb * 64 + Cc) * 2u; }
    const size_t kstep = (size_t)32768;
    const size_t hstep = (size_t)HALF * 64 * 2;
    const size_t tstep = (size_t)(K / BK) * kstep;
    const unsigned ldsw = (unsigned)wid * 1024u;
    const int aoff = lds_byte(wr * 64 + fr, fq * 8), boff = lds_byte(wc * 32 + fr, fq * 8);
#define PG8_SA(b, h) (((b) * 2 + (h)) * HTB)
#define PG8_SB(b, h) ((4 + (b) * 2 + (h)) * HTB)
#define PG8_STAGE(bufoff, gbase, voff) do { _Pragma("unroll") for (int _i = 0; _i < 2; ++_i) \
        __builtin_amdgcn_global_load_lds((const unsigned*)((const char*)(gbase) + (voff)[_i]), (PG8_LAS unsigned*)(lds + (bufoff) + ldsw + _i * 8192), 16, 0, 0); } while (0)
#define PG8_LDA(dst, b, h) do { _Pragma("unroll") for (int m = 0; m < 4; ++m) _Pragma("unroll") for (int k = 0; k < 2; ++k) dst[m][k] = *(const PG8_LAS bf16x8*)(lds + PG8_SA(b, h) + aoff + m * 2048 + k * 1024); } while (0)
#define PG8_LDB(dst, b, h) do { _Pragma("unroll") for (int n = 0; n < 2; ++n) _Pragma("unroll") for (int k = 0; k < 2; ++k) dst[n][k] = *(const PG8_LAS bf16x8*)(lds + PG8_SB(b, h) + boff + n * 2048 + k * 1024); } while (0)
#define PG8_MMA(ai, bj, At, Bt) do { __builtin_amdgcn_s_setprio(1); _Pragma("unroll") for (int m = 0; m < 4; ++m) _Pragma("unroll") for (int n = 0; n < 2; ++n) _Pragma("unroll") for (int k = 0; k < 2; ++k) \
        { if constexpr (I8) acc[ai][bj][m][n] = __builtin_amdgcn_mfma_i32_16x16x64_i8(__builtin_bit_cast(i32x4, Bt[n][k]), __builtin_bit_cast(i32x4, At[m][k]), acc[ai][bj][m][n], 0, 0, 0); \
          else acc[ai][bj][m][n] = __builtin_amdgcn_mfma_f32_16x16x32_bf16(Bt[n][k], At[m][k], acc[ai][bj][m][n], 0, 0, 0); } __builtin_amdgcn_s_setprio(0); } while (0)
#define PG8_WAIT_V(n) asm volatile("s_waitcnt vmcnt(" #n ")" ::: "memory")
#define PG8_WAIT_LOOP() do { if constexpr (COPY) asm volatile("s_waitcnt vmcnt(13)" ::: "memory"); else asm volatile("s_waitcnt vmcnt(8)" ::: "memory"); } while (0)
#define PG8_WAIT_L(n) asm volatile("s_waitcnt lgkmcnt(" #n ")" ::: "memory")
#define PG8_BAR __builtin_amdgcn_s_barrier()
#define PG8_SCHED __builtin_amdgcn_sched_barrier(0)
    typedef unsigned cp4 __attribute__((ext_vector_type(4)));
    const unsigned cp_voff = (unsigned)lane * 16u;
    int cp_n = 0, cp_sl = 0;
    const int cp_base = C.cur, cp_cnt = C.end - C.cur;
    const char* cp_s = C.src + (size_t)cp_base * CP_STRIDE; char* cp_d = C.dst + ((size_t)cp_base - 4) * CP_STRIDE;
    PG8_LAS unsigned char* const cp_stage = lds + CP_STAGE_OFF + wid * 3072;
    cp4 cp_r = {0u, 0u, 0u, 0u};
#define CP_STORE() do { if constexpr (COPY) { \
        if (cp_n >= 4 && cp_n - 4 < cp_cnt) __builtin_nontemporal_store(cp_r, (cp4*)(cp_d + cp_voff)); else C.dummy[lane] = cp_r.x; } } while (0)
#define CP_READ() do { if constexpr (COPY) { const unsigned la_ = (unsigned)(unsigned long)(cp_stage + cp_sl * 1024) + cp_voff; \
        asm volatile("ds_read_b128 %0, %1" : "=v"(cp_r) : "v"(la_) : "memory"); } } while (0)
#define CP_ISSUE() do { if constexpr (COPY) { asm volatile("s_waitcnt lgkmcnt(0)" ::: "memory"); \
        const char* sp_ = (cp_n < cp_cnt) ? cp_s : (const char*)C.src; \
        __builtin_amdgcn_global_load_lds((const unsigned*)(sp_ + cp_voff), (PG8_LAS unsigned*)(cp_stage + cp_sl * 1024), 16, 0, 2); \
        ++cp_n; cp_sl = (cp_sl == 2) ? 0 : cp_sl + 1; cp_s += CP_STRIDE; cp_d += CP_STRIDE; } } while (0)
    Unit2 cur, nxt; int ui = 0;
    if (!S.next(0, cur)) return;
    typedef typename AccSel<I8>::type acc_t; const acc_t acc_zero = {};
    acc_t acc[2][2][4][2];
#pragma unroll
    for (int a = 0; a < 2; ++a)
#pragma unroll
        for (int b = 0; b < 2; ++b)
#pragma unroll
            for (int m = 0; m < 4; ++m)
#pragma unroll
                for (int n = 0; n < 2; ++n) acc[a][b][m][n] = acc_zero;
    bf16x8 At[4][2], B0[2][2], B1[2][2];
    const char* cA = (const char*)g.A + (size_t)cur.pm * tstep + (size_t)cur.k0 * kstep; const char* cB = (const char*)g.Bt + (size_t)cur.pn * tstep + (size_t)cur.k0 * kstep;
    S.a_ready(cur);
    {
        PG8_STAGE(PG8_SB(0, 0), cB, voffB); PG8_STAGE(PG8_SB(0, 1), cB + hstep, voffB); PG8_STAGE(PG8_SA(0, 0), cA, voffA); PG8_STAGE(PG8_SA(0, 1), cA + hstep, voffA);
        if (wr == 1) PG8_BAR;
        PG8_WAIT_V(2); PG8_BAR;
        PG8_STAGE(PG8_SB(1, 0), cB + kstep, voffB); PG8_STAGE(PG8_SA(1, 0), cA + kstep, voffA); PG8_STAGE(PG8_SB(1, 1), cB + hstep + kstep, voffB);
        PG8_WAIT_V(6); PG8_BAR;
    }
    for (;;) {
        const bool has_next = S.next(ui + 1, nxt);
        const char* nA = has_next ? (const char*)g.A + (size_t)nxt.pm * tstep + (size_t)nxt.k0 * kstep : cA; const char* nB = has_next ? (const char*)g.Bt + (size_t)nxt.pn * tstep + (size_t)nxt.k0 * kstep : cB;
        const int nt = cur.nt;
        for (int t = 0; t < nt; t += 2) {
            const bool last = (t == nt - 2);
            const char* a1 = cA + (size_t)(t + 1) * kstep;
            const char* a2 = last ? nA : cA + (size_t)(t + 2) * kstep; const char* b2 = last ? nB : cB + (size_t)(t + 2) * kstep;
            const char* a3 = a2 + kstep; const char* b3 = b2 + kstep;
            if (last && has_next) S.a_ready(nxt);
            PG8_LDB(B0, 0, 0); PG8_LDB(B1, 0, 1); PG8_SCHED; PG8_LDA(At, 0, 0); PG8_STAGE(PG8_SA(1, 1), a1 + hstep, voffA);
            CP_STORE(); PG8_WAIT_LOOP(); PG8_WAIT_L(0); PG8_BAR; PG8_MMA(0, 0, At, B0); CP_READ(); PG8_MMA(0, 1, At, B1); CP_ISSUE(); PG8_BAR; PG8_SCHED;
            PG8_LDA(At, 0, 1); PG8_STAGE(PG8_SB(0, 0), b2, voffB); PG8_STAGE(PG8_SB(0, 1), b2 + hstep, voffB); PG8_STAGE(PG8_SA(0, 0), a2, voffA);
            CP_STORE(); PG8_WAIT_LOOP(); PG8_WAIT_L(0); PG8_BAR; PG8_MMA(1, 0, At, B0); CP_READ(); PG8_MMA(1, 1, At, B1); CP_ISSUE(); PG8_BAR; PG8_SCHED;
            PG8_LDB(B0, 1, 0); PG8_LDB(B1, 1, 1); PG8_SCHED; PG8_LDA(At, 1, 0); PG8_STAGE(PG8_SA(0, 1), a2 + hstep, voffA);
            CP_STORE(); PG8_WAIT_LOOP(); PG8_WAIT_L(0); PG8_BAR; PG8_MMA(0, 0, At, B0); CP_READ(); PG8_MMA(0, 1, At, B1); CP_ISSUE(); PG8_BAR; PG8_SCHED;
            PG8_LDA(At, 1, 1); PG8_STAGE(PG8_SB(1, 0), b3, voffB); PG8_STAGE(PG8_SB(1, 1), b3 + hstep, voffB); PG8_STAGE(PG8_SA(1, 0), a3, voffA);
            CP_STORE(); PG8_WAIT_LOOP(); PG8_WAIT_L(0); PG8_BAR; PG8_MMA(1, 0, At, B0); CP_READ(); PG8_MMA(1, 1, At, B1); CP_ISSUE(); PG8_BAR; PG8_SCHED;
        }
        if constexpr (ALIGN_EPI) { if (wr == 0) PG8_BAR; }
        { int l2_; asm volatile("v_mbcnt_lo_u32_b32 %0, -1, 0\n\tv_mbcnt_hi_u32_b32 %0, -1, %0" : "=v"(l2_)); E(acc, cur, wr, wc, l2_ & 15, l2_ >> 4); } S.done(cur);
        if (!has_next) break;
#pragma unroll
        for (int a = 0; a < 2; ++a)
#pragma unroll
            for (int b = 0; b < 2; ++b)
#pragma unroll
                for (int m = 0; m < 4; ++m)
#pragma unroll
                    for (int n = 0; n < 2; ++n) acc[a][b][m][n] = acc_zero;
        cur = nxt; cA = nA; cB = nB; ++ui;
        if constexpr (ALIGN_EPI) { if (wr == 1) PG8_BAR; }
    }
    PG8_WAIT_V(0);
    if constexpr (!ALIGN_EPI) { if (wr == 0) PG8_BAR; }
    PG8_BAR;
    if constexpr (COPY) {
        if (cp_n >= 4 && cp_n - 4 < cp_cnt) __builtin_nontemporal_store(cp_r, (cp4*)(C.dst + ((size_t)cp_base + cp_n - 4) * CP_STRIDE + cp_voff));
#pragma unroll
        for (int j = 3; j >= 1; --j) { const int k = cp_n - j;
            if (k >= 0 && k < cp_cnt) { const int sl = k % 3; const cp4 v = *(const PG8_LAS cp4*)(cp_stage + sl * 1024 + cp_voff);
                __builtin_nontemporal_store(v, (cp4*)(C.dst + ((size_t)cp_base + k) * CP_STRIDE + cp_voff)); } }
        C.cur = cp_base + (cp_n < cp_cnt ? cp_n : cp_cnt);
    }
#undef CP_ISSUE
#undef CP_READ
#undef CP_STORE
#undef PG8_SA
#undef PG8_SB
#undef PG8_STAGE
#undef PG8_LDA
#undef PG8_LDB
#undef PG8_MMA
#undef PG8_WAIT_V
#undef PG8_WAIT_LOOP
#undef PG8_WAIT_L
#undef PG8_BAR
#undef PG8_SCHED
}
struct Order2 {
    StaticOrder so; int nt;
    __device__ __forceinline__ void init(int M, int N, int K, int G, int c) { so.init(M, N, G, c); nt = K / BK; }
    __device__ __forceinline__ bool next(int i, Unit2& u) const { Unit v; if (!so.next(i, v)) return false; u.pm = v.pm; u.pn = v.pn; u.k0 = 0; u.nt = nt; u.split = 0; return true; }
    __device__ __forceinline__ void a_ready(const Unit2&) const {}
    __device__ __forceinline__ void done(const Unit2&) const {}
};
struct SplitOrder {
    StaticOrder so; int nt, nsplit, nN, npre, ntot;
    __device__ __forceinline__ void init(int Mp, int N, int K, int nsplit_, int G, int c) { so.init(Mp, N, G, c); nt = K / BK; nsplit = nsplit_; nN = N / BM; npre = so.nwg; ntot = npre + 4 * nN * nsplit; }
    __device__ __forceinline__ bool next(int i, Unit2& u) const {
        const long L = (long)i * so.G + so.c; if (L >= ntot) return false;
        Unit v; v.pm = 0; v.pn = 0; const bool pre = so.next(i, v);
        const int s = (int)L - npre, ks = s % nsplit, tile = s / nsplit, nts = nt / nsplit;
        u.pm = pre ? v.pm : so.nM + tile / nN; u.pn = pre ? v.pn : tile % nN; u.nt = pre ? nt : nts; u.k0 = pre ? 0 : ks * nts; u.split = pre ? 0 : 1; return true;
    }
    __device__ __forceinline__ void a_ready(const Unit2&) const {}
    __device__ __forceinline__ void done(const Unit2&) const {}
};
}

constexpr int NWAVES = 8;
constexpr int DM = 1024, SEQ = 16384, NBAT = 128, DSEQ = 8, MP = SEQ, MS = NBAT * DSEQ, MTOT = MP + MS;
constexpr int DFF = 2816, NH = 8, HD = 64, DATT = 512, DSSM = 512, NG = 32, NP = 64, NC = 16, WBUF = 2048, PAST = 8192;
constexpr int NADA = 9 * DM;
constexpr float EPS = 1e-6f;
constexpr float QSCALE = 0.125f * 1.44269504088896340736f;
constexpr int CHUNK = 128, NCHUNK_P = SEQ / CHUNK  , NCHUNK_S = MS / CHUNK  ;

constexpr size_t MiB = 1u << 20;
constexpr size_t WS_CTL = 0, CTL_ZERO_BYTES = 1 * MiB;
constexpr size_t WS_ADA = 1 * MiB;
constexpr size_t WS_SC = 10 * MiB;
constexpr size_t WS_ROPE = 11 * MiB;
constexpr size_t WS_SSMT = 13 * MiB;
constexpr size_t WS_WADA = 14 * MiB;
constexpr size_t WS_W1T = 32 * MiB;
constexpr size_t WS_W1D = 43 * MiB;
constexpr size_t WS_W2T = 49 * MiB;
constexpr size_t WS_W2D = 60 * MiB;
constexpr size_t WS_WIN = 66 * MiB;
constexpr size_t WS_WGLU = 70 * MiB;
constexpr size_t WS_WOUT = 71 * MiB;
constexpr size_t WS_XN = 74 * MiB;
constexpr size_t WS_H = 108 * MiB;
constexpr size_t WS_X1 = 202 * MiB;
constexpr size_t WS_X2 = 270 * MiB;
constexpr size_t WS_Q = 338 * MiB;
constexpr size_t WS_K = 355 * MiB;
constexpr size_t WS_VT = 372 * MiB;
constexpr size_t WS_U = 420 * MiB;
constexpr size_t WS_SQKV = 437 * MiB;
constexpr size_t WS_MIX = 443 * MiB;
constexpr size_t WS_GB = 477 * MiB;
constexpr size_t WS_CS = 494 * MiB;
constexpr size_t WS_SLAB = 496 * MiB;
constexpr size_t WS_OP = 540 * MiB;
constexpr size_t WS_ML = 588 * MiB;
constexpr size_t WS_XN8 = 592 * MiB;
constexpr size_t WS_W1T8 = 610 * MiB;
constexpr size_t WS_W2T8 = 616 * MiB;
constexpr size_t WS_SB = 622 * MiB;
constexpr size_t WS_SA = 623 * MiB;
constexpr size_t WS_END = 624 * MiB;
constexpr size_t ST_ABAR = 0;
constexpr size_t ST_CM = 256 * 1024;
constexpr size_t ST_PW = 384 * 1024;
constexpr size_t ST_CP = 448 * 1024;
constexpr size_t ST_CL = 704 * 1024;
constexpr size_t O_YP = 0, O_YS = 16777216, O_KP = 17825792, O_VP = 18874368, O_HRP = 19922944, O_HIP = 19924992,
                 O_KS = 19927040, O_VS = 154144768, O_HRS = 288362496, O_HIS = 288624640, O_END = 288886784;
constexpr int CW_TMO = 0, CW_BAR = 4096, CW_AMAX = 16384;

constexpr int RING_OFF = 0, RING_BYTES = 131072;
constexpr int CPSTAGE_BYTES = 24576;
constexpr int LDSCTL_OFF = RING_BYTES + CPSTAGE_BYTES, MISC_OFF = LDSCTL_OFF + 320;
constexpr int LDS_BYTES = 157696;

#define GAS __attribute__((address_space(1)))
#define LAS __attribute__((address_space(3)))
typedef unsigned short bf16;
typedef unsigned v4u __attribute__((ext_vector_type(4)));
typedef unsigned v2u __attribute__((ext_vector_type(2)));
typedef float f32x4 __attribute__((ext_vector_type(4)));
typedef float f32x2 __attribute__((ext_vector_type(2)));
typedef short bf16x8 __attribute__((ext_vector_type(8)));
typedef GAS unsigned gu32;
#define RLX_AGENT __ATOMIC_RELAXED, __HIP_MEMORY_SCOPE_AGENT
#define LDS_WAIT() asm volatile("s_waitcnt lgkmcnt(0)" ::: "memory")
#define VM_WAIT() asm volatile("s_waitcnt vmcnt(0)" ::: "memory")
__device__ __forceinline__ unsigned f2bf(float f) { unsigned u = __builtin_bit_cast(unsigned, f); return (u + 0x7fffu + ((u >> 16) & 1u)) >> 16; }
__device__ __forceinline__ unsigned pk2(float lo, float hi) { return pg8::cvt_pk_bf16(lo, hi); }
__device__ __forceinline__ float bf2f(unsigned short b) { return __builtin_bit_cast(float, (unsigned)b << 16); }
__device__ __forceinline__ float fast_sigmoid(float x) { return __builtin_amdgcn_rcpf(1.0f + __builtin_amdgcn_exp2f(-1.44269504088896f * x)); }
__device__ __forceinline__ float gelu_tanh(float x) { const float z = 1.5957691216057308f * (x + 0.044715f * x * x * x); return x * fast_sigmoid(z); }
#define XB_TMO      128
#define XB_XCNT(j)  (256  + 64 * (j))
#define XB_XSUB(j)  (1280 + 64 * (j))
#define XB_XGEN(j)  (2304 + 64 * (j))
#define XB_TOP      3328
#define XB_TOPGEN   3392
#define XCD_BAR_WORDS 3456
#define XB_SPIN_CAP (1u << 18)

__device__ __forceinline__ unsigned xb_ld(unsigned* p)              { return __hip_atomic_load(p, __ATOMIC_RELAXED, __HIP_MEMORY_SCOPE_AGENT); }
__device__ __forceinline__ unsigned xb_add(unsigned* p, unsigned v) { return __hip_atomic_fetch_add(p, v, __ATOMIC_RELAXED, __HIP_MEMORY_SCOPE_AGENT); }
__device__ __forceinline__ unsigned xb_xcc_id() { return (unsigned)__builtin_amdgcn_s_getreg((3 << 11) | 20) & 0xFu; }
#define XB_SPIN(cond, bar) do { unsigned _sp = 0; while (cond) { __builtin_amdgcn_s_sleep(1); \
    if ((++_sp & 255u) == 0u) { if (xb_ld(&(bar)[XB_TMO])) break; if (_sp > XB_SPIN_CAP) { atomicAdd(&(bar)[XB_TMO], 1u); break; } } } } while (0)

struct XcdBarrier {
    unsigned* bar; unsigned x;
    volatile LAS unsigned* st;
};

__device__ __forceinline__ XcdBarrier xcd_barrier_post(unsigned* bar, volatile LAS unsigned* st) {
    XcdBarrier b; b.bar = bar; b.x = xb_xcc_id(); b.st = st;
    if (threadIdx.x == 0) (void)xb_add(&bar[XB_XCNT(b.x)], 1u);
    return b;
}
__device__ __forceinline__ void xcd_barrier_complete(unsigned* bar, unsigned x, unsigned& nloc, unsigned& nx) {
    const unsigned G = gridDim.x * gridDim.y * gridDim.z;
    unsigned sum, cnt, mine, sp = 0u;
    for (;;) {
        sum = 0u; cnt = 0u; mine = 0u;
#pragma unroll
        for (unsigned j = 0; j < 16; ++j) { const unsigned c = xb_ld(&bar[XB_XCNT(j)]); sum += c; cnt += (c > 0u) ? 1u : 0u; mine = (j == x) ? c : mine; }
        if (sum == G) break;
        __builtin_amdgcn_s_sleep(1);
        if ((++sp & 255u) == 0u) { if (xb_ld(&bar[XB_TMO])) break; if (sp > XB_SPIN_CAP) { atomicAdd(&bar[XB_TMO], 1u); break; } }
    }
    nloc = mine > 0u ? mine : 1u; nx = cnt > 0u ? cnt : 1u;
}

__device__ __forceinline__ void xcd_barrier(const XcdBarrier& b) {
    asm volatile("s_waitcnt vmcnt(0)" ::: "memory");
    __syncthreads();
    if (threadIdx.x == 0) {
        unsigned* bar = b.bar;
        __builtin_amdgcn_s_waitcnt(0);
        unsigned nloc = b.st[0], nx = b.st[1];
        if (nloc == 0u) { xcd_barrier_complete(bar, b.x, nloc, nx); b.st[0] = nloc; b.st[1] = nx; }
        const unsigned old = xb_add(&bar[XB_XSUB(b.x)], 1u);
        const unsigned gen = old / nloc;
        if (old + 1u == (gen + 1u) * nloc) {
            __builtin_amdgcn_fence(__ATOMIC_RELEASE, "agent");
            asm volatile("s_waitcnt vmcnt(0)" ::: "memory");
            const unsigned og = xb_add(&bar[XB_TOP], 1u);
            if (og + 1u == (gen + 1u) * nx) xb_add(&bar[XB_TOPGEN], 1u);
        }
        XB_SPIN(xb_ld(&bar[XB_TOPGEN]) == gen, bar);
        __builtin_amdgcn_fence(__ATOMIC_ACQUIRE, "agent");
        asm volatile("s_waitcnt vmcnt(0)" ::: "memory");
    }
    __syncthreads();
}


struct Args { const float* in[32]; float* out; unsigned char* ws; int ph_lo, ph_hi, nocopy, pad; };
enum { I_XP = 0, I_XS, I_CP, I_CS, I_CK, I_CV, I_SRE, I_SIM, I_WADA, I_BADA, I_GF1, I_W1G, I_W1U, I_W1D, I_GMIX, I_WIN, I_GQ, I_GK,
       I_ARE, I_AIM, I_LDT, I_BRE, I_BIM, I_CRE, I_CIM, I_SD, I_WGLU, I_WOUT, I_GF2, I_W2G, I_W2U, I_W2D };
struct Frame {
    LAS unsigned char* lds;
    volatile LAS unsigned* MISC;
    gu32* ctl;
    int tid, lane, wave;
    int vcu, G;
};
__device__ __forceinline__ int ada_row(int m) { return m < MP ? 0 : 1 + ((m - MP) >> 3); }
__device__ __forceinline__ float wave_sum(float v) {
#pragma unroll
    for (int o = 1; o < 64; o <<= 1) v += __shfl_xor(v, o);
    return v;
}
__device__ __forceinline__ float wave_max(float v) {
#pragma unroll
    for (int o = 1; o < 64; o <<= 1) v = fmaxf(v, __shfl_xor(v, o));
    return v;
}

namespace pg8 {
struct EpiF32 {
    static constexpr bool PERM = false, AFTER_DRAIN = false;
    float* C; int ldc; const float* bias;
    __device__ __forceinline__ void operator()(const f32x4 (&acc)[2][2][4][2], const Unit2& u, int wr, int wc, int fr, int fq) const {
        const int row0 = u.pm * BM + wr * 64 + fr, col0 = u.pn * BM + wc * 32 + 4 * fq;
        f32x4 bv[2][2];
#pragma unroll
        for (int bj = 0; bj < 2; ++bj)
#pragma unroll
            for (int n = 0; n < 2; ++n) bv[bj][n] = *(const f32x4*)(bias + col0 + bj * HALF + n * 16);
#pragma unroll
        for (int ai = 0; ai < 2; ++ai)
#pragma unroll
            for (int m = 0; m < 4; ++m) { float* rowp = C + (size_t)(row0 + ai * HALF + m * 16) * ldc + col0;
#pragma unroll
                for (int bj = 0; bj < 2; ++bj)
#pragma unroll
                    for (int n = 0; n < 2; ++n) *(f32x4*)(rowp + bj * HALF + n * 16) = acc[ai][bj][m][n] + bv[bj][n]; }
    }
};
template <int ACT  > struct EpiGated {
    static constexpr bool PERM = true, AFTER_DRAIN = false;
    bf16_t* O; int ldo; int col_off;
    __device__ __forceinline__ void operator()(const f32x4 (&acc)[2][2][4][2], const Unit2& u, int wr, int wc, int fr, int fq) const {
        const int row0 = u.pm * BM + wr * 64 + fr, col = col_off + u.pn * HALF + wc * 32 + 8 * fq;
#pragma unroll
        for (int ai = 0; ai < 2; ++ai)
#pragma unroll
            for (int m = 0; m < 4; ++m) {
                float r[8];
#pragma unroll
                for (int n = 0; n < 2; ++n)
#pragma unroll
                    for (int e = 0; e < 4; ++e) { const float a = acc[ai][0][m][n][e], b = acc[ai][1][m][n][e];
                        r[n * 4 + e] = (ACT == 0) ? a * b * fast_sigmoid(a) : a * fast_sigmoid(b); }
                u32x4 w; w.x = cvt_pk_bf16(r[0], r[1]); w.y = cvt_pk_bf16(r[2], r[3]); w.z = cvt_pk_bf16(r[4], r[5]); w.w = cvt_pk_bf16(r[6], r[7]);
                *(u32x4*)(O + blk_off(row0 + ai * HALF + m * 16, col, ldo)) = w;
            }
    }
};
struct EpiGated8 {
    static constexpr bool PERM = true, AFTER_DRAIN = false;
    bf16_t* O; int ldo; const float* sA; const unsigned* amax;
    __device__ __forceinline__ void operator()(const i32x4 (&acc)[2][2][4][2], const Unit2& u, int wr, int wc, int fr, int fq) const {
        const int row0 = u.pm * BM + wr * 64 + fr, col = u.pn * HALF + wc * 32 + 8 * fq;
        const float sg = __builtin_bit_cast(float, amax[0]) * (1.0f / 127.0f), su = __builtin_bit_cast(float, amax[1]) * (1.0f / 127.0f);
        float ras[2][4];
#pragma unroll
        for (int ai = 0; ai < 2; ++ai)
#pragma unroll
            for (int m = 0; m < 4; ++m) ras[ai][m] = sA[row0 + ai * HALF + m * 16];
#pragma unroll
        for (int ai = 0; ai < 2; ++ai)
#pragma unroll
            for (int m = 0; m < 4; ++m) { const int row = row0 + ai * HALF + m * 16; const float ra = ras[ai][m]; const float fg = ra * sg, fu = ra * su;
                float r[8];
#pragma unroll
                for (int n = 0; n < 2; ++n)
#pragma unroll
                    for (int e = 0; e < 4; ++e) { const float a = (float)acc[ai][0][m][n][e] * fg, b = (float)acc[ai][1][m][n][e] * fu;
                        r[n * 4 + e] = a * b * fast_sigmoid(a); }
                u32x4 w; w.x = cvt_pk_bf16(r[0], r[1]); w.y = cvt_pk_bf16(r[2], r[3]); w.z = cvt_pk_bf16(r[4], r[5]); w.w = cvt_pk_bf16(r[6], r[7]);
                *(u32x4*)(O + blk_off(row, col, ldo)) = w;
                __builtin_amdgcn_sched_barrier(0);
            }
    }
};
template <bool BIN, bool BOUT>
struct EpiResid {
    static constexpr bool PERM = false, AFTER_DRAIN = false;
    const float* baseP; const float* baseS; float* out; const float* ada; int gate_off; float coef; float* slab;
    __device__ __forceinline__ void operator()(f32x4 (&acc)[2][2][4][2], const Unit2& u, int wr, int wc, int fr, int fq) const {
        const int row0 = u.pm * BM + wr * 64 + fr, col0 = u.pn * BM + wc * 32 + 4 * fq;
        if (u.split) {
#pragma unroll
            for (int ai = 0; ai < 2; ++ai)
#pragma unroll
                for (int m = 0; m < 4; ++m) { const int row = row0 + ai * HALF + m * 16;
                    unsigned short* sl = (unsigned short*)slab + ((size_t)(u.k0 / u.nt) * MS + (size_t)(row - MP)) * DM;
#pragma unroll
                    for (int bj = 0; bj < 2; ++bj)
#pragma unroll
                        for (int n = 0; n < 2; ++n) { const int c = col0 + bj * HALF + n * 16; const f32x4 a_ = acc[ai][bj][m][n];
                            *(u32x2v*)(sl + c) = (u32x2v){cvt_pk_bf16(a_.x, a_.y), cvt_pk_bf16(a_.z, a_.w)}; } }
        } else {
            f32x4 g00, g01, g10, g11;
#define RES_LDP(D0, D1, D2, D3, PTR) do { const float* p_ = (PTR); \
                asm volatile("global_load_dwordx4 %0, %4, off\n\tglobal_load_dwordx4 %1, %4, off offset:64\n\tglobal_load_dwordx4 %2, %4, off offset:512\n\tglobal_load_dwordx4 %3, %4, off offset:576" \
                             : "=&v"(D0), "=&v"(D1), "=&v"(D2), "=&v"(D3) : "v"(p_) : "memory"); } while (0)
#define RES_LDB(D0, D1, D2, D3, PTR) do { const unsigned short* p_ = (PTR); \
                asm volatile("global_load_dwordx2 %0, %4, off\n\tglobal_load_dwordx2 %1, %4, off offset:32\n\tglobal_load_dwordx2 %2, %4, off offset:256\n\tglobal_load_dwordx2 %3, %4, off offset:288" \
                             : "=&v"(D0), "=&v"(D1), "=&v"(D2), "=&v"(D3) : "v"(p_) : "memory"); } while (0)
#define RES_WAIT(N, C0, C1, C2, C3) asm volatile("s_waitcnt vmcnt(" #N ")" : "+v"(C0), "+v"(C1), "+v"(C2), "+v"(C3), "+v"(g00), "+v"(g01), "+v"(g10), "+v"(g11) :: "memory")
#define RES_FMA(Q, V0, V1, V2, V3) do { constexpr int ai_ = (Q) >> 2, m_ = (Q) & 3; \
                acc[ai_][0][m_][0] = (V0) + (g00 * coef) * acc[ai_][0][m_][0]; acc[ai_][0][m_][1] = (V1) + (g01 * coef) * acc[ai_][0][m_][1]; \
                acc[ai_][1][m_][0] = (V2) + (g10 * coef) * acc[ai_][1][m_][0]; acc[ai_][1][m_][1] = (V3) + (g11 * coef) * acc[ai_][1][m_][1]; } while (0)
            RES_LDP(g00, g01, g10, g11, ada + gate_off + col0);
            if constexpr (!BIN) {
                f32x4 b0, b1, b2, b3, n0, n1, n2, n3;
#define RES_LD(D0, D1, D2, D3, ROWOFF) RES_LDP(D0, D1, D2, D3, baseP + (ROWOFF))
                RES_LD(b0, b1, b2, b3, (size_t)row0 * DM + col0);
#define RES_STEP(Q, C0, C1, C2, C3, N0, N1, N2, N3) do { \
                    if ((Q) < 7) { constexpr int ai2_ = ((Q) + 1) >> 2, m2_ = ((Q) + 1) & 3; RES_LD(N0, N1, N2, N3, (size_t)(row0 + ai2_ * HALF + m2_ * 16) * DM + col0); RES_WAIT(4, C0, C1, C2, C3); } \
                    else RES_WAIT(0, C0, C1, C2, C3); \
                    RES_FMA(Q, C0, C1, C2, C3); } while (0)
                RES_STEP(0, b0, b1, b2, b3, n0, n1, n2, n3); RES_STEP(1, n0, n1, n2, n3, b0, b1, b2, b3); RES_STEP(2, b0, b1, b2, b3, n0, n1, n2, n3); RES_STEP(3, n0, n1, n2, n3, b0, b1, b2, b3);
                RES_STEP(4, b0, b1, b2, b3, n0, n1, n2, n3); RES_STEP(5, n0, n1, n2, n3, b0, b1, b2, b3); RES_STEP(6, b0, b1, b2, b3, n0, n1, n2, n3); RES_STEP(7, n0, n1, n2, n3, b0, b1, b2, b3);
#undef RES_STEP
#undef RES_LD
            } else {
                const unsigned short* bp = (const unsigned short*)baseP;
                u32x2v b0, b1, b2, b3, n0, n1, n2, n3;
#define RES_BF(W) ((f32x4){__builtin_bit_cast(float, (W).x << 16), __builtin_bit_cast(float, (W).x & 0xffff0000u), __builtin_bit_cast(float, (W).y << 16), __builtin_bit_cast(float, (W).y & 0xffff0000u)})
#define RES_LD(D0, D1, D2, D3, ROWOFF) RES_LDB(D0, D1, D2, D3, bp + (ROWOFF))
                RES_LD(b0, b1, b2, b3, (size_t)row0 * DM + col0);
#define RES_STEP(Q, C0, C1, C2, C3, N0, N1, N2, N3) do { \
                    if ((Q) < 7) { constexpr int ai2_ = ((Q) + 1) >> 2, m2_ = ((Q) + 1) & 3; RES_LD(N0, N1, N2, N3, (size_t)(row0 + ai2_ * HALF + m2_ * 16) * DM + col0); RES_WAIT(4, C0, C1, C2, C3); } \
                    else RES_WAIT(0, C0, C1, C2, C3); \
                    RES_FMA(Q, RES_BF(C0), RES_BF(C1), RES_BF(C2), RES_BF(C3)); } while (0)
                RES_STEP(0, b0, b1, b2, b3, n0, n1, n2, n3); RES_STEP(1, n0, n1, n2, n3, b0, b1, b2, b3); RES_STEP(2, b0, b1, b2, b3, n0, n1, n2, n3); RES_STEP(3, n0, n1, n2, n3, b0, b1, b2, b3);
                RES_STEP(4, b0, b1, b2, b3, n0, n1, n2, n3); RES_STEP(5, n0, n1, n2, n3, b0, b1, b2, b3); RES_STEP(6, b0, b1, b2, b3, n0, n1, n2, n3); RES_STEP(7, n0, n1, n2, n3, b0, b1, b2, b3);
#undef RES_STEP
#undef RES_LD
#undef RES_BF
            }
#undef RES_FMA
#undef RES_WAIT
#undef RES_LDB
#undef RES_LDP
            asm volatile("" ::: "memory");
            if constexpr (!BOUT) {
#pragma unroll
                for (int q = 0; q < 8; ++q) { const int ai = q >> 2, m = q & 3; const size_t ro = (size_t)(row0 + ai * HALF + m * 16) * DM + col0;
                    *(f32x4*)(out + ro) = acc[ai][0][m][0]; *(f32x4*)(out + ro + 16) = acc[ai][0][m][1]; *(f32x4*)(out + ro + HALF) = acc[ai][1][m][0]; *(f32x4*)(out + ro + HALF + 16) = acc[ai][1][m][1]; }
            } else {
                unsigned short* ob = (unsigned short*)out;
#define RES_PK(V) ((u32x2v){cvt_pk_bf16((V).x, (V).y), cvt_pk_bf16((V).z, (V).w)})
#pragma unroll
                for (int q = 0; q < 8; ++q) { const int ai = q >> 2, m = q & 3; const size_t ro = (size_t)(row0 + ai * HALF + m * 16) * DM + col0;
                    *(u32x2v*)(ob + ro) = RES_PK(acc[ai][0][m][0]); *(u32x2v*)(ob + ro + 16) = RES_PK(acc[ai][0][m][1]); *(u32x2v*)(ob + ro + HALF) = RES_PK(acc[ai][1][m][0]); *(u32x2v*)(ob + ro + HALF + 16) = RES_PK(acc[ai][1][m][1]); }
#undef RES_PK
            }
        }
    }
};
struct EpiInProj {
    static constexpr bool PERM = false, AFTER_DRAIN = false;
    bf16_t *Q, *K, *VT, *U; float* SQKV; float* out; const _Float16* rope16; const float* gq; const float* gk;
    __device__ __forceinline__ void operator()(const f32x4 (&acc)[2][2][4][2], const Unit2& u, int wr, int wc, int fr, int fq) const {
        const int row0 = u.pm * BM + wr * 64 + fr; const int pn = u.pn;
        if (pn < 4) {
            const bool isq = pn < 2; const int hh = 4 * (pn & 1) + wc; const float* gw = isq ? gq : gk;
            f32x4 gv[2][2];
#pragma unroll
            for (int bj = 0; bj < 2; ++bj)
#pragma unroll
                for (int n = 0; n < 2; ++n) gv[bj][n] = *(const f32x4*)(gw + 32 * bj + 16 * n + 4 * fq);
            typedef _Float16 h16x4 __attribute__((ext_vector_type(4)));
            h16x4 rcs[2][4], rsn[2][4];
#pragma unroll
            for (int ai = 0; ai < 2; ++ai)
#pragma unroll
                for (int m = 0; m < 4; ++m) { const size_t ro = (size_t)(row0 + ai * HALF + m * 16) * 16 + 4 * (fq & 1); rcs[ai][m] = *(const h16x4*)(rope16 + ro); rsn[ai][m] = *(const h16x4*)(rope16 + ro + 8); }
#pragma unroll
            for (int ai = 0; ai < 2; ++ai)
#pragma unroll
                for (int m = 0; m < 4; ++m) { const int row = row0 + ai * HALF + m * 16;
                    const f32x4 cs = {(float)rcs[ai][m][0], (float)rcs[ai][m][1], (float)rcs[ai][m][2], (float)rcs[ai][m][3]}, sn = {(float)rsn[ai][m][0], (float)rsn[ai][m][1], (float)rsn[ai][m][2], (float)rsn[ai][m][3]};
                    float ss = 0.f;
#pragma unroll
                    for (int bj = 0; bj < 2; ++bj)
#pragma unroll
                        for (int n = 0; n < 2; ++n) { const f32x4 x = acc[ai][bj][m][n]; ss += (x[0] * x[0] + x[1] * x[1]) + (x[2] * x[2] + x[3] * x[3]); }
                    ss += __shfl_xor(ss, 16); ss += __shfl_xor(ss, 32);
                    const float rs = 1.0f / sqrtf(ss * (1.0f / 64.0f) + EPS);
                    f32x4 y[2][2];
#pragma unroll
                    for (int bj = 0; bj < 2; ++bj)
#pragma unroll
                        for (int n = 0; n < 2; ++n) y[bj][n] = acc[ai][bj][m][n] * rs * gv[bj][n];
                    {

                        f32x4 w;
#pragma unroll
                        for (int e = 0; e < 4; ++e) w[e] = __shfl_xor(y[0][0][e], 32);
                        y[0][0] = (fq < 2) ? (y[0][0] * cs - w * sn) : (y[0][0] * cs + w * sn);
                    }
                    if (isq) {
#pragma unroll
                        for (int bj = 0; bj < 2; ++bj)
#pragma unroll
                            for (int n = 0; n < 2; ++n) { const f32x4 v = y[bj][n] * QSCALE; const int c = hh * 64 + 32 * bj + 16 * n + 4 * fq;
                                u32x2v w2; w2.x = cvt_pk_bf16(v[0], v[1]); w2.y = cvt_pk_bf16(v[2], v[3]); *(u32x2v*)(Q + (size_t)row * DATT + c) = w2;
                                if (row >= MP) *(f32x4*)(SQKV + (size_t)(row - MP) * 1536 + c) = v; }
                    } else {
#pragma unroll
                        for (int bj = 0; bj < 2; ++bj)
#pragma unroll
                            for (int n = 0; n < 2; ++n) { const f32x4 v = y[bj][n]; const int c = hh * 64 + 32 * bj + 16 * n + 4 * fq;
                                u32x2v w2; w2.x = cvt_pk_bf16(v[0], v[1]); w2.y = cvt_pk_bf16(v[2], v[3]); *(u32x2v*)(K + (size_t)row * DATT + c) = w2;
                                if (row >= MP) { const int rs_ = row - MP, b = rs_ >> 3, s = rs_ & 7;
                                    *(f32x4*)(SQKV + (size_t)rs_ * 1536 + 512 + c) = v;
                                    *(f32x4*)(out + O_KS + ((size_t)b * WBUF + (WBUF - DSEQ) + s) * DATT + c) = v; }
                                else if (row >= MP - WBUF) *(f32x4*)(out + O_KP + (size_t)(row - (MP - WBUF)) * DATT + c) = v; }
                    }
                }
        } else if (pn < 6) {
#pragma unroll
            for (int ai = 0; ai < 2; ++ai)
#pragma unroll
                for (int m = 0; m < 4; ++m) { const int row = row0 + ai * HALF + m * 16;
#pragma unroll
                    for (int bj = 0; bj < 2; ++bj)
#pragma unroll
                        for (int n = 0; n < 2; ++n) { const f32x4 v = acc[ai][bj][m][n]; const int c = (pn - 4) * 256 + bj * HALF + wc * 32 + n * 16 + 4 * fq;
                            if (row >= MP) { const int rs_ = row - MP, b = rs_ >> 3, s = rs_ & 7;
                                *(f32x4*)(SQKV + (size_t)rs_ * 1536 + 1024 + c) = v;
                                *(f32x4*)(out + O_VS + ((size_t)b * WBUF + (WBUF - DSEQ) + s) * DATT + c) = v; }
                            else {
                                if (row >= MP - WBUF) *(f32x4*)(out + O_VP + (size_t)(row - (MP - WBUF)) * DATT + c) = v;
                                u32x2v w2; w2.x = cvt_pk_bf16(v[0], v[1]); w2.y = cvt_pk_bf16(v[2], v[3]); *(u32x2v*)(VT + (size_t)row * DATT + c) = w2;
                            } }
                }
        } else {
#pragma unroll
            for (int ai = 0; ai < 2; ++ai)
#pragma unroll
                for (int m = 0; m < 4; ++m) { const int row = row0 + ai * HALF + m * 16;
#pragma unroll
                    for (int bj = 0; bj < 2; ++bj)
#pragma unroll
                        for (int n = 0; n < 2; ++n) { const f32x4 v = acc[ai][bj][m][n]; const int c = (pn - 6) * 256 + bj * HALF + wc * 32 + n * 16 + 4 * fq;
                            u32x2v w2; w2.x = cvt_pk_bf16(v[0], v[1]); w2.y = cvt_pk_bf16(v[2], v[3]); *(u32x2v*)(U + (size_t)row * DSSM + c) = w2; }
                }
        }
    }
};
}

__device__ __forceinline__ void p0_transpose_item(const float* W, int K, int N, bf16* WT, int k0, int n0, int dest_row0, LAS float* scr, int lane) {
    float tv[32];
#pragma unroll
    for (int i = 0; i < 32; ++i) tv[i] = __builtin_nontemporal_load(W + (size_t)(k0 + 2 * i + (lane >> 5)) * N + n0 + (lane & 31));
#pragma unroll
    for (int i = 0; i < 32; ++i) scr[(2 * i + (lane >> 5)) * 33 + (lane & 31)] = tv[i];
    LDS_WAIT(); asm volatile("" ::: "memory");
    const int c = lane & 7;
#pragma unroll
    for (int j = 0; j < 4; ++j) { const int n = (lane >> 3) + 8 * j; const LAS float* s = scr + (8 * c) * 33 + n;
        v4u o; o.x = pk2(s[0 * 33], s[1 * 33]); o.y = pk2(s[2 * 33], s[3 * 33]); o.z = pk2(s[4 * 33], s[5 * 33]); o.w = pk2(s[6 * 33], s[7 * 33]);
        *(GAS v4u*)(WT + pg8::blk_off(dest_row0 + n, k0 + 8 * c, K)) = o; }
    LDS_WAIT(); asm volatile("" ::: "memory");
}
__device__ __forceinline__ int dest_row_of(int mode, int half, int n0);
__device__ __forceinline__ void p0_transpose_item8(const float* W, int K, int N, unsigned char* WT8, int k0, int n0, int dest_row0, const unsigned* amax, LAS float* scr, int lane) {
    float tv[32];
#pragma unroll
    for (int i = 0; i < 32; ++i) tv[i] = __builtin_nontemporal_load(W + (size_t)(k0 + 2 * i + (lane >> 5)) * N + n0 + (lane & 31));
#pragma unroll
    for (int i = 0; i < 32; ++i) scr[(2 * i + (lane >> 5)) * 33 + (lane & 31)] = tv[i];
    LDS_WAIT(); asm volatile("" ::: "memory");
    const int c = lane & 7; const float am = __builtin_bit_cast(float, amax[0]); const float qs = am > 0.f ? 127.0f / am : 0.f;
#pragma unroll
    for (int j = 0; j < 4; ++j) { const int n = (lane >> 3) + 8 * j; const LAS float* s = scr + (8 * c) * 33 + n;
        unsigned lo = 0u, hi = 0u;
#pragma unroll
        for (int q = 0; q < 4; ++q) { const int a = (int)__builtin_rintf(s[q * 33] * qs), b = (int)__builtin_rintf(s[(q + 4) * 33] * qs); lo |= ((unsigned)a & 0xffu) << (8 * q); hi |= ((unsigned)b & 0xffu) << (8 * q); }
        *(GAS v2u*)(WT8 + pg8::blk_byte(dest_row0 + n, k0 + 8 * c, K)) = (v2u){lo, hi}; }
    LDS_WAIT(); asm volatile("" ::: "memory");
}
__device__ __forceinline__ bool p0_mat8(const float* W, int K, int N, unsigned char* WT8, int half, const unsigned* amax, int& r, LAS float* scr, int lane) {
    const int nblk = N / 32, items = (K / 64) * nblk;
    if (r < items) { const int kb = r / nblk, nb = r % nblk; p0_transpose_item8(W, K, N, WT8, 64 * kb, 32 * nb, dest_row_of(1, half, 32 * nb), amax, scr, lane); return true; }
    r -= items; return false;
}
__device__ __forceinline__ int dest_row_of(int mode, int half, int n0) {
    if (mode == 1) return 256 * (n0 >> 7) + 128 * half + (n0 & 127);
    if (mode == 3) { const int hf = n0 >> 9, n = n0 & 511; return 256 * (n >> 7) + 128 * hf + (n & 127); }
    if (mode == 2 && n0 < 1024) { const int tile = n0 >> 8, hd = (n0 & 255) >> 6, e = n0 & 63; return 256 * tile + 128 * (e >> 5) + 32 * hd + (e & 31); }
    return n0;
}
__device__ __forceinline__ bool p0_mat(const float* W, int K, int N, bf16* WT, int mode, int half, int& r, LAS float* scr, int lane) {
    const int nblk = N / 32, items = (K / 64) * nblk;
    if (r < items) { const int kb = r / nblk, nb = r % nblk; p0_transpose_item(W, K, N, WT, 64 * kb, 32 * nb, dest_row_of(mode, half, 32 * nb), scr, lane); return true; }
    r -= items; return false;
}
__device__ __forceinline__ void p1_weights(Frame& F, const Args& A, int widx, int nworker) {
    LAS float* scr = (LAS float*)(F.lds + RING_OFF + F.wave * 16384);
    unsigned char* ws = A.ws;
    constexpr int NITEMS = 6 * 1408 + 1024 + 256 + 512;
    const unsigned* amax = (const unsigned*)(ws + WS_CTL) + CW_AMAX;
    for (int it = widx; it < NITEMS; it += nworker) {
        int r = it;
        if (p0_mat8(A.in[I_W1G], DM, DFF, ws + WS_W1T8, 0, amax + 0, r, scr, F.lane)) continue;
        if (p0_mat8(A.in[I_W1U], DM, DFF, ws + WS_W1T8, 1, amax + 1, r, scr, F.lane)) continue;
        if (p0_mat(A.in[I_W1D], DFF, DM, (bf16*)(ws + WS_W1D), 0, 0, r, scr, F.lane)) continue;
        if (p0_mat(A.in[I_WIN], DM, 2048, (bf16*)(ws + WS_WIN), 2, 0, r, scr, F.lane)) continue;
        if (p0_mat(A.in[I_WGLU], DSSM, 1024, (bf16*)(ws + WS_WGLU), 3, 0, r, scr, F.lane)) continue;
        if (p0_mat(A.in[I_WOUT], DM, DM, (bf16*)(ws + WS_WOUT), 0, 0, r, scr, F.lane)) continue;
        if (p0_mat8(A.in[I_W2G], DM, DFF, ws + WS_W2T8, 0, amax + 2, r, scr, F.lane)) continue;
        if (p0_mat8(A.in[I_W2U], DM, DFF, ws + WS_W2T8, 1, amax + 3, r, scr, F.lane)) continue;
        p0_mat(A.in[I_W2D], DFF, DM, (bf16*)(ws + WS_W2D), 0, 0, r, scr, F.lane);
    }
}
__device__ __forceinline__ void p0_prologue(Frame& F, const Args& A) {
    LAS float* scr = (LAS float*)(F.lds + RING_OFF + F.wave * 16384);
    const int gw = F.vcu * NWAVES + F.wave, NGW = F.G * NWAVES;
    unsigned char* ws = A.ws;
    for (int it = gw; it < 4608; it += NGW) { int r = it; p0_mat(A.in[I_WADA], DM, NADA, (bf16*)(ws + WS_WADA), 0, 0, r, scr, F.lane); }
    { unsigned* amax = (unsigned*)(ws + WS_CTL) + CW_AMAX;
      for (int it = gw; it < 4 * 44 * 8; it += NGW) { const int mat = it / 352, rem = it % 352, cb = rem >> 3, kb = rem & 7;
          const float* W = A.in[mat == 0 ? I_W1G : (mat == 1 ? I_W1U : (mat == 2 ? I_W2G : I_W2U))] + (size_t)(128 * kb) * DFF + 64 * cb + F.lane;
          float mx = 0.f;
#pragma unroll 16
          for (int k = 0; k < 128; ++k) mx = fmaxf(mx, fabsf(W[(size_t)k * DFF]));
          mx = wave_max(mx); if (F.lane == 0) atomicMax(amax + mat, __builtin_bit_cast(unsigned, mx)); } }
    const int gt = gw * 64 + F.lane, NGT = NGW * 64;
    { bf16* SC = (bf16*)(ws + WS_SC);
      for (int i = gt; i < 256 * DM / 2; i += NGT) { const int row = (2 * i) / DM, col = (2 * i) % DM; unsigned w = 0u;
          if (row < 129) { const float* c = row == 0 ? A.in[I_CP] : A.in[I_CS] + (size_t)(row - 1) * DM; const float a = c[col], b = c[col + 1]; w = pk2(a * fast_sigmoid(a), b * fast_sigmoid(b)); }
          *(GAS unsigned*)(SC + pg8::blk_off(row, col, DM)) = w; } }
    { _Float16* R = (_Float16*)(ws + WS_ROPE);
      for (int i = gt; i < MTOT * 8; i += NGT) { const int m = i >> 3, j = i & 7; const int pos = m < MP ? m : PAST + ((m - MP) & 7);
          const double inv = exp(-(double)j * (1.0 / 8.0) * 13.122363377404328  ); const double ang = (double)((float)pos * (float)inv);
          R[(size_t)m * 16 + j] = (_Float16)(float)cos(ang); R[(size_t)m * 16 + 8 + j] = (_Float16)(float)sin(ang); } }
    { unsigned char* T = ws + WS_SSMT;
      for (int id = gt; id < 83968; id += NGT) {
          if (id < 43008) {
              int gp, n; float* dst;
              if (id < 32768) { gp = id >> 4; n = (id & 15) + 1; dst = (float*)(T + ST_CP) + (size_t)gp * 32 + 2 * (id & 15); }
              else if (id < 40960) { const int i = id - 32768; gp = i >> 2; n = 1 << (i & 3); dst = (float*)(T + ST_PW) + (size_t)gp * 8 + 2 * (i & 3); }
              else { gp = id - 40960; n = CHUNK; dst = (float*)(T + ST_CL) + (size_t)gp * 2; }
              const double dt = exp((double)A.in[I_LDT][gp >> 6]); const double zr = (double)A.in[I_ARE][gp] * dt, zi = (double)A.in[I_AIM][gp] * dt;
              const double mg = exp((double)n * zr); dst[0] = (float)(mg * cos((double)n * zi)); dst[1] = (float)(mg * sin((double)n * zi));
          } else if (id < 75776) {
              const int i = id - 43008, gp = i >> 4, c = i & 15, grp = gp >> 6, p = gp & 63, pr = p >> 4, rho = p & 15;
              const double dt = exp((double)A.in[I_LDT][grp]); const double lre = (double)A.in[I_ARE][gp], lim = (double)A.in[I_AIM][gp];
              const double zr = lre * dt, zi = lim * dt; const double mg1 = exp(zr), br = mg1 * cos(zi) - 1.0, bi = mg1 * sin(zi); const double den = lre * lre + lim * lim;
              const double fr_ = (br * lre + bi * lim) / den, fi_ = (bi * lre - br * lim) / den;
              const double b_r = (double)A.in[I_BRE][(size_t)gp * 16 + c], b_i = (double)A.in[I_BIM][(size_t)gp * 16 + c];
              bf16* AB = (bf16*)(T + ST_ABAR) + (size_t)grp * 8 * 64 * 8; const int gq = c >> 3, j = c & 7;
              AB[((size_t)(2 * pr + 0) * 64 + rho + 16 * gq) * 8 + j] = (bf16)f2bf((float)(fr_ * b_r - fi_ * b_i));
              AB[((size_t)(2 * pr + 1) * 64 + rho + 16 * gq) * 8 + j] = (bf16)f2bf((float)(fr_ * b_i + fi_ * b_r));
              AB[((size_t)(2 * pr + 0) * 64 + rho + 16 * (gq + 2)) * 8 + j] = 0; AB[((size_t)(2 * pr + 1) * 64 + rho + 16 * (gq + 2)) * 8 + j] = 0;
          } else {
              const int i = id - 75776, grp = i >> 8, prc = (i >> 6) & 3, ln = i & 63, c = ln & 15, gq = ln >> 4;
              bf16* CMt = (bf16*)(T + ST_CM) + ((size_t)(grp * 4 + prc) * 64 + ln) * 8;
#pragma unroll
              for (int j = 0; j < 8; ++j) { const int ps = 16 * prc + 4 * gq + (j & 3);
                  const float v = (j < 4) ? A.in[I_CRE][((size_t)grp * 16 + c) * 64 + ps] : -A.in[I_CIM][((size_t)grp * 16 + c) * 64 + ps];
                  CMt[j] = (bf16)f2bf(v); }
          }
      } }
}

__device__ __forceinline__ void copy_tiles(const Args& A, int widx, int nworker, int lane) {
    constexpr int TPB = 255, NT = 2 * NBAT * TPB;
    for (int t = widx; t < NT; t += nworker) {
        const int kv = t / (NBAT * TPB), r = t % (NBAT * TPB), b = r / TPB, tl = r % TPB;
        const f32x4* src = (const f32x4*)(A.in[kv ? I_CV : I_CK] + (size_t)b * (WBUF * DATT) + DSEQ * DATT) + (size_t)tl * 1024 + lane;
        f32x4* dst = (f32x4*)(A.out + (kv ? O_VS : O_KS) + (size_t)b * (WBUF * DATT)) + (size_t)tl * 1024 + lane;
        f32x4 v[16];
#pragma unroll
        for (int j = 0; j < 16; ++j) v[j] = __builtin_nontemporal_load(src + 64 * j);
#pragma unroll
        for (int j = 0; j < 16; ++j) __builtin_nontemporal_store(v[j], dst + 64 * j);
    }
}

struct Combine { const float* slab; int nsl; const float* cbase; int gate_off; float ccoef; float* cres; };
__device__ __forceinline__ f32x4 bf4(const v2u w) { return (f32x4){__builtin_bit_cast(float, w.x << 16), __builtin_bit_cast(float, w.x & 0xffff0000u), __builtin_bit_cast(float, w.y << 16), __builtin_bit_cast(float, w.y & 0xffff0000u)}; }
template <int NSL>
__device__ __forceinline__ f32x4 combine_chunk(const Combine& C, const float* ar, int ms, int lane, int j) {
    v2u sl[NSL];
#pragma unroll
    for (int k = 0; k < NSL; ++k) sl[k] = ((const v2u*)((const bf16*)C.slab + ((size_t)k * MS + ms) * DM))[lane + 64 * j];
    const f32x4 gv = ((const f32x4*)(ar + C.gate_off))[lane + 64 * j], bv = ((const f32x4*)(C.cbase + (size_t)ms * DM))[lane + 64 * j];
    f32x4 acc = bf4(sl[0]);
#pragma unroll
    for (int k = 1; k < NSL; ++k) acc += bf4(sl[k]);
    const f32x4 r = bv + C.ccoef * gv * acc;
    ((f32x4*)(C.cres + (size_t)ms * DM))[lane + 64 * j] = r;
    return r;
}
template <int NSL>
__device__ __forceinline__ void combine_row(const Combine& C, const float* ar, int ms, int lane, f32x4 (&v)[4]) {
#pragma unroll
    for (int j = 0; j < 4; ++j) v[j] = combine_chunk<NSL>(C, ar, ms, lane, j);
}
template <bool PBF>
__device__ __forceinline__ f32x4 ld_prow(const float* srcP, const int m, const int i) {
    if constexpr (!PBF) return ((const f32x4*)(srcP + (size_t)m * DM))[i];
    else { const v2u w = ((const v2u*)((const bf16*)srcP + (size_t)m * DM))[i];
        return (f32x4){__builtin_bit_cast(float, w.x << 16), __builtin_bit_cast(float, w.x & 0xffff0000u), __builtin_bit_cast(float, w.y << 16), __builtin_bit_cast(float, w.y & 0xffff0000u)}; }
}
template <bool Q8>
__device__ __forceinline__ void norm_row(const f32x4 (&v)[4], const f32x4 (&gv)[4], const f32x4 (&sh)[4], const f32x4 (&sc)[4], const int m, const int lane, bf16* XN, unsigned char* XN8, float* sA) {
    float s = 0.f;
#pragma unroll
    for (int j = 0; j < 4; ++j) s += (v[j].x * v[j].x + v[j].y * v[j].y) + (v[j].z * v[j].z + v[j].w * v[j].w);
    const float rstd = 1.f / sqrtf(wave_sum(s) * (1.f / DM) + EPS);
    f32x4 y[4]; float am = 0.f;
#pragma unroll
    for (int j = 0; j < 4; ++j) { y[j] = (v[j] * rstd * gv[j]) * (1.0f + sc[j]) + sh[j];
        am = fmaxf(am, fmaxf(fmaxf(fabsf(y[j].x), fabsf(y[j].y)), fmaxf(fabsf(y[j].z), fabsf(y[j].w)))); }
    if constexpr (Q8) {
        am = wave_max(am); const float qs = am > 0.f ? 127.0f / am : 0.f;
#pragma unroll
        for (int j = 0; j < 4; ++j) { const int a = (int)__builtin_rintf(y[j].x * qs), b = (int)__builtin_rintf(y[j].y * qs), c = (int)__builtin_rintf(y[j].z * qs), d = (int)__builtin_rintf(y[j].w * qs);
            *(GAS unsigned*)(XN8 + pg8::blk_byte(m, 4 * lane + 256 * j, DM)) = ((unsigned)a & 0xffu) | (((unsigned)b & 0xffu) << 8) | (((unsigned)c & 0xffu) << 16) | (((unsigned)d & 0xffu) << 24); }
        if (lane == 0) sA[m] = am * (1.0f / 127.0f);
    } else {
#pragma unroll
        for (int j = 0; j < 4; ++j) *(GAS unsigned long long*)(XN + pg8::blk_off(m, 4 * lane + 256 * j, DM)) = (unsigned long long)pk2(y[j].x, y[j].y) | ((unsigned long long)pk2(y[j].z, y[j].w) << 32);
    }
}
template <bool Q8, int NSL, int PE, bool PBF>
__device__ __forceinline__ void norm_mod_rows(Frame& F, const float* srcP, const float* srcS, const float* g, const float* ada, int sh_off, int sc_off, bf16* XN, const Combine C, unsigned char* XN8, float* sA) {
    f32x4 gv[4];
#pragma unroll
    for (int j = 0; j < 4; ++j) gv[j] = ((const f32x4*)g)[F.lane + 64 * j];
    if (F.G == 256) {
        const int pair = F.wave >> 1, odd = F.wave & 1;
        const int np = odd ? 16 - PE : PE, p0 = F.vcu * 64 + pair * 16 + (odd ? PE : 0);
        f32x4 vn[4], sh[4], sc[4];
#pragma unroll
        for (int j = 0; j < 4; ++j) vn[j] = ld_prow<PBF>(srcP, p0, F.lane + 64 * j);
        if (!odd) {
            const int ms = F.vcu * 4 + pair, m = MP + ms; const float* ar = ada + (size_t)ada_row(m) * NADA;
            f32x4 v[4];
#pragma unroll
            for (int j = 0; j < 4; ++j) { sh[j] = ((const f32x4*)(ar + sh_off))[F.lane + 64 * j]; sc[j] = ((const f32x4*)(ar + sc_off))[F.lane + 64 * j]; }
            if constexpr (NSL > 0) combine_row<NSL>(C, ar, ms, F.lane, v);
            else {
#pragma unroll
                for (int j = 0; j < 4; ++j) v[j] = ((const f32x4*)(srcS + (size_t)ms * DM))[F.lane + 64 * j]; }
            norm_row<Q8>(v, gv, sh, sc, m, F.lane, XN, XN8, sA);
        }
#pragma unroll
        for (int j = 0; j < 4; ++j) { sh[j] = ((const f32x4*)(ada + sh_off))[F.lane + 64 * j]; sc[j] = ((const f32x4*)(ada + sc_off))[F.lane + 64 * j]; }
#pragma unroll 1
        for (int i = 0; i < np; ++i) {
            f32x4 v[4];
#pragma unroll
            for (int j = 0; j < 4; ++j) v[j] = vn[j];
            const int nx = p0 + (i + 1 < np ? i + 1 : i);
#pragma unroll
            for (int j = 0; j < 4; ++j) vn[j] = ld_prow<PBF>(srcP, nx, F.lane + 64 * j);
            norm_row<Q8>(v, gv, sh, sc, p0 + i, F.lane, XN, XN8, sA);
        }
        return;
    }
    const int gw = F.vcu * NWAVES + F.wave, NGW = F.G * NWAVES;
    for (int m = gw; m < MTOT; m += NGW) {
        const float* ar = ada + (size_t)ada_row(m) * NADA;
        f32x4 v[4], sh[4], sc[4];
#pragma unroll
        for (int j = 0; j < 4; ++j) { sh[j] = ((const f32x4*)(ar + sh_off))[F.lane + 64 * j]; sc[j] = ((const f32x4*)(ar + sc_off))[F.lane + 64 * j]; }
        bool done = false;
        if constexpr (NSL > 0) { if (m >= MP) { combine_row<NSL>(C, ar, m - MP, F.lane, v); done = true; } }
        if (!done) {
#pragma unroll
            for (int j = 0; j < 4; ++j) v[j] = m < MP ? ld_prow<PBF>(srcP, m, F.lane + 64 * j) : ((const f32x4*)(srcS + (size_t)(m - MP) * DM))[F.lane + 64 * j]; }
        norm_row<Q8>(v, gv, sh, sc, m, F.lane, XN, XN8, sA);
    }
}

__device__ __forceinline__ void copy_back(pg8::CopyJob& C, int nops, const int lane) {
    while (nops > 0 && C.end > C.cur) {
        int nb = C.end - C.cur; nb = nb < 8 ? nb : 8; nb = nb < nops ? nb : nops;
        v4u v[8];
#pragma unroll
        for (int j = 0; j < 8; ++j) if (j < nb) v[j] = __builtin_nontemporal_load((const v4u*)(C.src + (size_t)(C.end - 1 - j) * pg8::CP_STRIDE) + lane);
#pragma unroll
        for (int j = 0; j < 8; ++j) if (j < nb) __builtin_nontemporal_store(v[j], (v4u*)(C.dst + (size_t)(C.end - 1 - j) * pg8::CP_STRIDE) + lane);
        C.end -= nb; nops -= nb;
    }
}

__device__ __forceinline__ bf16x8 ld8(const bf16* p) { return *(const bf16x8*)p; }
#define MFMA16(a, b, c) __builtin_amdgcn_mfma_f32_16x16x32_bf16((a), (b), (c), 0, 0, 0)

constexpr int AT_ROWB = 144, AT_VOFF = 384 * AT_ROWB;
typedef short s16x4 __attribute__((ext_vector_type(4)));
__device__ __forceinline__ s16x4 lds_tr(const LAS unsigned char* p) { return __builtin_amdgcn_ds_read_tr16_b64_v4i16((LAS s16x4*)p); }
__device__ __forceinline__ void attn_unit(unsigned char* ws, LAS unsigned char* lds, const int unit, const int tid, const int wave, const int lane) {
    const int G = unit >> 9, u = unit & 511, h = u >> 6;
    int r, sb, d, L;
    if (G == 0) { d = 1; L = 16384; r = 0; sb = u & 63; } else if (G == 1) { d = 4; L = 4096; r = (u >> 4) & 3; sb = u & 15; } else { d = 16; L = 1024; r = (u >> 2) & 15; sb = u & 3; }
    const int q0 = sb * 256, k0 = q0 - 128;
    const bf16* Q = (const bf16*)(ws + WS_Q); const bf16* Kb = (const bf16*)(ws + WS_K) + h * 64; const bf16* Vb = (const bf16*)(ws + WS_VT) + h * 64;
#pragma unroll
    for (int i = 0; i < 6; ++i) { const int c = tid + 512 * i, row = c >> 3, ch = c & 7; int kk = k0 + row; kk = kk < 0 ? 0 : (kk > L - 1 ? L - 1 : kk);
        const size_t off = (size_t)(r + d * kk) * DATT + ch * 8;
        const v4u kv = *(const v4u*)(Kb + off), vv = *(const v4u*)(Vb + off);
        *(LAS v4u*)(lds + row * AT_ROWB + ch * 16) = kv; *(LAS v4u*)(lds + AT_VOFF + row * AT_ROWB + ch * 16) = vv; }
    __syncthreads();
    const int l15 = lane & 15, g = lane >> 4, kb0 = 32 * wave;
    bf16x8 qf[2][2];
#pragma unroll
    for (int cb = 0; cb < 2; ++cb) { const size_t tq = (size_t)r + (size_t)d * (q0 + 32 * wave + 16 * cb + l15); const bf16* qp = Q + tq * DATT + h * 64 + 8 * g; qf[cb][0] = ld8(qp); qf[cb][1] = ld8(qp + 32); }
    f32x4 s[2][10];
#pragma unroll
    for (int pp = 0; pp < 5; ++pp)
#pragma unroll
        for (int hb = 0; hb < 2; ++hb) {
            const int kw = kb0 + 32 * pp + 8 * (l15 >> 2) + 4 * hb + (l15 & 3);
            const LAS unsigned char* kp = lds + kw * AT_ROWB + 16 * g;
            const bf16x8 a0 = *(const LAS bf16x8*)kp, a1 = *(const LAS bf16x8*)(kp + 64);
#pragma unroll
            for (int cb = 0; cb < 2; ++cb) { f32x4 z = {0.f, 0.f, 0.f, 0.f}; z = MFMA16(a0, qf[cb][0], z); z = MFMA16(a1, qf[cb][1], z); s[cb][2 * pp + hb] = z; }
        }
    float mx[2], ls[2];
#pragma unroll
    for (int cb = 0; cb < 2; ++cb) {
        const int qi = 32 * wave + 16 * cb + l15; float m = -1e30f;
#pragma unroll
        for (int i = 0; i < 10; ++i)
#pragma unroll
            for (int e = 0; e < 4; ++e) { const int kw = kb0 + 32 * (i >> 1) + 8 * g + 4 * (i & 1) + e; const bool valid = (kw >= qi) && (kw <= qi + 128) && (k0 + kw >= 0);
                const float v = valid ? s[cb][i][e] : -1e30f; s[cb][i][e] = v; m = fmaxf(m, v); }
        m = fmaxf(m, __shfl_xor(m, 16)); m = fmaxf(m, __shfl_xor(m, 32));
        float l = 0.f;
#pragma unroll
        for (int i = 0; i < 10; ++i)
#pragma unroll
            for (int e = 0; e < 4; ++e) { const float p = __builtin_amdgcn_exp2f(s[cb][i][e] - m); s[cb][i][e] = p; l += p; }
        l += __shfl_xor(l, 16); l += __shfl_xor(l, 32);
        mx[cb] = m; ls[cb] = l;
    }
    f32x4 o[2][4];
#pragma unroll
    for (int cb = 0; cb < 2; ++cb)
#pragma unroll
        for (int nb = 0; nb < 4; ++nb) o[cb][nb] = (f32x4){0.f, 0.f, 0.f, 0.f};
#pragma unroll
    for (int pp = 0; pp < 5; ++pp) {
        bf16x8 pb[2];
#pragma unroll
        for (int cb = 0; cb < 2; ++cb) { v4u pw; pw.x = pk2(s[cb][2 * pp][0], s[cb][2 * pp][1]); pw.y = pk2(s[cb][2 * pp][2], s[cb][2 * pp][3]); pw.z = pk2(s[cb][2 * pp + 1][0], s[cb][2 * pp + 1][1]); pw.w = pk2(s[cb][2 * pp + 1][2], s[cb][2 * pp + 1][3]);
            pb[cb] = __builtin_bit_cast(bf16x8, pw); }
        const LAS unsigned char* vp = lds + AT_VOFF + (kb0 + 32 * pp + 8 * g + (l15 >> 2)) * AT_ROWB + 8 * (l15 & 3);
#pragma unroll
        for (int nb = 0; nb < 4; ++nb) { const s16x4 t0 = lds_tr(vp + 32 * nb), t1 = lds_tr(vp + 4 * AT_ROWB + 32 * nb);
            const bf16x8 av = {t0[0], t0[1], t0[2], t0[3], t1[0], t1[1], t1[2], t1[3]};
#pragma unroll
            for (int cb = 0; cb < 2; ++cb) o[cb][nb] = MFMA16(av, pb[cb], o[cb][nb]); }
    }
    bf16* OP = (bf16*)(ws + WS_OP); float* ML = (float*)(ws + WS_ML);
#pragma unroll
    for (int cb = 0; cb < 2; ++cb) { const size_t tq = (size_t)r + (size_t)d * (q0 + 32 * wave + 16 * cb + l15); const size_t rowi = ((size_t)G * SEQ + tq) * NH + h; const float inv = 1.0f / ls[cb];
#pragma unroll
        for (int nb = 0; nb < 4; ++nb) { const f32x4 v = o[cb][nb] * inv; v2u w; w.x = pk2(v[0], v[1]); w.y = pk2(v[2], v[3]); *(v2u*)(OP + rowi * 64 + 16 * nb + 4 * g) = w; }
        if (g == 0) *(f32x2*)(ML + rowi * 2) = (f32x2){mx[cb], ls[cb]}; }
    __syncthreads();
}
constexpr int AT4_VOFF = 256 * AT_ROWB;
__device__ __forceinline__ void sync4(LAS unsigned* cnt, unsigned& epoch, const int lane) {
    asm volatile("s_waitcnt vmcnt(0) lgkmcnt(0)" ::: "memory");
    epoch += 4u;
    if (lane == 0) __hip_atomic_fetch_add(cnt, 1u, __ATOMIC_RELAXED, __HIP_MEMORY_SCOPE_WORKGROUP);
    for (unsigned sp = 0; __hip_atomic_load(cnt, __ATOMIC_RELAXED, __HIP_MEMORY_SCOPE_WORKGROUP) < epoch && sp < (1u << 22); ++sp) __builtin_amdgcn_s_sleep(1);
    asm volatile("s_waitcnt lgkmcnt(0)" ::: "memory");
}
struct AttU { int G, h, r, d, q0, k0, edge; };
__device__ __forceinline__ AttU att_decode(const int unit) {
    AttU a; a.G = unit >> 10; const int u = unit & 1023, rest = u & 127; a.h = u >> 7; int sb;
    if (a.G == 0) { a.d = 1; a.r = 0; sb = rest; } else if (a.G == 1) { a.d = 4; a.r = rest >> 5; sb = rest & 31; } else { a.d = 16; a.r = rest >> 3; sb = rest & 7; }
    a.q0 = sb * 128; a.k0 = a.q0 - 128; a.edge = (sb == 0); return a;
}
__device__ __forceinline__ void att_load(unsigned char* ws, const AttU& a, const int tid4, v4u (&kv)[8], v4u (&vv)[8]) {
    const bf16* Kb = (const bf16*)(ws + WS_K) + a.h * 64; const bf16* Vb = (const bf16*)(ws + WS_VT) + a.h * 64;
#pragma unroll
    for (int i = 0; i < 8; ++i) { const int c = tid4 + 256 * i, row = c >> 3, ch = c & 7; int kk = a.k0 + row; kk = kk < 0 ? 0 : kk;
        const size_t off = (size_t)(a.r + a.d * kk) * DATT + ch * 8; kv[i] = *(const v4u*)(Kb + off); vv[i] = *(const v4u*)(Vb + off); }
}
__device__ __forceinline__ void att_store(LAS unsigned char* lds, const int tid4, const v4u (&kv)[8], const v4u (&vv)[8]) {
#pragma unroll
    for (int i = 0; i < 8; ++i) { const int c = tid4 + 256 * i, row = c >> 3, ch = c & 7;
        *(LAS v4u*)(lds + row * AT_ROWB + ch * 16) = kv[i]; *(LAS v4u*)(lds + AT4_VOFF + row * AT_ROWB + ch * 16) = vv[i]; }
}
__device__ __forceinline__ void attn_unit4_compute(unsigned char* ws, LAS unsigned char* lds, const AttU& au, const int wave, const int lane, const bool pf, const AttU& nxt, const int tid4, v4u (&kv)[8], v4u (&vv)[8]) {
    const int G = au.G, h = au.h, r = au.r, d = au.d, q0 = au.q0, k0 = au.k0; const bool edge = au.edge != 0;
    const bf16* Q = (const bf16*)(ws + WS_Q);
    const int l15 = lane & 15, g = lane >> 4, kb0 = 32 * wave;
    bf16x8 qf[2][2];
#pragma unroll
    for (int cb = 0; cb < 2; ++cb) { const size_t tq = (size_t)r + (size_t)d * (q0 + 32 * wave + 16 * cb + l15); const bf16* qp = Q + tq * DATT + h * 64 + 8 * g; qf[cb][0] = ld8(qp); qf[cb][1] = ld8(qp + 32); }
    float mx[2], ls[2]; bf16x8 pb[2][5];
#pragma unroll
    for (int cb = 0; cb < 2; ++cb) {
        f32x4 s[10];
#pragma unroll
        for (int pp = 0; pp < 5; ++pp)
#pragma unroll
            for (int hb = 0; hb < 2; ++hb) {
                const int kw = kb0 + 32 * pp + 8 * (l15 >> 2) + 4 * hb + (l15 & 3);
                const LAS unsigned char* kp = lds + kw * AT_ROWB + 16 * g;
                const bf16x8 a0 = *(const LAS bf16x8*)kp, a1 = *(const LAS bf16x8*)(kp + 64);
                f32x4 z = {0.f, 0.f, 0.f, 0.f}; z = MFMA16(a0, qf[cb][0], z); z = MFMA16(a1, qf[cb][1], z); s[2 * pp + hb] = z;
            }
        const int qi = 32 * wave + 16 * cb + l15; float m = -1e30f;
#pragma unroll
        for (int i = 0; i < 10; ++i) {
            const bool interior = (i >= 2 && i < 8);
            if (!interior || edge) {
#pragma unroll
                for (int e = 0; e < 4; ++e) { const int kw = kb0 + 32 * (i >> 1) + 8 * g + 4 * (i & 1) + e; const bool valid = (kw >= qi) && (kw <= qi + 128) && (k0 + kw >= 0);
                    s[i][e] = valid ? s[i][e] : -1e30f; }
            }
#pragma unroll
            for (int e = 0; e < 4; ++e) m = fmaxf(m, s[i][e]);
        }
        m = fmaxf(m, __shfl_xor(m, 16)); m = fmaxf(m, __shfl_xor(m, 32));
        float l = 0.f;
#pragma unroll
        for (int i = 0; i < 10; ++i)
#pragma unroll
            for (int e = 0; e < 4; ++e) { const float p = __builtin_amdgcn_exp2f(s[i][e] - m); s[i][e] = p; l += p; }
        l += __shfl_xor(l, 16); l += __shfl_xor(l, 32);
        mx[cb] = m; ls[cb] = l;
#pragma unroll
        for (int pp = 0; pp < 5; ++pp) { v4u pw; pw.x = pk2(s[2 * pp][0], s[2 * pp][1]); pw.y = pk2(s[2 * pp][2], s[2 * pp][3]); pw.z = pk2(s[2 * pp + 1][0], s[2 * pp + 1][1]); pw.w = pk2(s[2 * pp + 1][2], s[2 * pp + 1][3]);
            pb[cb][pp] = __builtin_bit_cast(bf16x8, pw); }
    }
    if (pf) att_load(ws, nxt, tid4, kv, vv);
    f32x4 o[2][4];
#pragma unroll
    for (int cb = 0; cb < 2; ++cb)
#pragma unroll
        for (int nb = 0; nb < 4; ++nb) o[cb][nb] = (f32x4){0.f, 0.f, 0.f, 0.f};
#pragma unroll
    for (int pp = 0; pp < 5; ++pp) {
        const LAS unsigned char* vp = lds + AT4_VOFF + (kb0 + 32 * pp + 8 * g + (l15 >> 2)) * AT_ROWB + 8 * (l15 & 3);
#pragma unroll
        for (int nb = 0; nb < 4; ++nb) { const s16x4 t0 = lds_tr(vp + 32 * nb), t1 = lds_tr(vp + 4 * AT_ROWB + 32 * nb);
            const bf16x8 av = {t0[0], t0[1], t0[2], t0[3], t1[0], t1[1], t1[2], t1[3]};
#pragma unroll
            for (int cb = 0; cb < 2; ++cb) o[cb][nb] = MFMA16(av, pb[cb][pp], o[cb][nb]); }
    }
    bf16* OP = (bf16*)(ws + WS_OP); float* ML = (float*)(ws + WS_ML);
#pragma unroll
    for (int cb = 0; cb < 2; ++cb) { const size_t tq = (size_t)r + (size_t)d * (q0 + 32 * wave + 16 * cb + l15); const size_t rowi = ((size_t)G * SEQ + tq) * NH + h; const float inv = 1.0f / ls[cb];
#pragma unroll
        for (int nb = 0; nb < 4; ++nb) { const f32x4 v = o[cb][nb] * inv; v2u w; w.x = pk2(v[0], v[1]); w.y = pk2(v[2], v[3]); *(v2u*)(OP + rowi * 64 + 16 * nb + 4 * g) = w; }
        if (g == 0) *(f32x2*)(ML + rowi * 2) = (f32x2){mx[cb], ls[cb]}; }
}
__device__ __forceinline__ void attn_units4(unsigned char* ws, LAS unsigned char* lds, LAS unsigned* cnt, unsigned& epoch, const int u0, const int ustride, const int nunits, const int tid4, const int wave, const int lane) {
    if (u0 >= nunits) return;
    v4u kv[8], vv[8];
    AttU cur = att_decode(u0 % 3072); att_load(ws, cur, tid4, kv, vv);
    for (int u = u0; u < nunits; u += ustride) {
        sync4(cnt, epoch, lane);
        att_store(lds, tid4, kv, vv);
        sync4(cnt, epoch, lane);
        const int un = u + ustride; AttU nxt = cur; const bool pf = un < nunits;
        if (pf) nxt = att_decode(un % 3072);
        attn_unit4_compute(ws, lds, cur, wave, lane, pf, nxt, tid4, kv, vv);
        cur = nxt;
    }
}
__device__ __forceinline__ void attn_combine(unsigned char* ws, const int t, const int lane) {
    const bf16* OP = (const bf16*)(ws + WS_OP); const float* ML = (const float*)(ws + WS_ML); bf16* MIX = (bf16*)(ws + WS_MIX);
    const int h = lane >> 3, dg = lane & 7;
    f32x2 ml[3]; v4u ov[3];
#pragma unroll
    for (int G = 0; G < 3; ++G) { const size_t rowi = ((size_t)G * SEQ + t) * NH + h; ml[G] = *(const f32x2*)(ML + rowi * 2); ov[G] = *(const v4u*)(OP + rowi * 64 + 8 * dg); }
    const float M = fmaxf(ml[0].x, fmaxf(ml[1].x, ml[2].x));
    float w[3], ws_ = 0.f;
#pragma unroll
    for (int G = 0; G < 3; ++G) { w[G] = ml[G].y * __builtin_amdgcn_exp2f(ml[G].x - M); ws_ += w[G]; }
    const float inv = 1.0f / ws_;
    float acc[8];
#pragma unroll
    for (int i = 0; i < 8; ++i) acc[i] = 0.f;
#pragma unroll
    for (int G = 0; G < 3; ++G) { const float wg = w[G] * inv;
#pragma unroll
        for (int i = 0; i < 4; ++i) { const unsigned x = ov[G][i]; acc[2 * i] += wg * __builtin_bit_cast(float, x << 16); acc[2 * i + 1] += wg * __builtin_bit_cast(float, x & 0xffff0000u); } }
    v4u o; o.x = pk2(acc[0], acc[1]); o.y = pk2(acc[2], acc[3]); o.z = pk2(acc[4], acc[5]); o.w = pk2(acc[6], acc[7]);
    *(v4u*)(MIX + pg8::blk_off(t, h * 64 + 8 * dg, DM)) = o;
}
__device__ __forceinline__ void attn_sample_item(const Args& A, unsigned char* ws, const int item, const int lane) {
    const int s = item & 7, h = (item >> 3) & 7, b = item >> 6; const int part = lane & 3, ks = lane >> 2;
    const float* SQ = (const float*)(ws + WS_SQKV); bf16* MIX = (bf16*)(ws + WS_MIX);
    f32x4 qv[4];
#pragma unroll
    for (int i = 0; i < 4; ++i) qv[i] = *(const f32x4*)(SQ + (size_t)(b * 8 + s) * 1536 + h * 64 + 16 * i + 4 * part);
    float m = -1e30f, l = 0.f; f32x4 o[4];
#pragma unroll
    for (int i = 0; i < 4; ++i) o[i] = (f32x4){0.f, 0.f, 0.f, 0.f};
#define SMP_LOAD(RND, KV, VV) do { const int e_ = 16 * (RND) + ks; const int ec_ = e_ < 387 ? e_ : 0; const int G_ = ec_ / 129, j_ = ec_ - 129 * G_; const int idx_ = WBUF + s - (j_ << (2 * G_)); \
        const bool inb_ = idx_ < WBUF; \
        const size_t coff_ = (((size_t)b * WBUF + (inb_ ? idx_ : 0)) * NH + h) * HD + 4 * part, noff_ = (size_t)(b * 8 + (inb_ ? 0 : idx_ - WBUF)) * 1536 + h * 64 + 4 * part; \
        const float* kp_ = inb_ ? A.in[I_CK] + coff_ : SQ + noff_ + 512; const float* vp_ = inb_ ? A.in[I_CV] + coff_ : SQ + noff_ + 1024; \
        if ((RND) >= 17) { _Pragma("unroll") for (int i = 0; i < 4; ++i) { KV[i] = __builtin_nontemporal_load((const f32x4*)(kp_ + 16 * i)); VV[i] = __builtin_nontemporal_load((const f32x4*)(vp_ + 16 * i)); } }     \
        else { _Pragma("unroll") for (int i = 0; i < 4; ++i) { KV[i] = *(const f32x4*)(kp_ + 16 * i); VV[i] = *(const f32x4*)(vp_ + 16 * i); } } } while (0)
    f32x4 kc[4], vc[4], kn[4], vn[4];
    SMP_LOAD(0, kc, vc);
#pragma unroll 1
    for (int rnd = 0; rnd < 25; ++rnd) {
        const int rn = rnd + 1 < 25 ? rnd + 1 : 24;
        SMP_LOAD(rn, kn, vn);
        const bool valid = 16 * rnd + ks < 387;
        float d = 0.f;
#pragma unroll
        for (int i = 0; i < 4; ++i) d += (qv[i].x * kc[i].x + qv[i].y * kc[i].y) + (qv[i].z * kc[i].z + qv[i].w * kc[i].w);
        d += __shfl_xor(d, 1); d += __shfl_xor(d, 2);
        d = valid ? d : -1e30f;
        const float mn = fmaxf(m, d), alpha = __builtin_amdgcn_exp2f(m - mn), p = __builtin_amdgcn_exp2f(d - mn);
        l = l * alpha + p; m = mn;
#pragma unroll
        for (int i = 0; i < 4; ++i) { o[i] = o[i] * alpha + p * vc[i]; kc[i] = kn[i]; vc[i] = vn[i]; }
    }
#undef SMP_LOAD
    float M = m;
#pragma unroll
    for (int off = 4; off < 64; off <<= 1) M = fmaxf(M, __shfl_xor(M, off));
    const float scl = __builtin_amdgcn_exp2f(m - M); l *= scl;
#pragma unroll
    for (int off = 4; off < 64; off <<= 1) l += __shfl_xor(l, off);
    const float inv = 1.0f / l;
#pragma unroll
    for (int i = 0; i < 4; ++i) { f32x4 v = o[i] * scl;
#pragma unroll
        for (int off = 4; off < 64; off <<= 1)
#pragma unroll
            for (int e = 0; e < 4; ++e) v[e] += __shfl_xor(v[e], off);
        if (ks == 0) { v2u w; w.x = pk2(v[0] * inv, v[1] * inv); w.y = pk2(v[2] * inv, v[3] * inv);
            *(v2u*)(MIX + pg8::blk_off(MP + b * 8 + s, h * 64 + 16 * i + 4 * part, DM)) = w; } }
}


template <int SH> __device__ __forceinline__ float dpp_shr_t(float v) {
    return __builtin_bit_cast(float, __builtin_amdgcn_update_dpp(0, __builtin_bit_cast(int, v), 0x110 + SH, 0xf, 0xf, true));
}
template <int ROT> __device__ __forceinline__ float dpp_ror_t(float v) {
    return __builtin_bit_cast(float, __builtin_amdgcn_update_dpp(0, __builtin_bit_cast(int, v), 0x120 + ROT, 0xf, 0xf, false));
}
__device__ __forceinline__ void ssm_pass1_unit(unsigned char* ws, const int grp, const int chunk, const int lane) {
    const int t = lane & 15, g = lane >> 4; const int m0 = chunk * CHUNK;
    const bf16* U = (const bf16*)(ws + WS_U); const unsigned char* T = ws + WS_SSMT;
    const bf16* ABAR = (const bf16*)(T + ST_ABAR); const float* CP = (const float*)(T + ST_CP);
    bf16x8 ub[8];
#pragma unroll
    for (int blk = 0; blk < 8; ++blk) { bf16x8 z = {0, 0, 0, 0, 0, 0, 0, 0}; if (g < 2) z = ld8(U + (size_t)(m0 + 16 * blk + t) * DSSM + 16 * grp + 8 * g); ub[blk] = z; }
#pragma unroll 1
    for (int pr = 0; pr < 4; ++pr) {
        const bf16x8 are = ld8(ABAR + ((size_t)(grp * 8 + 2 * pr) * 64 + lane) * 8), aim = ld8(ABAR + ((size_t)(grp * 8 + 2 * pr + 1) * 64 + lane) * 8);
        const int p0 = 16 * pr + 4 * g;
        float wr_[4], wi_[4], l16r[4], l16i[4], sr[4], si[4];
#pragma unroll
        for (int i = 0; i < 4; ++i) { const float* cp = CP + (size_t)(grp * 64 + p0 + i) * 32;
            const f32x2 w = *(const f32x2*)(cp + 2 * (t == 15 ? 0 : 14 - t)); wr_[i] = (t == 15) ? 1.0f : w.x; wi_[i] = (t == 15) ? 0.0f : w.y;
            const f32x2 l = *(const f32x2*)(cp + 30); l16r[i] = l.x; l16i[i] = l.y; sr[i] = 0.f; si[i] = 0.f; }
#pragma unroll
        for (int blk = 0; blk < 8; ++blk) {
            const f32x4 z4 = {0.f, 0.f, 0.f, 0.f};
            const f32x4 hre = MFMA16(are, ub[blk], z4), him = MFMA16(aim, ub[blk], z4);
#pragma unroll
            for (int i = 0; i < 4; ++i) {
                float pr_ = wr_[i] * hre[i] - wi_[i] * him[i], pi_ = wr_[i] * him[i] + wi_[i] * hre[i];
                pr_ += dpp_ror_t<8>(pr_); pi_ += dpp_ror_t<8>(pi_); pr_ += dpp_ror_t<4>(pr_); pi_ += dpp_ror_t<4>(pi_);
                pr_ += dpp_ror_t<2>(pr_); pi_ += dpp_ror_t<2>(pi_); pr_ += dpp_ror_t<1>(pr_); pi_ += dpp_ror_t<1>(pi_);
                const float nr = l16r[i] * sr[i] - l16i[i] * si[i] + pr_, ni = l16r[i] * si[i] + l16i[i] * sr[i] + pi_; sr[i] = nr; si[i] = ni;
            }
        }
        if (t == 0) { float* CS = (float*)(ws + WS_CS) + ((size_t)(chunk * NG + grp) * NP + p0) * 2;
            *(f32x4*)CS = (f32x4){sr[0], si[0], sr[1], si[1]}; *(f32x4*)(CS + 4) = (f32x4){sr[2], si[2], sr[3], si[3]}; }
    }
}
template <bool PASS2, bool SAMPLE, int NBLK>
__device__ __forceinline__ void ssm_unit(const Args& A, unsigned char* ws, const int grp, const int chunk, const LAS float* carr, const int lane) {
    const int t = lane & 15, g = lane >> 4, tt = SAMPLE ? (t & 7) : t;
    const int m0 = SAMPLE ? MP + chunk * (16 * NBLK) : chunk * (16 * NBLK);
    const bf16* U = (const bf16*)(ws + WS_U); bf16* GB = (bf16*)(ws + WS_GB);
    const unsigned char* T = ws + WS_SSMT;
    const bf16* ABAR = (const bf16*)(T + ST_ABAR); const bf16* CMt = (const bf16*)(T + ST_CM);
    const float* PW = (const float*)(T + ST_PW); const float* CP = (const float*)(T + ST_CP);
    bf16x8 ub[NBLK];
#pragma unroll
    for (int blk = 0; blk < NBLK; ++blk) { bf16x8 z = {0, 0, 0, 0, 0, 0, 0, 0}; if (g < 2) z = ld8(U + (size_t)(m0 + 16 * blk + t) * DSSM + 16 * grp + 8 * g); ub[blk] = z; }
    f32x4 yacc[NBLK];
#pragma unroll
    for (int blk = 0; blk < NBLK; ++blk) yacc[blk] = (f32x4){0.f, 0.f, 0.f, 0.f};
#pragma unroll 1
    for (int pr = 0; pr < 4; ++pr) {
        const bf16x8 are = ld8(ABAR + ((size_t)(grp * 8 + 2 * pr) * 64 + lane) * 8), aim = ld8(ABAR + ((size_t)(grp * 8 + 2 * pr + 1) * 64 + lane) * 8);
        bf16x8 cm = {0, 0, 0, 0, 0, 0, 0, 0}; if (PASS2) cm = ld8(CMt + ((size_t)(grp * 4 + pr) * 64 + lane) * 8);
        const int p0 = 16 * pr + 4 * g;
        float pwr[4][4], pwi[4][4], cpr[4], cpi[4];
#pragma unroll
        for (int i = 0; i < 4; ++i) { const f32x4 a = *(const f32x4*)(PW + (size_t)(grp * 64 + p0 + i) * 8), b = *(const f32x4*)(PW + (size_t)(grp * 64 + p0 + i) * 8 + 4);
            pwr[i][0] = a.x; pwi[i][0] = a.y; pwr[i][1] = a.z; pwi[i][1] = a.w; pwr[i][2] = b.x; pwi[i][2] = b.y; pwr[i][3] = b.z; pwi[i][3] = b.w;
            const f32x2 c = *(const f32x2*)(CP + (size_t)(grp * 64 + p0 + i) * 32 + 2 * tt); cpr[i] = c.x; cpi[i] = c.y; }
        float cre[4], cim[4];
#pragma unroll
        for (int i = 0; i < 4; ++i) { cre[i] = 0.f; cim[i] = 0.f; }
        if (!SAMPLE && PASS2) {
#pragma unroll
            for (int i = 0; i < 4; ++i) { const f32x2 c = *(const LAS f32x2*)(carr + (size_t)(chunk * 64 + p0 + i) * 2); cre[i] = c.x; cim[i] = c.y; }
        }
#pragma unroll
        for (int blk = 0; blk < NBLK; ++blk) {
            int bsm = 0;
            if (SAMPLE) { bsm = ((m0 - MP + 16 * blk) >> 3) + (t >> 3);
                const f32x4 hr = *(const f32x4*)(A.in[I_SRE] + (size_t)(bsm * NG + grp) * NP + p0), hi = *(const f32x4*)(A.in[I_SIM] + (size_t)(bsm * NG + grp) * NP + p0);
#pragma unroll
                for (int i = 0; i < 4; ++i) { cre[i] = hr[i]; cim[i] = hi[i]; } }
            const f32x4 z4 = {0.f, 0.f, 0.f, 0.f};
            f32x4 hre = MFMA16(are, ub[blk], z4), him = MFMA16(aim, ub[blk], z4);
#define SSM_STEP(K_, SH_) { const bool keep = !SAMPLE || (tt >= SH_); \
                _Pragma("unroll") for (int i = 0; i < 4; ++i) { float sr = dpp_shr_t<SH_>(hre[i]), si = dpp_shr_t<SH_>(him[i]); if (!keep) { sr = 0.f; si = 0.f; } \
                    const float nr = hre[i] + pwr[i][K_] * sr - pwi[i][K_] * si, ni = him[i] + pwr[i][K_] * si + pwi[i][K_] * sr; hre[i] = nr; him[i] = ni; } }
            SSM_STEP(0, 1) SSM_STEP(1, 2) SSM_STEP(2, 4)
            if (!SAMPLE) SSM_STEP(3, 8)
#undef SSM_STEP
#pragma unroll
            for (int i = 0; i < 4; ++i) { const float nr = hre[i] + cpr[i] * cre[i] - cpi[i] * cim[i], ni = him[i] + cpr[i] * cim[i] + cpi[i] * cre[i]; hre[i] = nr; him[i] = ni; }
            if (!SAMPLE) {
#pragma unroll
                for (int i = 0; i < 4; ++i) { cre[i] = __shfl(hre[i], (lane & 48) | 15); cim[i] = __shfl(him[i], (lane & 48) | 15); }
            } else if (tt == 7) {
                *(f32x4*)(A.out + O_HRS + (size_t)(bsm * NG + grp) * NP + p0) = hre; *(f32x4*)(A.out + O_HIS + (size_t)(bsm * NG + grp) * NP + p0) = him;
            }
            if (PASS2) { v4u hw; hw.x = pk2(hre[0], hre[1]); hw.y = pk2(hre[2], hre[3]); hw.z = pk2(him[0], him[1]); hw.w = pk2(him[2], him[3]);
                yacc[blk] = MFMA16(cm, __builtin_bit_cast(bf16x8, hw), yacc[blk]); }
        }
        if (!PASS2 && !SAMPLE && t == 15) {
            float* CS = (float*)(ws + WS_CS) + ((size_t)(chunk * NG + grp) * NP + p0) * 2;
            *(f32x4*)CS = (f32x4){cre[0], cim[0], cre[1], cim[1]}; *(f32x4*)(CS + 4) = (f32x4){cre[2], cim[2], cre[3], cim[3]};
        }
    }
    if (PASS2) {
        const f32x4 dv = *(const f32x4*)(A.in[I_SD] + 16 * grp + 4 * g);
#pragma unroll
        for (int blk = 0; blk < NBLK; ++blk) { const size_t off = (size_t)(m0 + 16 * blk + t) * DSSM + 16 * grp + 4 * g;
            const v2u uw = *(const v2u*)(U + off);
            const float u0 = __builtin_bit_cast(float, uw.x << 16), u1 = __builtin_bit_cast(float, uw.x & 0xffff0000u), u2 = __builtin_bit_cast(float, uw.y << 16), u3 = __builtin_bit_cast(float, uw.y & 0xffff0000u);
            const float y0 = gelu_tanh(yacc[blk][0] + dv[0] * u0), y1 = gelu_tanh(yacc[blk][1] + dv[1] * u1), y2 = gelu_tanh(yacc[blk][2] + dv[2] * u2), y3 = gelu_tanh(yacc[blk][3] + dv[3] * u3);
            v2u w; w.x = pk2(y0, y1); w.y = pk2(y2, y3); *(v2u*)(GB + pg8::blk_off(m0 + 16 * blk + t, 16 * grp + 4 * g, DSSM)) = w; }
    }
}

constexpr int N_PHASES = 15;
__global__ void __launch_bounds__(NWAVES * 64, 2) hymba_fwd(Args args) {
    extern __shared__ __attribute__((aligned(16))) unsigned char lds[];
    Frame F;
    F.lds = (LAS unsigned char*)lds;
    F.MISC = (volatile LAS unsigned*)(F.lds + MISC_OFF);
    F.tid = threadIdx.x; F.lane = F.tid & 63; F.wave = __builtin_amdgcn_readfirstlane(F.tid >> 6);
    F.G = gridDim.x; { const int bx = blockIdx.x; F.vcu = (F.G % 8 == 0) ? (bx % 8) * (F.G / 8) + bx / 8 : bx; }
    unsigned char* ws = args.ws;
    F.ctl = (gu32*)(ws + WS_CTL);
    for (int u = F.tid; u < (LDS_BYTES - LDSCTL_OFF) / 4; u += NWAVES * 64) ((LAS unsigned*)(F.lds + LDSCTL_OFF))[u] = 0u;
    __syncthreads();
    XcdBarrier bar = xcd_barrier_post((unsigned*)(F.ctl + CW_BAR), F.MISC + 8);
    const int lo = args.ph_lo, hi = args.ph_hi;
#ifndef PHASE_MASK
#define PHASE_MASK 0x7fff
#endif
#define IN(k) (((PHASE_MASK >> (k)) & 1) && lo <= (k) && (k) < hi)
#define SEAM(k) do { if (IN(k) && IN((k) + 1)) xcd_barrier(bar); } while (0)
#ifndef REPEAT_MASK
#define REPEAT_MASK 0
#endif
#define REP(k) for (int rep_ = 0; rep_ <= ((REPEAT_MASK >> (k)) & 1); ++rep_, ((rep_ <= ((REPEAT_MASK >> (k)) & 1)) ? xcd_barrier(bar) : (void)0))
    bf16* XN = (bf16*)(ws + WS_XN); bf16* HB = (bf16*)(ws + WS_H); float* X1 = (float*)(ws + WS_X1); float* X2 = (float*)(ws + WS_X2);
    float* ADA = (float*)(ws + WS_ADA); float* SLAB = (float*)(ws + WS_SLAB);
    const int gw = F.vcu * NWAVES + F.wave, NGW = F.G * NWAVES;
    const bool fastcopy = (F.G == 256);
    pg8::CopyJob CJ; { const int seg = (int)blockIdx.x & 255, kv = seg >> 7, b = seg & 127; const size_t eo = ((size_t)b * (WBUF * DATT)) * 4 + (size_t)F.wave * 1024;
        CJ.src = (const char*)args.in[kv ? I_CV : I_CK] + (size_t)DSEQ * DATT * 4 + eo; CJ.dst = (char*)(args.out + (kv ? O_VS : O_KS)) + eo; CJ.cur = 0; CJ.end = (fastcopy && !args.nocopy) ? 510 : 0; CJ.dummy = (unsigned*)(F.ctl + 2048 + 64 * F.wave); }

    if (IN(0)) REP(0) if ((F.lane = (int)__builtin_amdgcn_mbcnt_hi(~0u, __builtin_amdgcn_mbcnt_lo(~0u, 0u)), F.tid = F.wave * 64 + F.lane, true)) { p0_prologue(F, args); }
    SEAM(0);
    if (IN(1)) REP(1) if ((F.lane = (int)__builtin_amdgcn_mbcnt_hi(~0u, __builtin_amdgcn_mbcnt_lo(~0u, 0u)), F.tid = F.wave * 64 + F.lane, true)) {
        pg8::Gemm g{(const bf16*)(ws + WS_SC), (const bf16*)(ws + WS_WADA), 256, NADA, DM}; pg8::Order2 S; S.init(256, NADA, DM, F.G, (int)blockIdx.x);
        pg8::EpiF32 E{ADA, NADA, args.in[I_BADA]};
        pg8::gemm_phase2<pg8::EpiF32, pg8::Order2, true, false>(F.lds + RING_OFF, g, S, E, CJ, F.wave);
        const int nun = NADA / 256;
        const int nworker = (F.G > nun) ? (F.G - nun) : F.G, widx = (F.G > nun) ? ((int)blockIdx.x - nun) : (int)blockIdx.x;
        if (widx >= 0) p1_weights(F, args, widx * NWAVES + F.wave, nworker * NWAVES);
        if (!fastcopy && widx >= 0) copy_tiles(args, widx * NWAVES + F.wave, nworker * NWAVES, F.lane);
    }
    SEAM(1);
    if (IN(2)) REP(2) if ((F.lane = (int)__builtin_amdgcn_mbcnt_hi(~0u, __builtin_amdgcn_mbcnt_lo(~0u, 0u)), F.tid = F.wave * 64 + F.lane, true)) norm_mod_rows<true, 0, 8, false>(F, args.in[I_XP], args.in[I_XS], args.in[I_GF1], ADA, 0 * DM, 1 * DM, XN, Combine{nullptr, 0, nullptr, 0, 0.f, nullptr}, ws + WS_XN8, (float*)(ws + WS_SA));
    SEAM(2);
    if (IN(3)) REP(3) if ((F.lane = (int)__builtin_amdgcn_mbcnt_hi(~0u, __builtin_amdgcn_mbcnt_lo(~0u, 0u)), F.tid = F.wave * 64 + F.lane, true)) {
        pg8::Gemm g{(const bf16*)(ws + WS_XN8), (const bf16*)(ws + WS_W1T8), MTOT, 2 * DFF, DM / 2}; pg8::Order2 S; S.init(MTOT, 2 * DFF, DM / 2, F.G, (int)blockIdx.x);
        pg8::EpiGated8 E{HB, DFF, (const float*)(ws + WS_SA), (const unsigned*)(ws + WS_CTL) + CW_AMAX};
        pg8::gemm_phase2<pg8::EpiGated8, pg8::Order2, true, true, true>(F.lds + RING_OFF, g, S, E, CJ, F.wave);
    }
    SEAM(3);
    if (IN(4)) REP(4) if ((F.lane = (int)__builtin_amdgcn_mbcnt_hi(~0u, __builtin_amdgcn_mbcnt_lo(~0u, 0u)), F.tid = F.wave * 64 + F.lane, true)) {
        pg8::Gemm g{HB, (const bf16*)(ws + WS_W1D), MTOT, DM, DFF}; pg8::SplitOrder S; S.init(MP, DM, DFF, 11, F.G, (int)blockIdx.x);
        pg8::EpiResid<false, true> E{args.in[I_XP], args.in[I_XS], X1, ADA, 2 * DM, 0.5f, SLAB};
        pg8::gemm_phase2<pg8::EpiResid<false, true>, pg8::SplitOrder, true, true>(F.lds + RING_OFF, g, S, E, CJ, F.wave);
    }
    SEAM(4);
    if (IN(5)) REP(5) if ((F.lane = (int)__builtin_amdgcn_mbcnt_hi(~0u, __builtin_amdgcn_mbcnt_lo(~0u, 0u)), F.tid = F.wave * 64 + F.lane, true)) norm_mod_rows<false, 11, 4, true>(F, X1, X1 + (size_t)MP * DM, args.in[I_GMIX], ADA, 3 * DM, 4 * DM, XN, Combine{SLAB, 11, args.in[I_XS], 2 * DM, 0.5f, X1 + (size_t)MP * DM}, nullptr, nullptr);
    SEAM(5);
    if (IN(6)) REP(6) if ((F.lane = (int)__builtin_amdgcn_mbcnt_hi(~0u, __builtin_amdgcn_mbcnt_lo(~0u, 0u)), F.tid = F.wave * 64 + F.lane, true)) {
        pg8::Gemm g{XN, (const bf16*)(ws + WS_WIN), MTOT, 2048, DM}; pg8::Order2 S; S.init(MTOT, 2048, DM, F.G, (int)blockIdx.x);
        pg8::EpiInProj E{(bf16*)(ws + WS_Q), (bf16*)(ws + WS_K), (bf16*)(ws + WS_VT), (bf16*)(ws + WS_U), (float*)(ws + WS_SQKV), args.out, (const _Float16*)(ws + WS_ROPE), args.in[I_GQ], args.in[I_GK]};
        pg8::gemm_phase2<pg8::EpiInProj, pg8::Order2, true, false>(F.lds + RING_OFF, g, S, E, CJ, F.wave);
    }
    SEAM(6);
    if (IN(7)) REP(7) if ((F.lane = (int)__builtin_amdgcn_mbcnt_hi(~0u, __builtin_amdgcn_mbcnt_lo(~0u, 0u)), F.tid = F.wave * 64 + F.lane, true)) {
#ifndef P7R1
#define P7R1 0
#endif
#ifndef P7R2
#define P7R2 0
#endif
#ifndef P7R3
#define P7R3 0
#endif
#ifndef P7_PARTS
#define P7_PARTS 7
#endif
        const int p7m = args.pad ? args.pad : P7_PARTS;
        { const int hw = F.vcu * 4 + (F.wave & 3), NHW = F.G * 4;
          if (F.wave < 4) {
              unsigned epoch = 0u; LAS unsigned* cnt = (LAS unsigned*)(F.MISC + 16);
              if (p7m & 1) attn_units4(ws, F.lds + RING_OFF, cnt, epoch, F.vcu, F.G, 3072 * (1 + P7R1), F.tid, F.wave, F.lane);
              if (p7m & 2) for (int u = hw; u < NCHUNK_P * NG * (1 + P7R2); u += NHW) ssm_pass1_unit(ws, u & 31, (u >> 5) & 127, F.lane);
          } else { __builtin_amdgcn_s_setprio(3);
              if (p7m & 4) for (int a = hw; a < NBAT * NH * DSEQ * (1 + P7R3); a += NHW) attn_sample_item(args, ws, a & 8191, F.lane);
              __builtin_amdgcn_s_setprio(0); } }
    }
    SEAM(7);
    if (IN(8)) REP(8) if ((F.lane = (int)__builtin_amdgcn_mbcnt_hi(~0u, __builtin_amdgcn_mbcnt_lo(~0u, 0u)), F.tid = F.wave * 64 + F.lane, true)) {
        for (int t = gw; t < SEQ; t += NGW) attn_combine(ws, t, F.lane);
        LAS float* carr = (LAS float*)(F.lds + RING_OFF);
        LAS float* segE = carr + NCHUNK_P * 64 * 2;
        for (int item = F.vcu; item < 256; item += F.G) {
            const int grp = item & 31, sub = item >> 5;
            {
                const float* CS = (const float*)(ws + WS_CS); const float* CL = (const float*)(ws + WS_SSMT + ST_CL);
                const f32x2 lam = *(const f32x2*)(CL + (size_t)(grp * 64 + F.lane) * 2);
                f32x2 sv[16];
#pragma unroll
                for (int j = 0; j < 16; ++j) sv[j] = *(const f32x2*)(CS + ((size_t)((16 * F.wave + j) * NG + grp) * NP + F.lane) * 2);
                float lr[16], li[16]; float cr = 0.f, ci = 0.f;
#pragma unroll
                for (int j = 0; j < 16; ++j) { lr[j] = cr; li[j] = ci; const float nr = lam.x * cr - lam.y * ci + sv[j].x, ni = lam.x * ci + lam.y * cr + sv[j].y; cr = nr; ci = ni; }
                *(LAS f32x2*)(segE + (size_t)(F.wave * 64 + F.lane) * 2) = (f32x2){cr, ci};
                float sr = lam.x, si = lam.y;
#pragma unroll
                for (int q = 0; q < 4; ++q) { const float nr = sr * sr - si * si, ni = 2.f * sr * si; sr = nr; si = ni; }
                LDS_WAIT(); __syncthreads();
                float Cr = 0.f, Ci = 0.f;
                float Tr = 0.f, Ti = 0.f;
#pragma unroll
                for (int w = 0; w < 8; ++w) { const f32x2 e = *(const LAS f32x2*)(segE + (size_t)(w * 64 + F.lane) * 2);
                    if (w == F.wave) { Cr = Tr; Ci = Ti; }
                    const float nr = sr * Tr - si * Ti + e.x, ni = sr * Ti + si * Tr + e.y; Tr = nr; Ti = ni; }
                float pr_ = 1.f, pi_ = 0.f;
#pragma unroll
                for (int j = 0; j < 16; ++j) { const float ar_ = lr[j] + pr_ * Cr - pi_ * Ci, ai_ = li[j] + pr_ * Ci + pi_ * Cr;
                    *(LAS f32x2*)(carr + (size_t)((16 * F.wave + j) * 64 + F.lane) * 2) = (f32x2){ar_, ai_};
                    const float nr = pr_ * lam.x - pi_ * lam.y, ni = pr_ * lam.y + pi_ * lam.x; pr_ = nr; pi_ = ni; }
                if (sub == 0 && F.wave == 0) { args.out[O_HRP + grp * 64 + F.lane] = Tr; args.out[O_HIP + grp * 64 + F.lane] = Ti; }
                LDS_WAIT(); __syncthreads();
            }
            for (int k = F.wave; k < 16; k += NWAVES) { ssm_unit<true, false, 8>(args, ws, grp, sub + 8 * k, carr, F.lane); copy_back(CJ, 32, F.lane); }
            ssm_unit<true, true, 1>(args, ws, grp, sub + 8 * F.wave, nullptr, F.lane);
            copy_back(CJ, 24, F.lane);
            __syncthreads();
        }
    }
    SEAM(8);
    if (IN(9)) REP(9) if ((F.lane = (int)__builtin_amdgcn_mbcnt_hi(~0u, __builtin_amdgcn_mbcnt_lo(~0u, 0u)), F.tid = F.wave * 64 + F.lane, true)) {
        pg8::Gemm g{(const bf16*)(ws + WS_GB), (const bf16*)(ws + WS_WGLU), MTOT, 1024, DSSM}; pg8::Order2 S; S.init(MTOT, 1024, DSSM, F.G, (int)blockIdx.x);
        pg8::EpiGated<1> E{(bf16*)(ws + WS_MIX), DM, DATT};
        pg8::gemm_phase2<pg8::EpiGated<1>, pg8::Order2, true, false>(F.lds + RING_OFF, g, S, E, CJ, F.wave);
    }
    SEAM(9);
    if (IN(10)) REP(10) if ((F.lane = (int)__builtin_amdgcn_mbcnt_hi(~0u, __builtin_amdgcn_mbcnt_lo(~0u, 0u)), F.tid = F.wave * 64 + F.lane, true)) {
        pg8::Gemm g{(const bf16*)(ws + WS_MIX), (const bf16*)(ws + WS_WOUT), MTOT, DM, DM}; pg8::SplitOrder S; S.init(MP, DM, DM, 4, F.G, (int)blockIdx.x);
        pg8::EpiResid<true, true> E{X1, X1 + (size_t)MP * DM, X2, ADA, 5 * DM, 1.0f, SLAB};
        pg8::gemm_phase2<pg8::EpiResid<true, true>, pg8::SplitOrder, true, true>(F.lds + RING_OFF, g, S, E, CJ, F.wave);
    }
    SEAM(10);
    if (IN(11)) REP(11) if ((F.lane = (int)__builtin_amdgcn_mbcnt_hi(~0u, __builtin_amdgcn_mbcnt_lo(~0u, 0u)), F.tid = F.wave * 64 + F.lane, true)) norm_mod_rows<true, 4, 5, true>(F, X2, X2 + (size_t)MP * DM, args.in[I_GF2], ADA, 6 * DM, 7 * DM, XN, Combine{SLAB, 4, X1 + (size_t)MP * DM, 5 * DM, 1.0f, X2 + (size_t)MP * DM}, ws + WS_XN8, (float*)(ws + WS_SA));
    SEAM(11);
    if (IN(12)) REP(12) if ((F.lane = (int)__builtin_amdgcn_mbcnt_hi(~0u, __builtin_amdgcn_mbcnt_lo(~0u, 0u)), F.tid = F.wave * 64 + F.lane, true)) {
        pg8::Gemm g{(const bf16*)(ws + WS_XN8), (const bf16*)(ws + WS_W2T8), MTOT, 2 * DFF, DM / 2}; pg8::Order2 S; S.init(MTOT, 2 * DFF, DM / 2, F.G, (int)blockIdx.x);
        pg8::EpiGated8 E{HB, DFF, (const float*)(ws + WS_SA), (const unsigned*)(ws + WS_CTL) + CW_AMAX + 2};
        pg8::gemm_phase2<pg8::EpiGated8, pg8::Order2, true, true, true>(F.lds + RING_OFF, g, S, E, CJ, F.wave);
    }
    SEAM(12);
    if (IN(13)) REP(13) if ((F.lane = (int)__builtin_amdgcn_mbcnt_hi(~0u, __builtin_amdgcn_mbcnt_lo(~0u, 0u)), F.tid = F.wave * 64 + F.lane, true)) {
        pg8::Gemm g{HB, (const bf16*)(ws + WS_W2D), MTOT, DM, DFF}; pg8::SplitOrder S; S.init(MP, DM, DFF, 11, F.G, (int)blockIdx.x);
        pg8::EpiResid<true, false> E{X2, X2 + (size_t)MP * DM, args.out, ADA, 8 * DM, 0.5f, SLAB};
        pg8::gemm_phase2<pg8::EpiResid<true, false>, pg8::SplitOrder, true, true>(F.lds + RING_OFF, g, S, E, CJ, F.wave);
        copy_back(CJ, 1 << 20, F.lane);
    }
    SEAM(13);
    if (IN(14)) { F.lane = (int)__builtin_amdgcn_mbcnt_hi(~0u, __builtin_amdgcn_mbcnt_lo(~0u, 0u)); F.tid = F.wave * 64 + F.lane;
        const Combine C{SLAB, 11, X2 + (size_t)MP * DM, 8 * DM, 0.5f, args.out + O_YS};
        for (int u = gw; u < 2 * MS; u += NGW) { const int ms = u >> 1, j0 = (u & 1) * 2; const float* ar = ADA + (size_t)ada_row(MP + ms) * NADA;
            (void)combine_chunk<11>(C, ar, ms, F.lane, j0); (void)combine_chunk<11>(C, ar, ms, F.lane, j0 + 1); }
    }
#undef IN
#undef SEAM
}

#ifndef MK_N_LAUNCHES
#define MK_N_LAUNCHES 1
#endif
extern "C" void kernel_launch(void* const* d_in, const int* in_sizes, int n_in, void* d_out, int out_size, void* d_ws, size_t ws_size, hipStream_t stream) {
    static int grid = 0;
    if (grid == 0) {
        if (n_in != 32 || (size_t)out_size != O_END || ws_size < WS_END) { fprintf(stderr, "kernel_launch: unexpected shapes (n_in %d out %d ws %zu)\n", n_in, out_size, ws_size); grid = -1; return; }
        int dev = 0, cus = 0, per_cu = 0;
        if (hipGetDevice(&dev) != hipSuccess || hipDeviceGetAttribute(&cus, hipDeviceAttributeMultiprocessorCount, dev) != hipSuccess) { grid = -1; return; }
        if (hipFuncSetAttribute((const void*)hymba_fwd, hipFuncAttributeMaxDynamicSharedMemorySize, LDS_BYTES) != hipSuccess) { fprintf(stderr, "kernel_launch: hipFuncSetAttribute failed\n"); grid = -1; return; }
        if (hipOccupancyMaxActiveBlocksPerMultiprocessor(&per_cu, (const void*)hymba_fwd, NWAVES * 64, LDS_BYTES) != hipSuccess || per_cu < 1)
            fprintf(stderr, "kernel_launch: note: occupancy query reports %d workgroups per CU\n", per_cu);
        (void)hipGetLastError();
        grid = cus;
    }
    if (grid < 0) return;
    if (hipMemsetAsync((char*)d_ws + WS_CTL, 0, CTL_ZERO_BYTES, stream) != hipSuccess) return;
    Args a{};
    for (int i = 0; i < 32; ++i) a.in[i] = (const float*)d_in[i];
    a.out = (float*)d_out; a.ws = (unsigned char*)d_ws;
#if MK_N_LAUNCHES == 1
    a.ph_lo = 0; a.ph_hi = N_PHASES;
    hipLaunchKernelGGL(hymba_fwd, dim3(grid), dim3(NWAVES * 64), LDS_BYTES, stream, a);
#ifdef PROBE_LIST
    { const int pl[] = PROBE_LIST; for (int p : pl) { a.ph_lo = p % 100; a.ph_hi = p % 100 + 1; a.nocopy = (p % 1000) >= 100; a.pad = p / 1000; hipLaunchKernelGGL(hymba_fwd, dim3(grid), dim3(NWAVES * 64), LDS_BYTES, stream, a); } }
#endif
#else
    for (int p = 0; p < N_PHASES; ++p) { a.ph_lo = p; a.ph_hi = p + 1; hipLaunchKernelGGL(hymba_fwd, dim3(grid), dim3(NWAVES * 64), LDS_BYTES, stream, a); }
#endif
}
```

```cpp
#include <hip/hip_runtime.h>
#include <cstdio>
#include <cstdint>
namespace pg8 {
#define PG8_LAS __attribute__((address_space(3)))
typedef unsigned short bf16_t;
typedef short bf16x8 __attribute__((ext_vector_type(8)));
typedef float f32x4 __attribute__((ext_vector_type(4)));
typedef unsigned u32x4 __attribute__((ext_vector_type(4)));
constexpr int BM = 256, BK = 64, HALF = 128, HTB = HALF * BK * 2  , STAGE_BYTES = 8 * HTB, NXCD = 8, WGM = 8;

__host__ __device__ __forceinline__ int lds_byte(int r, int c) { const int st = (r >> 4) * 2 + (c >> 5), rr = r & 15, cc = c & 31, ob = rr * 64 + cc * 2; return st * 1024 + (ob ^ (((ob >> 9) & 1) << 5)); }
__host__ __device__ __forceinline__ void stage_rc(int b, int& R, int& C) { const int st = b / 1024, sb = b % 1024, swz = sb ^ (((sb >> 9) & 1) << 5); R = (st >> 1) * 16 + swz / 64; C = (st & 1) * 32 + (swz % 64) / 2; }
__host__ __device__ __forceinline__ int perm32(int rho) { const int n = rho >> 4, i = rho & 15; return 8 * (i >> 2) + 4 * n + (i & 3); }

__host__ __device__ __forceinline__ size_t blk_off(int row, int col, int K) { return ((size_t)(row >> 8) * (size_t)(K >> 6) + (size_t)(col >> 6)) * 16384 + (size_t)((row & 255) * 64 + (col & 63)); }
__host__ __device__ __forceinline__ size_t blk_byte(int row, int bcol, int Kbytes) { return ((size_t)(row >> 8) * (size_t)(Kbytes >> 7) + (size_t)(bcol >> 7)) * 32768 + (size_t)((row & 255) * 128 + (bcol & 127)); }
struct Unit { int pm, pn; };
struct Gemm { const bf16_t* A; const bf16_t* Bt; int M, N, K; };

struct StaticOrder {
    int nM, nN, nwg, G, c;
    __host__ __device__ void init(int M, int N, int G_, int c_) { nM = M / BM; nN = N / BM; nwg = nM * nN; G = G_; c = c_; }
    __host__ __device__ bool next(int i, Unit& u) const {
        const long L = (long)i * G + c; if (L >= nwg) return false;
        int wgid = (int)L; { const int q = nwg / NXCD, r = nwg % NXCD, xcd = wgid % NXCD, off = wgid / NXCD; wgid = (xcd < r ? xcd * (q + 1) : r * (q + 1) + (xcd - r) * q) + off; }
        const int nig = WGM * nN, gid = wgid / nig, fm = gid * WGM, gsz = (nM - fm) < WGM ? (nM - fm) : WGM;
        u.pm = fm + ((wgid % nig) % gsz); u.pn = (wgid % nig) / gsz; return true;
    }
    __device__ __forceinline__ void a_ready(const Unit&) const {}
    __device__ __forceinline__ void done(const Unit&) const {}
};

__device__ __forceinline__ unsigned cvt_pk_bf16(float lo, float hi) { unsigned r; asm volatile("v_cvt_pk_bf16_f32 %0, %1, %2" : "=v"(r) : "v"(lo), "v"(hi)); return r; }
typedef float f32x2 __attribute__((ext_vector_type(2)));
typedef unsigned u32x2v __attribute__((ext_vector_type(2)));
constexpr int CP_STAGE_OFF = STAGE_BYTES;
constexpr int CP_STRIDE = 8192;
struct CopyJob { const char* src; char* dst; int cur, end; unsigned* dummy; };
struct Unit2 { int pm, pn, k0, nt, split; };
typedef int i32x4 __attribute__((ext_vector_type(4)));
template <bool I8> struct AccSel { typedef f32x4 type; };
template <> struct AccSel<true> { typedef i32x4 type; };
template <class Epi, class Sched, bool ALIGN_EPI, bool COPY, bool I8 = false>
__device__ __forceinline__ void gemm_phase2(PG8_LAS unsigned char* lds, const Gemm g, const Sched& S, const Epi& E, CopyJob& C, const int wid  ) {
    const int lane = (int)__builtin_amdgcn_mbcnt_hi(~0u, __builtin_amdgcn_mbcnt_lo(~0u, 0u)), tid = wid * 64 + lane,
              wr = wid >> 2, wc = wid & 3, fr = lane & 15, fq = lane >> 4;
    const int K = g.K;
    unsigned voffA[2], voffB[2];
#pragma unroll
    for (int i = 0; i < 2; ++i) { int R, Cc; stage_rc(tid * 16 + i * 8192, R, Cc); const int Rb = Epi::PERM ? ((R & ~31) + perm32(R & 31)) : R;
        voffA[i] = (unsigned)(R * 64 + Cc) * 2u; voffB[i] = (unsigned)(Rb * 64 + Cc) * 2u; }
    const size_t kstep = (size_t)32768;
    const size_t hstep = (size_t)HALF * 64 * 2;
    const size_t tstep = (size_t)(K / BK) * kstep;
    const unsigned ldsw = (unsigned)wid * 1024u;
    const int aoff = lds_byte(wr * 64 + fr, fq * 8), boff = lds_byte(wc * 32 + fr, fq * 8);
#define PG8_SA(b, h) (((b) * 2 + (h)) * HTB)
#define PG8_SB(b, h) ((4 + (b) * 2 + (h)) * HTB)
#define PG8_STAGE(bufoff, gbase, voff) do { _Pragma("unroll") for (int _i = 0; _i < 2; ++_i) \
        __builtin_amdgcn_global_load_lds((const unsigned*)((const char*)(gbase) + (voff)[_i]), (PG8_LAS unsigned*)(lds + (bufoff) + ldsw + _i * 8192), 16, 0, 0); } while (0)
#define PG8_LDA(dst, b, h) do { _Pragma("unroll") for (int m = 0; m < 4; ++m) _Pragma("unroll") for (int k = 0; k < 2; ++k) dst[m][k] = *(const PG8_LAS bf16x8*)(lds + PG8_SA(b, h) + aoff + m * 2048 + k * 1024); } while (0)
#define PG8_LDB(dst, b, h) do { _Pragma("unroll") for (int n = 0; n < 2; ++n) _Pragma("unroll") for (int k = 0; k < 2; ++k) dst[n][k] = *(const PG8_LAS bf16x8*)(lds + PG8_SB(b, h) + boff + n * 2048 + k * 1024); } while (0)
#define PG8_MMA(ai, bj, At, Bt) do { __builtin_amdgcn_s_setprio(1); _Pragma("unroll") for (int m = 0; m < 4; ++m) _Pragma("unroll") for (int n = 0; n < 2; ++n) _Pragma("unroll") for (int k = 0; k < 2; ++k) \
        { if constexpr (I8) acc[ai][bj][m][n] = __builtin_amdgcn_mfma_i32_16x16x64_i8(__builtin_bit_cast(i32x4, Bt[n][k]), __builtin_bit_cast(i32x4, At[m][k]), acc[ai][bj][m][n], 0, 0, 0); \
          else acc[ai][bj][m][n] = __builtin_amdgcn_mfma_f32_16x16x32_bf16(Bt[n][k], At[m][k], acc[ai][bj][m][n], 0, 0, 0); } __builtin_amdgcn_s_setprio(0); } while (0)
#define PG8_WAIT_V(n) asm volatile("s_waitcnt vmcnt(" #n ")" ::: "memory")
#define PG8_WAIT_LOOP() do { if constexpr (COPY) asm volatile("s_waitcnt vmcnt(13)" ::: "memory"); else asm volatile("s_waitcnt vmcnt(8)" ::: "memory"); } while (0)
#define PG8_WAIT_L(n) asm volatile("s_waitcnt lgkmcnt(" #n ")" ::: "memory")
#define PG8_BAR __builtin_amdgcn_s_barrier()
#define PG8_SCHED __builtin_amdgcn_sched_barrier(0)
    typedef unsigned cp4 __attribute__((ext_vector_type(4)));
    const unsigned cp_voff = (unsigned)lane * 16u;
    int cp_n = 0, cp_sl = 0;
    const int cp_base = C.cur, cp_cnt = C.end - C.cur;
    const char* cp_s = C.src + (size_t)cp_base * CP_STRIDE; char* cp_d = C.dst + ((size_t)cp_base - 4) * CP_STRIDE;
    PG8_LAS unsigned char* const cp_stage = lds + CP_STAGE_OFF + wid * 3072;
    cp4 cp_r = {0u, 0u, 0u, 0u};
#define CP_STORE() do { if constexpr (COPY) { \
        if (cp_n >= 4 && cp_n - 4 < cp_cnt) __builtin_nontemporal_store(cp_r, (cp4*)(cp_d + cp_voff)); else C.dummy[lane] = cp_r.x; } } while (0)
#define CP_READ() do { if constexpr (COPY) { const unsigned la_ = (unsigned)(unsigned long)(cp_stage + cp_sl * 1024) + cp_voff; \
        asm volatile("ds_read_b128 %0, %1" : "=v"(cp_r) : "v"(la_) : "memory"); } } while (0)
#define CP_ISSUE() do { if constexpr (COPY) { asm volatile("s_waitcnt lgkmcnt(0)" ::: "memory"); \
        const char* sp_ = (cp_n < cp_cnt) ? cp_s : (const char*)C.src; \
        __builtin_amdgcn_global_load_lds((const unsigned*)(sp_ + cp_voff), (PG8_LAS unsigned*)(cp_stage + cp_sl * 1024), 16, 0, 2); \
        ++cp_n; cp_sl = (cp_sl == 2) ? 0 : cp_sl + 1; cp_s += CP_STRIDE; cp_d += CP_STRIDE; } } while (0)
    Unit2 cur, nxt; int ui = 0;
    if (!S.next(0, cur)) return;
    typedef typename AccSel<I8>::type acc_t; const acc_t acc_zero = {};
    acc_t acc[2][2][4][2];
#pragma unroll
    for (int a = 0; a < 2; ++a)
#pragma unroll
        for (int b = 0; b < 2; ++b)
#pragma unroll
            for (int m = 0; m < 4; ++m)
#pragma unroll
                for (int n = 0; n < 2; ++n) acc[a][b][m][n] = acc_zero;
    bf16x8 At[4][2], B0[2][2], B1[2][2];
    const char* cA = (const char*)g.A + (size_t)cur.pm * tstep + (size_t)cur.k0 * kstep; const char* cB = (const char*)g.Bt + (size_t)cur.pn * tstep + (size_t)cur.k0 * kstep;
    S.a_ready(cur);
    {
        PG8_STAGE(PG8_SB(0, 0), cB, voffB); PG8_STAGE(PG8_SB(0, 1), cB + hstep, voffB); PG8_STAGE(PG8_SA(0, 0), cA, voffA); PG8_STAGE(PG8_SA(0, 1), cA + hstep, voffA);
        if (wr == 1) PG8_BAR;
        PG8_WAIT_V(2); PG8_BAR;
        PG8_STAGE(PG8_SB(1, 0), cB + kstep, voffB); PG8_STAGE(PG8_SA(1, 0), cA + kstep, voffA); PG8_STAGE(PG8_SB(1, 1), cB + hstep + kstep, voffB);
        PG8_WAIT_V(6); PG8_BAR;
    }
    for (;;) {
        const bool has_next = S.next(ui + 1, nxt);
        const char* nA = has_next ? (const char*)g.A + (size_t)nxt.pm * tstep + (size_t)nxt.k0 * kstep : cA; const char* nB = has_next ? (const char*)g.Bt + (size_t)nxt.pn * tstep + (size_t)nxt.k0 * kstep : cB;
        const int nt = cur.nt;
        for (int t = 0; t < nt; t += 2) {
            const bool last = (t == nt - 2);
            const char* a1 = cA + (size_t)(t + 1) * kstep;
            const char* a2 = last ? nA : cA + (size_t)(t + 2) * kstep; const char* b2 = last ? nB : cB + (size_t)(t + 2) * kstep;
            const char* a3 = a2 + kstep; const char* b3 = b2 + kstep;
            if (last && has_next) S.a_ready(nxt);
            PG8_LDB(B0, 0, 0); PG8_LDB(B1, 0, 1); PG8_SCHED; PG8_LDA(At, 0, 0); PG8_STAGE(PG8_SA(1, 1), a1 + hstep, voffA);
            CP_STORE(); PG8_WAIT_LOOP(); PG8_WAIT_L(0); PG8_BAR; PG8_MMA(0, 0, At, B0); CP_READ(); PG8_MMA(0, 1, At, B1); CP_ISSUE(); PG8_BAR; PG8_SCHED;
            PG8_LDA(At, 0, 1); PG8_STAGE(PG8_SB(0, 0), b2, voffB); PG8_STAGE(PG8_SB(0, 1), b2 + hstep, voffB); PG8_STAGE(PG8_SA(0, 0), a2, voffA);
            CP_STORE(); PG8_WAIT_LOOP(); PG8_WAIT_L(0); PG8_BAR; PG8_MMA(1, 0, At, B0); CP_READ(); PG8_MMA(1, 1, At, B1); CP_ISSUE(); PG8_BAR; PG8_SCHED;
            PG8_LDB(B0, 1, 0); PG8_LDB(B1, 1, 1); PG8_SCHED; PG8_LDA(At, 1, 0); PG8_STAGE(PG8_SA(0, 1), a2 + hstep, voffA);
            CP_STORE(); PG8_WAIT_LOOP(); PG8_WAIT_L(0); PG8_BAR; PG8_MMA(0, 0, At, B0); CP_READ(); PG8_MMA(0, 1, At, B1); CP_ISSUE(); PG8_BAR; PG8_SCHED;
            PG8_LDA(At, 1, 1); PG8_STAGE(PG8_SB(1, 0), b3, voffB); PG8_STAGE(PG8_SB(1, 1), b3 + hstep, voffB); PG8_STAGE(PG8_SA(1, 0), a3, voffA);
            CP_STORE(); PG8_WAIT_LOOP(); PG8_WAIT_L(0); PG8_BAR; PG8_MMA(1, 0, At, B0); CP_READ(); PG8_MMA(1, 1, At, B1); CP_ISSUE(); PG8_BAR; PG8_SCHED;
        }
        if constexpr (ALIGN_EPI) { if (wr == 0) PG8_BAR; }
        { int l2_; asm volatile("v_mbcnt_lo_u32_b32 %0, -1, 0\n\tv_mbcnt_hi_u32_b32 %0, -1, %0" : "=v"(l2_)); E(acc, cur, wr, wc, l2_ & 15, l2_ >> 4); } S.done(cur);
        if (!has_next) break;
#pragma unroll
        for (int a = 0; a < 2; ++a)
#pragma unroll
            for (int b = 0; b < 2; ++b)
#pragma unroll
                for (int m = 0; m < 4; ++m)
#pragma unroll
                    for (int n = 0; n < 2; ++n) acc[a][b][m][n] = acc_zero;
        cur = nxt; cA = nA; cB = nB; ++ui;
        if constexpr (ALIGN_EPI) { if (wr == 1) PG8_BAR; }
    }
    PG8_WAIT_V(0);
    if constexpr (!ALIGN_EPI) { if (wr == 0) PG8_BAR; }
    PG8_BAR;
    if constexpr (COPY) {
        if (cp_n >= 4 && cp_n - 4 < cp_cnt) __builtin_nontemporal_store(cp_r, (cp4*)(C.dst + ((size_t)cp_base + cp_n - 4) * CP_STRIDE + cp_voff));
#pragma unroll
        for (int j = 3; j >= 1; --j) { const int k = cp_n - j;
            if (k >= 0 && k < cp_cnt) { const int sl = k % 3; const cp4 v = *(const PG8_LAS cp4*)(cp_stage + sl * 1024 + cp_voff);
                __builtin_nontemporal_store(v, (cp4*)(C.dst + ((size_t)cp_base + k) * CP_STRIDE + cp_voff)); } }
        C.cur = cp_base + (cp_n < cp_cnt ? cp_n : cp_cnt);
    }
#undef CP_ISSUE
#undef CP_READ
#undef CP_STORE
#undef PG8_SA
#undef PG8_SB
#undef PG8_STAGE
#undef PG8_LDA
#undef PG8_LDB
#undef PG8_MMA
#undef PG8_WAIT_V
#undef PG8_WAIT_LOOP
#undef PG8_WAIT_L
#undef PG8_BAR
#undef PG8_SCHED
}
struct Order2 {
    StaticOrder so; int nt;
    __device__ __forceinline__ void init(int M, int N, int K, int G, int c) { so.init(M, N, G, c); nt = K / BK; }
    __device__ __forceinline__ bool next(int i, Unit2& u) const { Unit v; if (!so.next(i, v)) return false; u.pm = v.pm; u.pn = v.pn; u.k0 = 0; u.nt = nt; u.split = 0; return true; }
    __device__ __forceinline__ void a_ready(const Unit2&) const {}
    __device__ __forceinline__ void done(const Unit2&) const {}
};
struct SplitOrder {
    StaticOrder so; int nt, nsplit, nN, npre, ntot;
    __device__ __forceinline__ void init(int Mp, int N, int K, int nsplit_, int G, int c) { so.init(Mp, N, G, c); nt = K / BK; nsplit = nsplit_; nN = N / BM; npre = so.nwg; ntot = npre + 4 * nN * nsplit; }
    __device__ __forceinline__ bool next(int i, Unit2& u) const {
        const long L = (long)i * so.G + so.c; if (L >= ntot) return false;
        Unit v; v.pm = 0; v.pn = 0; const bool pre = so.next(i, v);
        const int s = (int)L - npre, ks = s % nsplit, tile = s / nsplit, nts = nt / nsplit;
        u.pm = pre ? v.pm : so.nM + tile / nN; u.pn = pre ? v.pn : tile % nN; u.nt = pre ? nt : nts; u.k0 = pre ? 0 : ks * nts; u.split = pre ? 0 : 1; return true;
    }
    __device__ __forceinline__ void a_ready(const Unit2&) const {}
    __device__ __forceinline__ void done(const Unit2&) const {}
};
}

constexpr int NWAVES = 8;
constexpr int DM = 1024, SEQ = 16384, NBAT = 128, DSEQ = 8, MP = SEQ, MS = NBAT * DSEQ, MTOT = MP + MS;
constexpr int DFF = 2816, NH = 8, HD = 64, DATT = 512, DSSM = 512, NG = 32, NP = 64, NC = 16, WBUF = 2048, PAST = 8192;
constexpr int NADA = 9 * DM;
constexpr float EPS = 1e-6f;
constexpr float QSCALE = 0.125f * 1.44269504088896340736f;
constexpr int CHUNK = 128, NCHUNK_P = SEQ / CHUNK  , NCHUNK_S = MS / CHUNK  ;

constexpr size_t MiB = 1u << 20;
constexpr size_t WS_CTL = 0, CTL_ZERO_BYTES = 1 * MiB;
constexpr size_t WS_ADA = 1 * MiB;
constexpr size_t WS_SC = 10 * MiB;
constexpr size_t WS_ROPE = 11 * MiB;
constexpr size_t WS_SSMT = 13 * MiB;
constexpr size_t WS_WADA = 14 * MiB;
constexpr size_t WS_W1T = 32 * MiB;
constexpr size_t WS_W1D = 43 * MiB;
constexpr size_t WS_W2T = 49 * MiB;
constexpr size_t WS_W2D = 60 * MiB;
constexpr size_t WS_WIN = 66 * MiB;
constexpr size_t WS_WGLU = 70 * MiB;
constexpr size_t WS_WOUT = 71 * MiB;
constexpr size_t WS_XN = 74 * MiB;
constexpr size_t WS_H = 108 * MiB;
constexpr size_t WS_X1 = 202 * MiB;
constexpr size_t WS_X2 = 270 * MiB;
constexpr size_t WS_Q = 338 * MiB;
constexpr size_t WS_K = 355 * MiB;
constexpr size_t WS_VT = 372 * MiB;
constexpr size_t WS_U = 420 * MiB;
constexpr size_t WS_SQKV = 437 * MiB;
constexpr size_t WS_MIX = 443 * MiB;
constexpr size_t WS_GB = 477 * MiB;
constexpr size_t WS_CS = 494 * MiB;
constexpr size_t WS_SLAB = 496 * MiB;
constexpr size_t WS_OP = 540 * MiB;
constexpr size_t WS_ML = 588 * MiB;
constexpr size_t WS_XN8 = 592 * MiB;
constexpr size_t WS_W1T8 = 610 * MiB;
constexpr size_t WS_W2T8 = 616 * MiB;
constexpr size_t WS_SB = 622 * MiB;
constexpr size_t WS_SA = 623 * MiB;
constexpr size_t WS_END = 624 * MiB;
constexpr size_t ST_ABAR = 0;
constexpr size_t ST_CM = 256 * 1024;
constexpr size_t ST_PW = 384 * 1024;
constexpr size_t ST_CP = 448 * 1024;
constexpr size_t ST_CL = 704 * 1024;
constexpr size_t O_YP = 0, O_YS = 16777216, O_KP = 17825792, O_VP = 18874368, O_HRP = 19922944, O_HIP = 19924992,
                 O_KS = 19927040, O_VS = 154144768, O_HRS = 288362496, O_HIS = 288624640, O_END = 288886784;
constexpr int CW_TMO = 0, CW_BAR = 4096, CW_AMAX = 16384;

constexpr int RING_OFF = 0, RING_BYTES = 131072;
constexpr int CPSTAGE_BYTES = 24576;
constexpr int LDSCTL_OFF = RING_BYTES + CPSTAGE_BYTES, MISC_OFF = LDSCTL_OFF + 320;
constexpr int LDS_BYTES = 157696;

#define GAS __attribute__((address_space(1)))
#define LAS __attribute__((address_space(3)))
typedef unsigned short bf16;
typedef unsigned v4u __attribute__((ext_vector_type(4)));
typedef unsigned v2u __attribute__((ext_vector_type(2)));
typedef float f32x4 __attribute__((ext_vector_type(4)));
typedef float f32x2 __attribute__((ext_vector_type(2)));
typedef short bf16x8 __attribute__((ext_vector_type(8)));
typedef GAS unsigned gu32;
#define RLX_AGENT __ATOMIC_RELAXED, __HIP_MEMORY_SCOPE_AGENT
#define LDS_WAIT() asm volatile("s_waitcnt lgkmcnt(0)" ::: "memory")
#define VM_WAIT() asm volatile("s_waitcnt vmcnt(0)" ::: "memory")
__device__ __forceinline__ unsigned f2bf(float f) { unsigned u = __builtin_bit_cast(unsigned, f); return (u + 0x7fffu + ((u >> 16) & 1u)) >> 16; }
__device__ __forceinline__ unsigned pk2(float lo, float hi) { return pg8::cvt_pk_bf16(lo, hi); }
__device__ __forceinline__ float bf2f(unsigned short b) { return __builtin_bit_cast(float, (unsigned)b << 16); }
__device__ __forceinline__ float fast_sigmoid(float x) { return __builtin_amdgcn_rcpf(1.0f + __builtin_amdgcn_exp2f(-1.44269504088896f * x)); }
__device__ __forceinline__ float gelu_tanh(float x) { const float z = 1.5957691216057308f * (x + 0.044715f * x * x * x); return x * fast_sigmoid(z); }
#define XB_TMO      128
#define XB_XCNT(j)  (256  + 64 * (j))
#define XB_XSUB(j)  (1280 + 64 * (j))
#define XB_XGEN(j)  (2304 + 64 * (j))
#define XB_TOP      3328
#define XB_TOPGEN   3392
#define XCD_BAR_WORDS 3456
#define XB_SPIN_CAP (1u << 18)

__device__ __forceinline__ unsigned xb_ld(unsigned* p)              { return __hip_atomic_load(p, __ATOMIC_RELAXED, __HIP_MEMORY_SCOPE_AGENT); }
__device__ __forceinline__ unsigned xb_add(unsigned* p, unsigned v) { return __hip_atomic_fetch_add(p, v, __ATOMIC_RELAXED, __HIP_MEMORY_SCOPE_AGENT); }
__device__ __forceinline__ unsigned xb_xcc_id() { return (unsigned)__builtin_amdgcn_s_getreg((3 << 11) | 20) & 0xFu; }
#define XB_SPIN(cond, bar) do { unsigned _sp = 0; while (cond) { __builtin_amdgcn_s_sleep(1); \
    if ((++_sp & 255u) == 0u) { if (xb_ld(&(bar)[XB_TMO])) break; if (_sp > XB_SPIN_CAP) { atomicAdd(&(bar)[XB_TMO], 1u); break; } } } } while (0)

struct XcdBarrier {
    unsigned* bar; unsigned x;
    volatile LAS unsigned* st;
};

__device__ __forceinline__ XcdBarrier xcd_barrier_post(unsigned* bar, volatile LAS unsigned* st) {
    XcdBarrier b; b.bar = bar; b.x = xb_xcc_id(); b.st = st;
    if (threadIdx.x == 0) (void)xb_add(&bar[XB_XCNT(b.x)], 1u);
    return b;
}
__device__ __forceinline__ void xcd_barrier_complete(unsigned* bar, unsigned x, unsigned& nloc, unsigned& nx) {
    const unsigned G = gridDim.x * gridDim.y * gridDim.z;
    unsigned sum, cnt, mine, sp = 0u;
    for (;;) {
        sum = 0u; cnt = 0u; mine = 0u;
#pragma unroll
        for (unsigned j = 0; j < 16; ++j) { const unsigned c = xb_ld(&bar[XB_XCNT(j)]); sum += c; cnt += (c > 0u) ? 1u : 0u; mine = (j == x) ? c : mine; }
        if (sum == G) break;
        __builtin_amdgcn_s_sleep(1);
        if ((++sp & 255u) == 0u) { if (xb_ld(&bar[XB_TMO])) break; if (sp > XB_SPIN_CAP) { atomicAdd(&bar[XB_TMO], 1u); break; } }
    }
    nloc = mine > 0u ? mine : 1u; nx = cnt > 0u ? cnt : 1u;
}

__device__ __forceinline__ void xcd_barrier(const XcdBarrier& b) {
    asm volatile("s_waitcnt vmcnt(0)" ::: "memory");
    __syncthreads();
    if (threadIdx.x == 0) {
        unsigned* bar = b.bar;
        __builtin_amdgcn_s_waitcnt(0);
        unsigned nloc = b.st[0], nx = b.st[1];
        if (nloc == 0u) { xcd_barrier_complete(bar, b.x, nloc, nx); b.st[0] = nloc; b.st[1] = nx; }
        const unsigned old = xb_add(&bar[XB_XSUB(b.x)], 1u);
        const unsigned gen = old / nloc;
        if (old + 1u == (gen + 1u) * nloc) {
            __builtin_amdgcn_fence(__ATOMIC_RELEASE, "agent");
            asm volatile("s_waitcnt vmcnt(0)" ::: "memory");
            const unsigned og = xb_add(&bar[XB_TOP], 1u);
            if (og + 1u == (gen + 1u) * nx) xb_add(&bar[XB_TOPGEN], 1u);
        }
        XB_SPIN(xb_ld(&bar[XB_TOPGEN]) == gen, bar);
        __builtin_amdgcn_fence(__ATOMIC_ACQUIRE, "agent");
        asm volatile("s_waitcnt vmcnt(0)" ::: "memory");
    }
    __syncthreads();
}


struct Args { const float* in[32]; float* out; unsigned char* ws; int ph_lo, ph_hi, nocopy, pad; };
enum { I_XP = 0, I_XS, I_CP, I_CS, I_CK, I_CV, I_SRE, I_SIM, I_WADA, I_BADA, I_GF1, I_W1G, I_W1U, I_W1D, I_GMIX, I_WIN, I_GQ, I_GK,
       I_ARE, I_AIM, I_LDT, I_BRE, I_BIM, I_CRE, I_CIM, I_SD, I_WGLU, I_WOUT, I_GF2, I_W2G, I_W2U, I_W2D };
struct Frame {
    LAS unsigned char* lds;
    volatile LAS unsigned* MISC;
    gu32* ctl;
    int tid, lane, wave;
    int vcu, G;
};
__device__ __forceinline__ int ada_row(int m) { return m < MP ? 0 : 1 + ((m - MP) >> 3); }
__device__ __forceinline__ float wave_sum(float v) {
#pragma unroll
    for (int o = 1; o < 64; o <<= 1) v += __shfl_xor(v, o);
    return v;
}
__device__ __forceinline__ float wave_max(float v) {
#pragma unroll
    for (int o = 1; o < 64; o <<= 1) v = fmaxf(v, __shfl_xor(v, o));
    return v;
}

namespace pg8 {
struct EpiF32 {
    static constexpr bool PERM = false, AFTER_DRAIN = false;
    float* C; int ldc; const float* bias;
    __device__ __forceinline__ void operator()(const f32x4 (&acc)[2][2][4][2], const Unit2& u, int wr, int wc, int fr, int fq) const {
        const int row0 = u.pm * BM + wr * 64 + fr, col0 = u.pn * BM + wc * 32 + 4 * fq;
        f32x4 bv[2][2];
#pragma unroll
        for (int bj = 0; bj < 2; ++bj)
#pragma unroll
            for (int n = 0; n < 2; ++n) bv[bj][n] = *(const f32x4*)(bias + col0 + bj * HALF + n * 16);
#pragma unroll
        for (int ai = 0; ai < 2; ++ai)
#pragma unroll
            for (int m = 0; m < 4; ++m) { float* rowp = C + (size_t)(row0 + ai * HALF + m * 16) * ldc + col0;
#pragma unroll
                for (int bj = 0; bj < 2; ++bj)
#pragma unroll
                    for (int n = 0; n < 2; ++n) *(f32x4*)(rowp + bj * HALF + n * 16) = acc[ai][bj][m][n] + bv[bj][n]; }
    }
};
template <int ACT  > struct EpiGated {
    static constexpr bool PERM = true, AFTER_DRAIN = false;
    bf16_t* O; int ldo; int col_off;
    __device__ __forceinline__ void operator()(const f32x4 (&acc)[2][2][4][2], const Unit2& u, int wr, int wc, int fr, int fq) const {
        const int row0 = u.pm * BM + wr * 64 + fr, col = col_off + u.pn * HALF + wc * 32 + 8 * fq;
#pragma unroll
        for (int ai = 0; ai < 2; ++ai)
#pragma unroll
            for (int m = 0; m < 4; ++m) {
                float r[8];
#pragma unroll
                for (int n = 0; n < 2; ++n)
#pragma unroll
                    for (int e = 0; e < 4; ++e) { const float a = acc[ai][0][m][n][e], b = acc[ai][1][m][n][e];
                        r[n * 4 + e] = (ACT == 0) ? a * b * fast_sigmoid(a) : a * fast_sigmoid(b); }
                u32x4 w; w.x = cvt_pk_bf16(r[0], r[1]); w.y = cvt_pk_bf16(r[2], r[3]); w.z = cvt_pk_bf16(r[4], r[5]); w.w = cvt_pk_bf16(r[6], r[7]);
                *(u32x4*)(O + blk_off(row0 + ai * HALF + m * 16, col, ldo)) = w;
            }
    }
};
struct EpiGated8 {
    static constexpr bool PERM = true, AFTER_DRAIN = false;
    bf16_t* O; int ldo; const float* sA; const unsigned* amax;
    __device__ __forceinline__ void operator()(const i32x4 (&acc)[2][2][4][2], const Unit2& u, int wr, int wc, int fr, int fq) const {
        const int row0 = u.pm * BM + wr * 64 + fr, col = u.pn * HALF + wc * 32 + 8 * fq;
        const float sg = __builtin_bit_cast(float, amax[0]) * (1.0f / 127.0f), su = __builtin_bit_cast(float, amax[1]) * (1.0f / 127.0f);
        float ras[2][4];
#pragma unroll
        for (int ai = 0; ai < 2; ++ai)
#pragma unroll
            for (int m = 0; m < 4; ++m) ras[ai][m] = sA[row0 + ai * HALF + m * 16];
#pragma unroll
        for (int ai = 0; ai < 2; ++ai)
#pragma unroll
            for (int m = 0; m < 4; ++m) { const int row = row0 + ai * HALF + m * 16; const float ra = ras[ai][m]; const float fg = ra * sg, fu = ra * su;
                float r[8];
#pragma unroll
                for (int n = 0; n < 2; ++n)
#pragma unroll
                    for (int e = 0; e < 4; ++e) { const float a = (float)acc[ai][0][m][n][e] * fg, b = (float)acc[ai][1][m][n][e] * fu;
                        r[n * 4 + e] = a * b * fast_sigmoid(a); }
                u32x4 w; w.x = cvt_pk_bf16(r[0], r[1]); w.y = cvt_pk_bf16(r[2], r[3]); w.z = cvt_pk_bf16(r[4], r[5]); w.w = cvt_pk_bf16(r[6], r[7]);
                *(u32x4*)(O + blk_off(row, col, ldo)) = w;
                __builtin_amdgcn_sched_barrier(0);
            }
    }
};
template <bool BIN, bool BOUT>
struct EpiResid {
    static constexpr bool PERM = false, AFTER_DRAIN = false;
    const float* baseP; const float* baseS; float* out; const float* ada; int gate_off; float coef; float* slab;
    __device__ __forceinline__ void operator()(f32x4 (&acc)[2][2][4][2], const Unit2& u, int wr, int wc, int fr, int fq) const {
        const int row0 = u.pm * BM + wr * 64 + fr, col0 = u.pn * BM + wc * 32 + 4 * fq;
        if (u.split) {
#pragma unroll
            for (int ai = 0; ai < 2; ++ai)
#pragma unroll
                for (int m = 0; m < 4; ++m) { const int row = row0 + ai * HALF + m * 16;
                    unsigned short* sl = (unsigned short*)slab + ((size_t)(u.k0 / u.nt) * MS + (size_t)(row - MP)) * DM;
#pragma unroll
                    for (int bj = 0; bj < 2; ++bj)
#pragma unroll
                        for (int n = 0; n < 2; ++n) { const int c = col0 + bj * HALF + n * 16; const f32x4 a_ = acc[ai][bj][m][n];
                            *(u32x2v*)(sl + c) = (u32x2v){cvt_pk_bf16(a_.x, a_.y), cvt_pk_bf16(a_.z, a_.w)}; } }
        } else {
            f32x4 g00, g01, g10, g11;
#define RES_LDP(D0, D1, D2, D3, PTR) do { const float* p_ = (PTR); \
                asm volatile("global_load_dwordx4 %0, %4, off\n\tglobal_load_dwordx4 %1, %4, off offset:64\n\tglobal_load_dwordx4 %2, %4, off offset:512\n\tglobal_load_dwordx4 %3, %4, off offset:576" \
                             : "=&v"(D0), "=&v"(D1), "=&v"(D2), "=&v"(D3) : "v"(p_) : "memory"); } while (0)
#define RES_LDB(D0, D1, D2, D3, PTR) do { const unsigned short* p_ = (PTR); \
                asm volatile("global_load_dwordx2 %0, %4, off\n\tglobal_load_dwordx2 %1, %4, off offset:32\n\tglobal_load_dwordx2 %2, %4, off offset:256\n\tglobal_load_dwordx2 %3, %4, off offset:288" \
                             : "=&v"(D0), "=&v"(D1), "=&v"(D2), "=&v"(D3) : "v"(p_) : "memory"); } while (0)
#define RES_WAIT(N, C0, C1, C2, C3) asm volatile("s_waitcnt vmcnt(" #N ")" : "+v"(C0), "+v"(C1), "+v"(C2), "+v"(C3), "+v"(g00), "+v"(g01), "+v"(g10), "+v"(g11) :: "memory")
#define RES_FMA(Q, V0, V1, V2, V3) do { constexpr int ai_ = (Q) >> 2, m_ = (Q) & 3; \
                acc[ai_][0][m_][0] = (V0) + (g00 * coef) * acc[ai_][0][m_][0]; acc[ai_][0][m_][1] = (V1) + (g01 * coef) * acc[ai_][0][m_][1]; \
                acc[ai_][1][m_][0] = (V2) + (g10 * coef) * acc[ai_][1][m_][0]; acc[ai_][1][m_][1] = (V3) + (g11 * coef) * acc[ai_][1][m_][1]; } while (0)
            RES_LDP(g00, g01, g10, g11, ada + gate_off + col0);
            if constexpr (!BIN) {
                f32x4 b0, b1, b2, b3, n0, n1, n2, n3;
#define RES_LD(D0, D1, D2, D3, ROWOFF) RES_LDP(D0, D1, D2, D3, baseP + (ROWOFF))
                RES_LD(b0, b1, b2, b3, (size_t)row0 * DM + col0);
#define RES_STEP(Q, C0, C1, C2, C3, N0, N1, N2, N3) do { \
                    if ((Q) < 7) { constexpr int ai2_ = ((Q) + 1) >> 2, m2_ = ((Q) + 1) & 3; RES_LD(N0, N1, N2, N3, (size_t)(row0 + ai2_ * HALF + m2_ * 16) * DM + col0); RES_WAIT(4, C0, C1, C2, C3); } \
                    else RES_WAIT(0, C0, C1, C2, C3); \
                    RES_FMA(Q, C0, C1, C2, C3); } while (0)
                RES_STEP(0, b0, b1, b2, b3, n0, n1, n2, n3); RES_STEP(1, n0, n1, n2, n3, b0, b1, b2, b3); RES_STEP(2, b0, b1, b2, b3, n0, n1, n2, n3); RES_STEP(3, n0, n1, n2, n3, b0, b1, b2, b3);
                RES_STEP(4, b0, b1, b2, b3, n0, n1, n2, n3); RES_STEP(5, n0, n1, n2, n3, b0, b1, b2, b3); RES_STEP(6, b0, b1, b2, b3, n0, n1, n2, n3); RES_STEP(7, n0, n1, n2, n3, b0, b1, b2, b3);
#undef RES_STEP
#undef RES_LD
            } else {
                const unsigned short* bp = (const unsigned short*)baseP;
                u32x2v b0, b1, b2, b3, n0, n1, n2, n3;
#define RES_BF(W) ((f32x4){__builtin_bit_cast(float, (W).x << 16), __builtin_bit_cast(float, (W).x & 0xffff0000u), __builtin_bit_cast(float, (W).y << 16), __builtin_bit_cast(float, (W).y & 0xffff0000u)})
#define RES_LD(D0, D1, D2, D3, ROWOFF) RES_LDB(D0, D1, D2, D3, bp + (ROWOFF))
                RES_LD(b0, b1, b2, b3, (size_t)row0 * DM + col0);
#define RES_STEP(Q, C0, C1, C2, C3, N0, N1, N2, N3) do { \
                    if ((Q) < 7) { constexpr int ai2_ = ((Q) + 1) >> 2, m2_ = ((Q) + 1) & 3; RES_LD(N0, N1, N2, N3, (size_t)(row0 + ai2_ * HALF + m2_ * 16) * DM + col0); RES_WAIT(4, C0, C1, C2, C3); } \
                    else RES_WAIT(0, C0, C1, C2, C3); \
                    RES_FMA(Q, RES_BF(C0), RES_BF(C1), RES_BF(C2), RES_BF(C3)); } while (0)
                RES_STEP(0, b0, b1, b2, b3, n0, n1, n2, n3); RES_STEP(1, n0, n1, n2, n3, b0, b1, b2, b3); RES_STEP(2, b0, b1, b2, b3, n0, n1, n2, n3); RES_STEP(3, n0, n1, n2, n3, b0, b1, b2, b3);
                RES_STEP(4, b0, b1, b2, b3, n0, n1, n2, n3); RES_STEP(5, n0, n1, n2, n3, b0, b1, b2, b3); RES_STEP(6, b0, b1, b2, b3, n0, n1, n2, n3); RES_STEP(7, n0, n1, n2, n3, b0, b1, b2, b3);
#undef RES_STEP
#undef RES_LD
#undef RES_BF
            }
#undef RES_FMA
#undef RES_WAIT
#undef RES_LDB
#undef RES_LDP
            asm volatile("" ::: "memory");
            if constexpr (!BOUT) {
#pragma unroll
                for (int q = 0; q < 8; ++q) { const int ai = q >> 2, m = q & 3; const size_t ro = (size_t)(row0 + ai * HALF + m * 16) * DM + col0;
                    *(f32x4*)(out + ro) = acc[ai][0][m][0]; *(f32x4*)(out + ro + 16) = acc[ai][0][m][1]; *(f32x4*)(out + ro + HALF) = acc[ai][1][m][0]; *(f32x4*)(out + ro + HALF + 16) = acc[ai][1][m][1]; }
            } else {
                unsigned short* ob = (unsigned short*)out;
#define RES_PK(V) ((u32x2v){cvt_pk_bf16((V).x, (V).y), cvt_pk_bf16((V).z, (V).w)})
#pragma unroll
                for (int q = 0; q < 8; ++q) { const int ai = q >> 2, m = q & 3; const size_t ro = (size_t)(row0 + ai * HALF + m * 16) * DM + col0;
                    *(u32x2v*)(ob + ro) = RES_PK(acc[ai][0][m][0]); *(u32x2v*)(ob + ro + 16) = RES_PK(acc[ai][0][m][1]); *(u32x2v*)(ob + ro + HALF) = RES_PK(acc[ai][1][m][0]); *(u32x2v*)(ob + ro + HALF + 16) = RES_PK(acc[ai][1][m][1]); }
#undef RES_PK
            }
        }
    }
};
struct EpiInProj {
    static constexpr bool PERM = false, AFTER_DRAIN = false;
    bf16_t *Q, *K, *VT, *U; float* SQKV; float* out; const _Float16* rope16; const float* gq; const float* gk;
    __device__ __forceinline__ void operator()(const f32x4 (&acc)[2][2][4][2], const Unit2& u, int wr, int wc, int fr, int fq) const {
        const int row0 = u.pm * BM + wr * 64 + fr; const int pn = u.pn;
        if (pn < 4) {
            const bool isq = pn < 2; const int hh = 4 * (pn & 1) + wc; const float* gw = isq ? gq : gk;
            f32x4 gv[2][2];
#pragma unroll
            for (int bj = 0; bj < 2; ++bj)
#pragma unroll
                for (int n = 0; n < 2; ++n) gv[bj][n] = *(const f32x4*)(gw + 32 * bj + 16 * n + 4 * fq);
            typedef _Float16 h16x4 __attribute__((ext_vector_type(4)));
            h16x4 rcs[2][4], rsn[2][4];
#pragma unroll
            for (int ai = 0; ai < 2; ++ai)
#pragma unroll
                for (int m = 0; m < 4; ++m) { const size_t ro = (size_t)(row0 + ai * HALF + m * 16) * 16 + 4 * (fq & 1); rcs[ai][m] = *(const h16x4*)(rope16 + ro); rsn[ai][m] = *(const h16x4*)(rope16 + ro + 8); }
#pragma unroll
            for (int ai = 0; ai < 2; ++ai)
#pragma unroll
                for (int m = 0; m < 4; ++m) { const int row = row0 + ai * HALF + m * 16;
                    const f32x4 cs = {(float)rcs[ai][m][0], (float)rcs[ai][m][1], (float)rcs[ai][m][2], (float)rcs[ai][m][3]}, sn = {(float)rsn[ai][m][0], (float)rsn[ai][m][1], (float)rsn[ai][m][2], (float)rsn[ai][m][3]};
                    float ss = 0.f;
#pragma unroll
                    for (int bj = 0; bj < 2; ++bj)
#pragma unroll
                        for (int n = 0; n < 2; ++n) { const f32x4 x = acc[ai][bj][m][n]; ss += (x[0] * x[0] + x[1] * x[1]) + (x[2] * x[2] + x[3] * x[3]); }
                    ss += __shfl_xor(ss, 16); ss += __shfl_xor(ss, 32);
                    const float rs = 1.0f / sqrtf(ss * (1.0f / 64.0f) + EPS);
                    f32x4 y[2][2];
#pragma unroll
                    for (int bj = 0; bj < 2; ++bj)
#pragma unroll
                        for (int n = 0; n < 2; ++n) y[bj][n] = acc[ai][bj][m][n] * rs * gv[bj][n];
                    {

                        f32x4 w;
#pragma unroll
                        for (int e = 0; e < 4; ++e) w[e] = __shfl_xor(y[0][0][e], 32);
                        y[0][0] = (fq < 2) ? (y[0][0] * cs - w * sn) : (y[0][0] * cs + w * sn);
                    }
                    if (isq) {
#pragma unroll
                        for (int bj = 0; bj < 2; ++bj)
#pragma unroll
                            for (int n = 0; n < 2; ++n) { const f32x4 v = y[bj][n] * QSCALE; const int c = hh * 64 + 32 * bj + 16 * n + 4 * fq;
                                u32x2v w2; w2.x = cvt_pk_bf16(v[0], v[1]); w2.y = cvt_pk_bf16(v[2], v[3]); *(u32x2v*)(Q + (size_t)row * DATT + c) = w2;
                                if (row >= MP) *(f32x4*)(SQKV + (size_t)(row - MP) * 1536 + c) = v; }
                    } else {
#pragma unroll
                        for (int bj = 0; bj < 2; ++bj)
#pragma unroll
                            for (int n = 0; n < 2; ++n) { const f32x4 v = y[bj][n]; const int c = hh * 64 + 32 * bj + 16 * n + 4 * fq;
                                u32x2v w2; w2.x = cvt_pk_bf16(v[0], v[1]); w2.y = cvt_pk_bf16(v[2], v[3]); *(u32x2v*)(K + (size_t)row * DATT + c) = w2;
                                if (row >= MP) { const int rs_ = row - MP, b = rs_ >> 3, s = rs_ & 7;
                                    *(f32x4*)(SQKV + (size_t)rs_ * 1536 + 512 + c) = v;
                                    *(f32x4*)(out + O_KS + ((size_t)b * WBUF + (WBUF - DSEQ) + s) * DATT + c) = v; }
                                else if (row >= MP - WBUF) *(f32x4*)(out + O_KP + (size_t)(row - (MP - WBUF)) * DATT + c) = v; }
                    }
                }
        } else if (pn < 6) {
#pragma unroll
            for (int ai = 0; ai < 2; ++ai)
#pragma unroll
                for (int m = 0; m < 4; ++m) { const int row = row0 + ai * HALF + m * 16;
#pragma unroll
                    for (int bj = 0; bj < 2; ++bj)
#pragma unroll
                        for (int n = 0; n < 2; ++n) { const f32x4 v = acc[ai][bj][m][n]; const int c = (pn - 4) * 256 + bj * HALF + wc * 32 + n * 16 + 4 * fq;
                            if (row >= MP) { const int rs_ = row - MP, b = rs_ >> 3, s = rs_ & 7;
                                *(f32x4*)(SQKV + (size_t)rs_ * 1536 + 1024 + c) = v;
                                *(f32x4*)(out + O_VS + ((size_t)b * WBUF + (WBUF - DSEQ) + s) * DATT + c) = v; }
                            else {
                                if (row >= MP - WBUF) *(f32x4*)(out + O_VP + (size_t)(row - (MP - WBUF)) * DATT + c) = v;
                                u32x2v w2; w2.x = cvt_pk_bf16(v[0], v[1]); w2.y = cvt_pk_bf16(v[2], v[3]); *(u32x2v*)(VT + (size_t)row * DATT + c) = w2;
                            } }
                }
        } else {
#pragma unroll
            for (int ai = 0; ai < 2; ++ai)
#pragma unroll
                for (int m = 0; m < 4; ++m) { const int row = row0 + ai * HALF + m * 16;
#pragma unroll
                    for (int bj = 0; bj < 2; ++bj)
#pragma unroll
                        for (int n = 0; n < 2; ++n) { const f32x4 v = acc[ai][bj][m][n]; const int c = (pn - 6) * 256 + bj * HALF + wc * 32 + n * 16 + 4 * fq;
                            u32x2v w2; w2.x = cvt_pk_bf16(v[0], v[1]); w2.y = cvt_pk_bf16(v[2], v[3]); *(u32x2v*)(U + (size_t)row * DSSM + c) = w2; }
                }
        }
    }
};
}

__device__ __forceinline__ void p0_transpose_item(const float* W, int K, int N, bf16* WT, int k0, int n0, int dest_row0, LAS float* scr, int lane) {
    float tv[32];
#pragma unroll
    for (int i = 0; i < 32; ++i) tv[i] = __builtin_nontemporal_load(W + (size_t)(k0 + 2 * i + (lane >> 5)) * N + n0 + (lane & 31));
#pragma unroll
    for (int i = 0; i < 32; ++i) scr[(2 * i + (lane >> 5)) * 33 + (lane & 31)] = tv[i];
    LDS_WAIT(); asm volatile("" ::: "memory");
    const int c = lane & 7;
#pragma unroll
    for (int j = 0; j < 4; ++j) { const int n = (lane >> 3) + 8 * j; const LAS float* s = scr + (8 * c) * 33 + n;
        v4u o; o.x = pk2(s[0 * 33], s[1 * 33]); o.y = pk2(s[2 * 33], s[3 * 33]); o.z = pk2(s[4 * 33], s[5 * 33]); o.w = pk2(s[6 * 33], s[7 * 33]);
        *(GAS v4u*)(WT + pg8::blk_off(dest_row0 + n, k0 + 8 * c, K)) = o; }
    LDS_WAIT(); asm volatile("" ::: "memory");
}
__device__ __forceinline__ int dest_row_of(int mode, int half, int n0);
__device__ __forceinline__ void p0_transpose_item8(const float* W, int K, int N, unsigned char* WT8, int k0, int n0, int dest_row0, const unsigned* amax, LAS float* scr, int lane) {
    float tv[32];
#pragma unroll
    for (int i = 0; i < 32; ++i) tv[i] = __builtin_nontemporal_load(W + (size_t)(k0 + 2 * i + (lane >> 5)) * N + n0 + (lane & 31));
#pragma unroll
    for (int i = 0; i < 32; ++i) scr[(2 * i + (lane >> 5)) * 33 + (lane & 31)] = tv[i];
    LDS_WAIT(); asm volatile("" ::: "memory");
    const int c = lane & 7; const float am = __builtin_bit_cast(float, amax[0]); const float qs = am > 0.f ? 127.0f / am : 0.f;
#pragma unroll
    for (int j = 0; j < 4; ++j) { const int n = (lane >> 3) + 8 * j; const LAS float* s = scr + (8 * c) * 33 + n;
        unsigned lo = 0u, hi = 0u;
#pragma unroll
        for (int q = 0; q < 4; ++q) { const int a = (int)__builtin_rintf(s[q * 33] * qs), b = (int)__builtin_rintf(s[(q + 4) * 33] * qs); lo |= ((unsigned)a & 0xffu) << (8 * q); hi |= ((unsigned)b & 0xffu) << (8 * q); }
        *(GAS v2u*)(WT8 + pg8::blk_byte(dest_row0 + n, k0 + 8 * c, K)) = (v2u){lo, hi}; }
    LDS_WAIT(); asm volatile("" ::: "memory");
}
__device__ __forceinline__ bool p0_mat8(const float* W, int K, int N, unsigned char* WT8, int half, const unsigned* amax, int& r, LAS float* scr, int lane) {
    const int nblk = N / 32, items = (K / 64) * nblk;
    if (r < items) { const int kb = r / nblk, nb = r % nblk; p0_transpose_item8(W, K, N, WT8, 64 * kb, 32 * nb, dest_row_of(1, half, 32 * nb), amax, scr, lane); return true; }
    r -= items; return false;
}
__device__ __forceinline__ int dest_row_of(int mode, int half, int n0) {
    if (mode == 1) return 256 * (n0 >> 7) + 128 * half + (n0 & 127);
    if (mode == 3) { const int hf = n0 >> 9, n = n0 & 511; return 256 * (n >> 7) + 128 * hf + (n & 127); }
    if (mode == 2 && n0 < 1024) { const int tile = n0 >> 8, hd = (n0 & 255) >> 6, e = n0 & 63; return 256 * tile + 128 * (e >> 5) + 32 * hd + (e & 31); }
    return n0;
}
__device__ __forceinline__ bool p0_mat(const float* W, int K, int N, bf16* WT, int mode, int half, int& r, LAS float* scr, int lane) {
    const int nblk = N / 32, items = (K / 64) * nblk;
    if (r < items) { const int kb = r / nblk, nb = r % nblk; p0_transpose_item(W, K, N, WT, 64 * kb, 32 * nb, dest_row_of(mode, half, 32 * nb), scr, lane); return true; }
    r -= items; return false;
}
__device__ __forceinline__ void p1_weights(Frame& F, const Args& A, int widx, int nworker) {
    LAS float* scr = (LAS float*)(F.lds + RING_OFF + F.wave * 16384);
    unsigned char* ws = A.ws;
    constexpr int NITEMS = 6 * 1408 + 1024 + 256 + 512;
    const unsigned* amax = (const unsigned*)(ws + WS_CTL) + CW_AMAX;
    for (int it = widx; it < NITEMS; it += nworker) {
        int r = it;
        if (p0_mat8(A.in[I_W1G], DM, DFF, ws + WS_W1T8, 0, amax + 0, r, scr, F.lane)) continue;
        if (p0_mat8(A.in[I_W1U], DM, DFF, ws + WS_W1T8, 1, amax + 1, r, scr, F.lane)) continue;
        if (p0_mat(A.in[I_W1D], DFF, DM, (bf16*)(ws + WS_W1D), 0, 0, r, scr, F.lane)) continue;
        if (p0_mat(A.in[I_WIN], DM, 2048, (bf16*)(ws + WS_WIN), 2, 0, r, scr, F.lane)) continue;
        if (p0_mat(A.in[I_WGLU], DSSM, 1024, (bf16*)(ws + WS_WGLU), 3, 0, r, scr, F.lane)) continue;
        if (p0_mat(A.in[I_WOUT], DM, DM, (bf16*)(ws + WS_WOUT), 0, 0, r, scr, F.lane)) continue;
        if (p0_mat8(A.in[I_W2G], DM, DFF, ws + WS_W2T8, 0, amax + 2, r, scr, F.lane)) continue;
        if (p0_mat8(A.in[I_W2U], DM, DFF, ws + WS_W2T8, 1, amax + 3, r, scr, F.lane)) continue;
        p0_mat(A.in[I_W2D], DFF, DM, (bf16*)(ws + WS_W2D), 0, 0, r, scr, F.lane);
    }
}
__device__ __forceinline__ void p0_prologue(Frame& F, const Args& A) {
    LAS float* scr = (LAS float*)(F.lds + RING_OFF + F.wave * 16384);
    const int gw = F.vcu * NWAVES + F.wave, NGW = F.G * NWAVES;
    unsigned char* ws = A.ws;
    for (int it = gw; it < 4608; it += NGW) { int r = it; p0_mat(A.in[I_WADA], DM, NADA, (bf16*)(ws + WS_WADA), 0, 0, r, scr, F.lane); }
    { unsigned* amax = (unsigned*)(ws + WS_CTL) + CW_AMAX;
      for (int it = gw; it < 4 * 44 * 8; it += NGW) { const int mat = it / 352, rem = it % 352, cb = rem >> 3, kb = rem & 7;
          const float* W = A.in[mat == 0 ? I_W1G : (mat == 1 ? I_W1U : (mat == 2 ? I_W2G : I_W2U))] + (size_t)(128 * kb) * DFF + 64 * cb + F.lane;
          float mx = 0.f;
#pragma unroll 16
          for (int k = 0; k < 128; ++k) mx = fmaxf(mx, fabsf(W[(size_t)k * DFF]));
          mx = wave_max(mx); if (F.lane == 0) atomicMax(amax + mat, __builtin_bit_cast(unsigned, mx)); } }
    const int gt = gw * 64 + F.lane, NGT = NGW * 64;
    { bf16* SC = (bf16*)(ws + WS_SC);
      for (int i = gt; i < 256 * DM / 2; i += NGT) { const int row = (2 * i) / DM, col = (2 * i) % DM; unsigned w = 0u;
          if (row < 129) { const float* c = row == 0 ? A.in[I_CP] : A.in[I_CS] + (size_t)(row - 1) * DM; const float a = c[col], b = c[col + 1]; w = pk2(a * fast_sigmoid(a), b * fast_sigmoid(b)); }
          *(GAS unsigned*)(SC + pg8::blk_off(row, col, DM)) = w; } }
    { _Float16* R = (_Float16*)(ws + WS_ROPE);
      for (int i = gt; i < MTOT * 8; i += NGT) { const int m = i >> 3, j = i & 7; const int pos = m < MP ? m : PAST + ((m - MP) & 7);
          const double inv = exp(-(double)j * (1.0 / 8.0) * 13.122363377404328  ); const double ang = (double)((float)pos * (float)inv);
          R[(size_t)m * 16 + j] = (_Float16)(float)cos(ang); R[(size_t)m * 16 + 8 + j] = (_Float16)(float)sin(ang); } }
    { unsigned char* T = ws + WS_SSMT;
      for (int id = gt; id < 83968; id += NGT) {
          if (id < 43008) {
              int gp, n; float* dst;
              if (id < 32768) { gp = id >> 4; n = (id & 15) + 1; dst = (float*)(T + ST_CP) + (size_t)gp * 32 + 2 * (id & 15); }
              else if (id < 40960) { const int i = id - 32768; gp = i >> 2; n = 1 << (i & 3); dst = (float*)(T + ST_PW) + (size_t)gp * 8 + 2 * (i & 3); }
              else { gp = id - 40960; n = CHUNK; dst = (float*)(T + ST_CL) + (size_t)gp * 2; }
              const double dt = exp((double)A.in[I_LDT][gp >> 6]); const double zr = (double)A.in[I_ARE][gp] * dt, zi = (double)A.in[I_AIM][gp] * dt;
              const double mg = exp((double)n * zr); dst[0] = (float)(mg * cos((double)n * zi)); dst[1] = (float)(mg * sin((double)n * zi));
          } else if (id < 75776) {
              const int i = id - 43008, gp = i >> 4, c = i & 15, grp = gp >> 6, p = gp & 63, pr = p >> 4, rho = p & 15;
              const double dt = exp((double)A.in[I_LDT][grp]); const double lre = (double)A.in[I_ARE][gp], lim = (double)A.in[I_AIM][gp];
              const double zr = lre * dt, zi = lim * dt; const double mg1 = exp(zr), br = mg1 * cos(zi) - 1.0, bi = mg1 * sin(zi); const double den = lre * lre + lim * lim;
              const double fr_ = (br * lre + bi * lim) / den, fi_ = (bi * lre - br * lim) / den;
              const double b_r = (double)A.in[I_BRE][(size_t)gp * 16 + c], b_i = (double)A.in[I_BIM][(size_t)gp * 16 + c];
              bf16* AB = (bf16*)(T + ST_ABAR) + (size_t)grp * 8 * 64 * 8; const int gq = c >> 3, j = c & 7;
              AB[((size_t)(2 * pr + 0) * 64 + rho + 16 * gq) * 8 + j] = (bf16)f2bf((float)(fr_ * b_r - fi_ * b_i));
              AB[((size_t)(2 * pr + 1) * 64 + rho + 16 * gq) * 8 + j] = (bf16)f2bf((float)(fr_ * b_i + fi_ * b_r));
              AB[((size_t)(2 * pr + 0) * 64 + rho + 16 * (gq + 2)) * 8 + j] = 0; AB[((size_t)(2 * pr + 1) * 64 + rho + 16 * (gq + 2)) * 8 + j] = 0;
          } else {
              const int i = id - 75776, grp = i >> 8, prc = (i >> 6) & 3, ln = i & 63, c = ln & 15, gq = ln >> 4;
              bf16* CMt = (bf16*)(T + ST_CM) + ((size_t)(grp * 4 + prc) * 64 + ln) * 8;
#pragma unroll
              for (int j = 0; j < 8; ++j) { const int ps = 16 * prc + 4 * gq + (j & 3);
                  const float v = (j < 4) ? A.in[I_CRE][((size_t)grp * 16 + c) * 64 + ps] : -A.in[I_CIM][((size_t)grp * 16 + c) * 64 + ps];
                  CMt[j] = (bf16)f2bf(v); }
          }
      } }
}

__device__ __forceinline__ void copy_tiles(const Args& A, int widx, int nworker, int lane) {
    constexpr int TPB = 255, NT = 2 * NBAT * TPB;
    for (int t = widx; t < NT; t += nworker) {
        const int kv = t / (NBAT * TPB), r = t % (NBAT * TPB), b = r / TPB, tl = r % TPB;
        const f32x4* src = (const f32x4*)(A.in[kv ? I_CV : I_CK] + (size_t)b * (WBUF * DATT) + DSEQ * DATT) + (size_t)tl * 1024 + lane;
        f32x4* dst = (f32x4*)(A.out + (kv ? O_VS : O_KS) + (size_t)b * (WBUF * DATT)) + (size_t)tl * 1024 + lane;
        f32x4 v[16];
#pragma unroll
        for (int j = 0; j < 16; ++j) v[j] = __builtin_nontemporal_load(src + 64 * j);
#pragma unroll
        for (int j = 0; j < 16; ++j) __builtin_nontemporal_store(v[j], dst + 64 * j);
    }
}

struct Combine { const float* slab; int nsl; const float* cbase; int gate_off; float ccoef; float* cres; };
__device__ __forceinline__ f32x4 bf4(const v2u w) { return (f32x4){__builtin_bit_cast(float, w.x << 16), __builtin_bit_cast(float, w.x & 0xffff0000u), __builtin_bit_cast(float, w.y << 16), __builtin_bit_cast(float, w.y & 0xffff0000u)}; }
template <int NSL>
__device__ __forceinline__ f32x4 combine_chunk(const Combine& C, const float* ar, int ms, int lane, int j) {
    v2u sl[NSL];
#pragma unroll
    for (int k = 0; k < NSL; ++k) sl[k] = ((const v2u*)((const bf16*)C.slab + ((size_t)k * MS + ms) * DM))[lane + 64 * j];
    const f32x4 gv = ((const f32x4*)(ar + C.gate_off))[lane + 64 * j], bv = ((const f32x4*)(C.cbase + (size_t)ms * DM))[lane + 64 * j];
    f32x4 acc = bf4(sl[0]);
#pragma unroll
    for (int k = 1; k < NSL; ++k) acc += bf4(sl[k]);
    const f32x4 r = bv + C.ccoef * gv * acc;
    ((f32x4*)(C.cres + (size_t)ms * DM))[lane + 64 * j] = r;
    return r;
}
template <int NSL>
__device__ __forceinline__ void combine_row(const Combine& C, const float* ar, int ms, int lane, f32x4 (&v)[4]) {
#pragma unroll
    for (int j = 0; j < 4; ++j) v[j] = combine_chunk<NSL>(C, ar, ms, lane, j);
}
template <bool PBF>
__device__ __forceinline__ f32x4 ld_prow(const float* srcP, const int m, const int i) {
    if constexpr (!PBF) return ((const f32x4*)(srcP + (size_t)m * DM))[i];
    else { const v2u w = ((const v2u*)((const bf16*)srcP + (size_t)m * DM))[i];
        return (f32x4){__builtin_bit_cast(float, w.x << 16), __builtin_bit_cast(float, w.x & 0xffff0000u), __builtin_bit_cast(float, w.y << 16), __builtin_bit_cast(float, w.y & 0xffff0000u)}; }
}
template <bool Q8>
__device__ __forceinline__ void norm_row(const f32x4 (&v)[4], const f32x4 (&gv)[4], const f32x4 (&sh)[4], const f32x4 (&sc)[4], const int m, const int lane, bf16* XN, unsigned char* XN8, float* sA) {
    float s = 0.f;
#pragma unroll
    for (int j = 0; j < 4; ++j) s += (v[j].x * v[j].x + v[j].y * v[j].y) + (v[j].z * v[j].z + v[j].w * v[j].w);
    const float rstd = 1.f / sqrtf(wave_sum(s) * (1.f / DM) + EPS);
    f32x4 y[4]; float am = 0.f;
#pragma unroll
    for (int j = 0; j < 4; ++j) { y[j] = (v[j] * rstd * gv[j]) * (1.0f + sc[j]) + sh[j];
        am = fmaxf(am, fmaxf(fmaxf(fabsf(y[j].x), fabsf(y[j].y)), fmaxf(fabsf(y[j].z), fabsf(y[j].w)))); }
    if constexpr (Q8) {
        am = wave_max(am); const float qs = am > 0.f ? 127.0f / am : 0.f;
#pragma unroll
        for (int j = 0; j < 4; ++j) { const int a = (int)__builtin_rintf(y[j].x * qs), b = (int)__builtin_rintf(y[j].y * qs), c = (int)__builtin_rintf(y[j].z * qs), d = (int)__builtin_rintf(y[j].w * qs);
            *(GAS unsigned*)(XN8 + pg8::blk_byte(m, 4 * lane + 256 * j, DM)) = ((unsigned)a & 0xffu) | (((unsigned)b & 0xffu) << 8) | (((unsigned)c & 0xffu) << 16) | (((unsigned)d & 0xffu) << 24); }
        if (lane == 0) sA[m] = am * (1.0f / 127.0f);
    } else {
#pragma unroll
        for (int j = 0; j < 4; ++j) *(GAS unsigned long long*)(XN + pg8::blk_off(m, 4 * lane + 256 * j, DM)) = (unsigned long long)pk2(y[j].x, y[j].y) | ((unsigned long long)pk2(y[j].z, y[j].w) << 32);
    }
}
template <bool Q8, int NSL, int PE, bool PBF>
__device__ __forceinline__ void norm_mod_rows(Frame& F, const float* srcP, const float* srcS, const float* g, const float* ada, int sh_off, int sc_off, bf16* XN, const Combine C, unsigned char* XN8, float* sA) {
    f32x4 gv[4];
#pragma unroll
    for (int j = 0; j < 4; ++j) gv[j] = ((const f32x4*)g)[F.lane + 64 * j];
    if (F.G == 256) {
        const int pair = F.wave >> 1, odd = F.wave & 1;
        const int np = odd ? 16 - PE : PE, p0 = F.vcu * 64 + pair * 16 + (odd ? PE : 0);
        f32x4 vn[4], sh[4], sc[4];
#pragma unroll
        for (int j = 0; j < 4; ++j) vn[j] = ld_prow<PBF>(srcP, p0, F.lane + 64 * j);
        if (!odd) {
            const int ms = F.vcu * 4 + pair, m = MP + ms; const float* ar = ada + (size_t)ada_row(m) * NADA;
            f32x4 v[4];
#pragma unroll
            for (int j = 0; j < 4; ++j) { sh[j] = ((const f32x4*)(ar + sh_off))[F.lane + 64 * j]; sc[j] = ((const f32x4*)(ar + sc_off))[F.lane + 64 * j]; }
            if constexpr (NSL > 0) combine_row<NSL>(C, ar, ms, F.lane, v);
            else {
#pragma unroll
                for (int j = 0; j < 4; ++j) v[j] = ((const f32x4*)(srcS + (size_t)ms * DM))[F.lane + 64 * j]; }
            norm_row<Q8>(v, gv, sh, sc, m, F.lane, XN, XN8, sA);
        }
#pragma unroll
        for (int j = 0; j < 4; ++j) { sh[j] = ((const f32x4*)(ada + sh_off))[F.lane + 64 * j]; sc[j] = ((const f32x4*)(ada + sc_off))[F.lane + 64 * j]; }
#pragma unroll 1
        for (int i = 0; i < np; ++i) {
            f32x4 v[4];
#pragma unroll
            for (int j = 0; j < 4; ++j) v[j] = vn[j];
            const int nx = p0 + (i + 1 < np ? i + 1 : i);
#pragma unroll
            for (int j = 0; j < 4; ++j) vn[j] = ld_prow<PBF>(srcP, nx, F.lane + 64 * j);
            norm_row<Q8>(v, gv, sh, sc, p0 + i, F.lane, XN, XN8, sA);
        }
        return;
    }
    const int gw = F.vcu * NWAVES + F.wave, NGW = F.G * NWAVES;
    for (int m = gw; m < MTOT; m += NGW) {
        const float* ar = ada + (size_t)ada_row(m) * NADA;
        f32x4 v[4], sh[4], sc[4];
#pragma unroll
        for (int j = 0; j < 4; ++j) { sh[j] = ((const f32x4*)(ar + sh_off))[F.lane + 64 * j]; sc[j] = ((const f32x4*)(ar + sc_off))[F.lane + 64 * j]; }
        bool done = false;
        if constexpr (NSL > 0) { if (m >= MP) { combine_row<NSL>(C, ar, m - MP, F.lane, v); done = true; } }
        if (!done) {
#pragma unroll
            for (int j = 0; j < 4; ++j) v[j] = m < MP ? ld_prow<PBF>(srcP, m, F.lane + 64 * j) : ((const f32x4*)(srcS + (size_t)(m - MP) * DM))[F.lane + 64 * j]; }
        norm_row<Q8>(v, gv, sh, sc, m, F.lane, XN, XN8, sA);
    }
}

__device__ __forceinline__ void copy_back(pg8::CopyJob& C, int nops, const int lane) {
    while (nops > 0 && C.end > C.cur) {
        int nb = C.end - C.cur; nb = nb < 8 ? nb : 8; nb = nb < nops ? nb : nops;
        v4u v[8];
#pragma unroll
        for (int j = 0; j < 8; ++j) if (j < nb) v[j] = __builtin_nontemporal_load((const v4u*)(C.src + (size_t)(C.end - 1 - j) * pg8::CP_STRIDE) + lane);
#pragma unroll
        for (int j = 0; j < 8; ++j) if (j < nb) __builtin_nontemporal_store(v[j], (v4u*)(C.dst + (size_t)(C.end - 1 - j) * pg8::CP_STRIDE) + lane);
        C.end -= nb; nops -= nb;
    }
}

__device__ __forceinline__ bf16x8 ld8(const bf16* p) { return *(const bf16x8*)p; }
#define MFMA16(a, b, c) __builtin_amdgcn_mfma_f32_16x16x32_bf16((a), (b), (c), 0, 0, 0)

constexpr int AT_ROWB = 144, AT_VOFF = 384 * AT_ROWB;
typedef short s16x4 __attribute__((ext_vector_type(4)));
__device__ __forceinline__ s16x4 lds_tr(const LAS unsigned char* p) { return __builtin_amdgcn_ds_read_tr16_b64_v4i16((LAS s16x4*)p); }
__device__ __forceinline__ void attn_unit(unsigned char* ws, LAS unsigned char* lds, const int unit, const int tid, const int wave, const int lane) {
    const int G = unit >> 9, u = unit & 511, h = u >> 6;
    int r, sb, d, L;
    if (G == 0) { d = 1; L = 16384; r = 0; sb = u & 63; } else if (G == 1) { d = 4; L = 4096; r = (u >> 4) & 3; sb = u & 15; } else { d = 16; L = 1024; r = (u >> 2) & 15; sb = u & 3; }
    const int q0 = sb * 256, k0 = q0 - 128;
    const bf16* Q = (const bf16*)(ws + WS_Q); const bf16* Kb = (const bf16*)(ws + WS_K) + h * 64; const bf16* Vb = (const bf16*)(ws + WS_VT) + h * 64;
#pragma unroll
    for (int i = 0; i < 6; ++i) { const int c = tid + 512 * i, row = c >> 3, ch = c & 7; int kk = k0 + row; kk = kk < 0 ? 0 : (kk > L - 1 ? L - 1 : kk);
        const size_t off = (size_t)(r + d * kk) * DATT + ch * 8;
        const v4u kv = *(const v4u*)(Kb + off), vv = *(const v4u*)(Vb + off);
        *(LAS v4u*)(lds + row * AT_ROWB + ch * 16) = kv; *(LAS v4u*)(lds + AT_VOFF + row * AT_ROWB + ch * 16) = vv; }
    __syncthreads();
    const int l15 = lane & 15, g = lane >> 4, kb0 = 32 * wave;
    bf16x8 qf[2][2];
#pragma unroll
    for (int cb = 0; cb < 2; ++cb) { const size_t tq = (size_t)r + (size_t)d * (q0 + 32 * wave + 16 * cb + l15); const bf16* qp = Q + tq * DATT + h * 64 + 8 * g; qf[cb][0] = ld8(qp); qf[cb][1] = ld8(qp + 32); }
    f32x4 s[2][10];
#pragma unroll
    for (int pp = 0; pp < 5; ++pp)
#pragma unroll
        for (int hb = 0; hb < 2; ++hb) {
            const int kw = kb0 + 32 * pp + 8 * (l15 >> 2) + 4 * hb + (l15 & 3);
            const LAS unsigned char* kp = lds + kw * AT_ROWB + 16 * g;
            const bf16x8 a0 = *(const LAS bf16x8*)kp, a1 = *(const LAS bf16x8*)(kp + 64);
#pragma unroll
            for (int cb = 0; cb < 2; ++cb) { f32x4 z = {0.f, 0.f, 0.f, 0.f}; z = MFMA16(a0, qf[cb][0], z); z = MFMA16(a1, qf[cb][1], z); s[cb][2 * pp + hb] = z; }
        }
    float mx[2], ls[2];
#pragma unroll
    for (int cb = 0; cb < 2; ++cb) {
        const int qi = 32 * wave + 16 * cb + l15; float m = -1e30f;
#pragma unroll
        for (int i = 0; i < 10; ++i)
#pragma unroll
            for (int e = 0; e < 4; ++e) { const int kw = kb0 + 32 * (i >> 1) + 8 * g + 4 * (i & 1) + e; const bool valid = (kw >= qi) && (kw <= qi + 128) && (k0 + kw >= 0);
                const float v = valid ? s[cb][i][e] : -1e30f; s[cb][i][e] = v; m = fmaxf(m, v); }
        m = fmaxf(m, __shfl_xor(m, 16)); m = fmaxf(m, __shfl_xor(m, 32));
        float l = 0.f;
#pragma unroll
        for (int i = 0; i < 10; ++i)
#pragma unroll
            for (int e = 0; e < 4; ++e) { const float p = __builtin_amdgcn_exp2f(s[cb][i][e] - m); s[cb][i][e] = p; l += p; }
        l += __shfl_xor(l, 16); l += __shfl_xor(l, 32);
        mx[cb] = m; ls[cb] = l;
    }
    f32x4 o[2][4];
#pragma unroll
    for (int cb = 0; cb < 2; ++cb)
#pragma unroll
        for (int nb = 0; nb < 4; ++nb) o[cb][nb] = (f32x4){0.f, 0.f, 0.f, 0.f};
#pragma unroll
    for (int pp = 0; pp < 5; ++pp) {
        bf16x8 pb[2];
#pragma unroll
        for (int cb = 0; cb < 2; ++cb) { v4u pw; pw.x = pk2(s[cb][2 * pp][0], s[cb][2 * pp][1]); pw.y = pk2(s[cb][2 * pp][2], s[cb][2 * pp][3]); pw.z = pk2(s[cb][2 * pp + 1][0], s[cb][2 * pp + 1][1]); pw.w = pk2(s[cb][2 * pp + 1][2], s[cb][2 * pp + 1][3]);
            pb[cb] = __builtin_bit_cast(bf16x8, pw); }
        const LAS unsigned char* vp = lds + AT_VOFF + (kb0 + 32 * pp + 8 * g + (l15 >> 2)) * AT_ROWB + 8 * (l15 & 3);
#pragma unroll
        for (int nb = 0; nb < 4; ++nb) { const s16x4 t0 = lds_tr(vp + 32 * nb), t1 = lds_tr(vp + 4 * AT_ROWB + 32 * nb);
            const bf16x8 av = {t0[0], t0[1], t0[2], t0[3], t1[0], t1[1], t1[2], t1[3]};
#pragma unroll
            for (int cb = 0; cb < 2; ++cb) o[cb][nb] = MFMA16(av, pb[cb], o[cb][nb]); }
    }
    bf16* OP = (bf16*)(ws + WS_OP); float* ML = (float*)(ws + WS_ML);
#pragma unroll
    for (int cb = 0; cb < 2; ++cb) { const size_t tq = (size_t)r + (size_t)d * (q0 + 32 * wave + 16 * cb + l15); const size_t rowi = ((size_t)G * SEQ + tq) * NH + h; const float inv = 1.0f / ls[cb];
#pragma unroll
        for (int nb = 0; nb < 4; ++nb) { const f32x4 v = o[cb][nb] * inv; v2u w; w.x = pk2(v[0], v[1]); w.y = pk2(v[2], v[3]); *(v2u*)(OP + rowi * 64 + 16 * nb + 4 * g) = w; }
        if (g == 0) *(f32x2*)(ML + rowi * 2) = (f32x2){mx[cb], ls[cb]}; }
    __syncthreads();
}
constexpr int AT4_VOFF = 256 * AT_ROWB;
__device__ __forceinline__ void sync4(LAS unsigned* cnt, unsigned& epoch, const int lane) {
    asm volatile("s_waitcnt vmcnt(0) lgkmcnt(0)" ::: "memory");
    epoch += 4u;
    if (lane == 0) __hip_atomic_fetch_add(cnt, 1u, __ATOMIC_RELAXED, __HIP_MEMORY_SCOPE_WORKGROUP);
    for (unsigned sp = 0; __hip_atomic_load(cnt, __ATOMIC_RELAXED, __HIP_MEMORY_SCOPE_WORKGROUP) < epoch && sp < (1u << 22); ++sp) __builtin_amdgcn_s_sleep(1);
    asm volatile("s_waitcnt lgkmcnt(0)" ::: "memory");
}
struct AttU { int G, h, r, d, q0, k0, edge; };
__device__ __forceinline__ AttU att_decode(const int unit) {
    AttU a; a.G = unit >> 10; const int u = unit & 1023, rest = u & 127; a.h = u >> 7; int sb;
    if (a.G == 0) { a.d = 1; a.r = 0; sb = rest; } else if (a.G == 1) { a.d = 4; a.r = rest >> 5; sb = rest & 31; } else { a.d = 16; a.r = rest >> 3; sb = rest & 7; }
    a.q0 = sb * 128; a.k0 = a.q0 - 128; a.edge = (sb == 0); return a;
}
__device__ __forceinline__ void att_load(unsigned char* ws, const AttU& a, const int tid4, v4u (&kv)[8], v4u (&vv)[8]) {
    const bf16* Kb = (const bf16*)(ws + WS_K) + a.h * 64; const bf16* Vb = (const bf16*)(ws + WS_VT) + a.h * 64;
#pragma unroll
    for (int i = 0; i < 8; ++i) { const int c = tid4 + 256 * i, row = c >> 3, ch = c & 7; int kk = a.k0 + row; kk = kk < 0 ? 0 : kk;
        const size_t off = (size_t)(a.r + a.d * kk) * DATT + ch * 8; kv[i] = *(const v4u*)(Kb + off); vv[i] = *(const v4u*)(Vb + off); }
}
__device__ __forceinline__ void att_store(LAS unsigned char* lds, const int tid4, const v4u (&kv)[8], const v4u (&vv)[8]) {
#pragma unroll
    for (int i = 0; i < 8; ++i) { const int c = tid4 + 256 * i, row = c >> 3, ch = c & 7;
        *(LAS v4u*)(lds + row * AT_ROWB + ch * 16) = kv[i]; *(LAS v4u*)(lds + AT4_VOFF + row * AT_ROWB + ch * 16) = vv[i]; }
}
__device__ __forceinline__ void attn_unit4_compute(unsigned char* ws, LAS unsigned char* lds, const AttU& au, const int wave, const int lane, const bool pf, const AttU& nxt, const int tid4, v4u (&kv)[8], v4u (&vv)[8]) {
    const int G = au.G, h = au.h, r = au.r, d = au.d, q0 = au.q0, k0 = au.k0; const bool edge = au.edge != 0;
    const bf16* Q = (const bf16*)(ws + WS_Q);
    const int l15 = lane & 15, g = lane >> 4, kb0 = 32 * wave;
    bf16x8 qf[2][2];
#pragma unroll
    for (int cb = 0; cb < 2; ++cb) { const size_t tq = (size_t)r + (size_t)d * (q0 + 32 * wave + 16 * cb + l15); const bf16* qp = Q + tq * DATT + h * 64 + 8 * g; qf[cb][0] = ld8(qp); qf[cb][1] = ld8(qp + 32); }
    float mx[2], ls[2]; bf16x8 pb[2][5];
#pragma unroll
    for (int cb = 0; cb < 2; ++cb) {
        f32x4 s[10];
#pragma unroll
        for (int pp = 0; pp < 5; ++pp)
#pragma unroll
            for (int hb = 0; hb < 2; ++hb) {
                const int kw = kb0 + 32 * pp + 8 * (l15 >> 2) + 4 * hb + (l15 & 3);
                const LAS unsigned char* kp = lds + kw * AT_ROWB + 16 * g;
                const bf16x8 a0 = *(const LAS bf16x8*)kp, a1 = *(const LAS bf16x8*)(kp + 64);
                f32x4 z = {0.f, 0.f, 0.f, 0.f}; z = MFMA16(a0, qf[cb][0], z); z = MFMA16(a1, qf[cb][1], z); s[2 * pp + hb] = z;
            }
        const int qi = 32 * wave + 16 * cb + l15; float m = -1e30f;
#pragma unroll
        for (int i = 0; i < 10; ++i) {
            const bool interior = (i >= 2 && i < 8);
            if (!interior || edge) {
#pragma unroll
                for (int e = 0; e < 4; ++e) { const int kw = kb0 + 32 * (i >> 1) + 8 * g + 4 * (i & 1) + e; const bool valid = (kw >= qi) && (kw <= qi + 128) && (k0 + kw >= 0);
                    s[i][e] = valid ? s[i][e] : -1e30f; }
            }
#pragma unroll
            for (int e = 0; e < 4; ++e) m = fmaxf(m, s[i][e]);
        }
        m = fmaxf(m, __shfl_xor(m, 16)); m = fmaxf(m, __shfl_xor(m, 32));
        float l = 0.f;
#pragma unroll
        for (int i = 0; i < 10; ++i)
#pragma unroll
            for (int e = 0; e < 4; ++e) { const float p = __builtin_amdgcn_exp2f(s[i][e] - m); s[i][e] = p; l += p; }
        l += __shfl_xor(l, 16); l += __shfl_xor(l, 32);
        mx[cb] = m; ls[cb] = l;
#pragma unroll
        for (int pp = 0; pp < 5; ++pp) { v4u pw; pw.x = pk2(s[2 * pp][0], s[2 * pp][1]); pw.y = pk2(s[2 * pp][2], s[2 * pp][3]); pw.z = pk2(s[2 * pp + 1][0], s[2 * pp + 1][1]); pw.w = pk2(s[2 * pp + 1][2], s[2 * pp + 1][3]);
            pb[cb][pp] = __builtin_bit_cast(bf16x8, pw); }
    }
    if (pf) att_load(ws, nxt, tid4, kv, vv);
    f32x4 o[2][4];
#pragma unroll
    for (int cb = 0; cb < 2; ++cb)
#pragma unroll
        for (int nb = 0; nb < 4; ++nb) o[cb][nb] = (f32x4){0.f, 0.f, 0.f, 0.f};
#pragma unroll
    for (int pp = 0; pp < 5; ++pp) {
        const LAS unsigned char* vp = lds + AT4_VOFF + (kb0 + 32 * pp + 8 * g + (l15 >> 2)) * AT_ROWB + 8 * (l15 & 3);
#pragma unroll
        for (int nb = 0; nb < 4; ++nb) { const s16x4 t0 = lds_tr(vp + 32 * nb), t1 = lds_tr(vp + 4 * AT_ROWB + 32 * nb);
            const bf16x8 av = {t0[0], t0[1], t0[2], t0[3], t1[0], t1[1], t1[2], t1[3]};
#pragma unroll
            for (int cb = 0; cb < 2; ++cb) o[cb][nb] = MFMA16(av, pb[cb][pp], o[cb][nb]); }
    }
    bf16* OP = (bf16*)(ws + WS_OP); float* ML = (float*)(ws + WS_ML);
#pragma unroll
    for (int cb = 0; cb < 2; ++cb) { const size_t tq = (size_t)r + (size_t)d * (q0 + 32 * wave + 16 * cb + l15); const size_t rowi = ((size_t)G * SEQ + tq) * NH + h; const float inv = 1.0f / ls[cb];
#pragma unroll
        for (int nb = 0; nb < 4; ++nb) { const f32x4 v = o[cb][nb] * inv; v2u w; w.x = pk2(v[0], v[1]); w.y = pk2(v[2], v[3]); *(v2u*)(OP + rowi * 64 + 16 * nb + 4 * g) = w; }
        if (g == 0) *(f32x2*)(ML + rowi * 2) = (f32x2){mx[cb], ls[cb]}; }
}
__device__ __forceinline__ void attn_units4(unsigned char* ws, LAS unsigned char* lds, LAS unsigned* cnt, unsigned& epoch, const int u0, const int ustride, const int nunits, const int tid4, const int wave, const int lane) {
    if (u0 >= nunits) return;
    v4u kv[8], vv[8];
    AttU cur = att_decode(u0 % 3072); att_load(ws, cur, tid4, kv, vv);
    for (int u = u0; u < nunits; u += ustride) {
        sync4(cnt, epoch, lane);
        att_store(lds, tid4, kv, vv);
        sync4(cnt, epoch, lane);
        const int un = u + ustride; AttU nxt = cur; const bool pf = un < nunits;
        if (pf) nxt = att_decode(un % 3072);
        attn_unit4_compute(ws, lds, cur, wave, lane, pf, nxt, tid4, kv, vv);
        cur = nxt;
    }
}
__device__ __forceinline__ void attn_combine(unsigned char* ws, const int t, const int lane) {
    const bf16* OP = (const bf16*)(ws + WS_OP); const float* ML = (const float*)(ws + WS_ML); bf16* MIX = (bf16*)(ws + WS_MIX);
    const int h = lane >> 3, dg = lane & 7;
    f32x2 ml[3]; v4u ov[3];
#pragma unroll
    for (int G = 0; G < 3; ++G) { const size_t rowi = ((size_t)G * SEQ + t) * NH + h; ml[G] = *(const f32x2*)(ML + rowi * 2); ov[G] = *(const v4u*)(OP + rowi * 64 + 8 * dg); }
    const float M = fmaxf(ml[0].x, fmaxf(ml[1].x, ml[2].x));
    float w[3], ws_ = 0.f;
#pragma unroll
    for (int G = 0; G < 3; ++G) { w[G] = ml[G].y * __builtin_amdgcn_exp2f(ml[G].x - M); ws_ += w[G]; }
    const float inv = 1.0f / ws_;
    float acc[8];
#pragma unroll
    for (int i = 0; i < 8; ++i) acc[i] = 0.f;
#pragma unroll
    for (int G = 0; G < 3; ++G) { const float wg = w[G] * inv;
#pragma unroll
        for (int i = 0; i < 4; ++i) { const unsigned x = ov[G][i]; acc[2 * i] += wg * __builtin_bit_cast(float, x << 16); acc[2 * i + 1] += wg * __builtin_bit_cast(float, x & 0xffff0000u); } }
    v4u o; o.x = pk2(acc[0], acc[1]); o.y = pk2(acc[2], acc[3]); o.z = pk2(acc[4], acc[5]); o.w = pk2(acc[6], acc[7]);
    *(v4u*)(MIX + pg8::blk_off(t, h * 64 + 8 * dg, DM)) = o;
}
__device__ __forceinline__ void attn_sample_item(const Args& A, unsigned char* ws, const int item, const int lane) {
    const int s = item & 7, h = (item >> 3) & 7, b = item >> 6; const int part = lane & 3, ks = lane >> 2;
    const float* SQ = (const float*)(ws + WS_SQKV); bf16* MIX = (bf16*)(ws + WS_MIX);
    f32x4 qv[4];
#pragma unroll
    for (int i = 0; i < 4; ++i) qv[i] = *(const f32x4*)(SQ + (size_t)(b * 8 + s) * 1536 + h * 64 + 16 * i + 4 * part);
    float m = -1e30f, l = 0.f; f32x4 o[4];
#pragma unroll
    for (int i = 0; i < 4; ++i) o[i] = (f32x4){0.f, 0.f, 0.f, 0.f};
#define SMP_LOAD(RND, KV, VV) do { const int e_ = 16 * (RND) + ks; const int ec_ = e_ < 387 ? e_ : 0; const int G_ = ec_ / 129, j_ = ec_ - 129 * G_; const int idx_ = WBUF + s - (j_ << (2 * G_)); \
        const bool inb_ = idx_ < WBUF; \
        const size_t coff_ = (((size_t)b * WBUF + (inb_ ? idx_ : 0)) * NH + h) * HD + 4 * part, noff_ = (size_t)(b * 8 + (inb_ ? 0 : idx_ - WBUF)) * 1536 + h * 64 + 4 * part; \
        const float* kp_ = inb_ ? A.in[I_CK] + coff_ : SQ + noff_ + 512; const float* vp_ = inb_ ? A.in[I_CV] + coff_ : SQ + noff_ + 1024; \
        if ((RND) >= 17) { _Pragma("unroll") for (int i = 0; i < 4; ++i) { KV[i] = __builtin_nontemporal_load((const f32x4*)(kp_ + 16 * i)); VV[i] = __builtin_nontemporal_load((const f32x4*)(vp_ + 16 * i)); } }     \
        else { _Pragma("unroll") for (int i = 0; i < 4; ++i) { KV[i] = *(const f32x4*)(kp_ + 16 * i); VV[i] = *(const f32x4*)(vp_ + 16 * i); } } } while (0)
    f32x4 kc[4], vc[4], kn[4], vn[4];
    SMP_LOAD(0, kc, vc);
#pragma unroll 1
    for (int rnd = 0; rnd < 25; ++rnd) {
        const int rn = rnd + 1 < 25 ? rnd + 1 : 24;
        SMP_LOAD(rn, kn, vn);
        const bool valid = 16 * rnd + ks < 387;
        float d = 0.f;
#pragma unroll
        for (int i = 0; i < 4; ++i) d += (qv[i].x * kc[i].x + qv[i].y * kc[i].y) + (qv[i].z * kc[i].z + qv[i].w * kc[i].w);
        d += __shfl_xor(d, 1); d += __shfl_xor(d, 2);
        d = valid ? d : -1e30f;
        const float mn = fmaxf(m, d), alpha = __builtin_amdgcn_exp2f(m - mn), p = __builtin_amdgcn_exp2f(d - mn);
        l = l * alpha + p; m = mn;
#pragma unroll
        for (int i = 0; i < 4; ++i) { o[i] = o[i] * alpha + p * vc[i]; kc[i] = kn[i]; vc[i] = vn[i]; }
    }
#undef SMP_LOAD
    float M = m;
#pragma unroll
    for (int off = 4; off < 64; off <<= 1) M = fmaxf(M, __shfl_xor(M, off));
    const float scl = __builtin_amdgcn_exp2f(m - M); l *= scl;
#pragma unroll
    for (int off = 4; off < 64; off <<= 1) l += __shfl_xor(l, off);
    const float inv = 1.0f / l;
#pragma unroll
    for (int i = 0; i < 4; ++i) { f32x4 v = o[i] * scl;
#pragma unroll
        for (int off = 4; off < 64; off <<= 1)
#pragma unroll
            for (int e = 0; e < 4; ++e) v[e] += __shfl_xor(v[e], off);
        if (ks == 0) { v2u w; w.x = pk2(v[0] * inv, v[1] * inv); w.y = pk2(v[2] * inv, v[3] * inv);
            *(v2u*)(MIX + pg8::blk_off(MP + b * 8 + s, h * 64 + 16 * i + 4 * part, DM)) = w; } }
}


template <int SH> __device__ __forceinline__ float dpp_shr_t(float v) {
    return __builtin_bit_cast(float, __builtin_amdgcn_update_dpp(0, __builtin_bit_cast(int, v), 0x110 + SH, 0xf, 0xf, true));
}
template <int ROT> __device__ __forceinline__ float dpp_ror_t(float v) {
    return __builtin_bit_cast(float, __builtin_amdgcn_update_dpp(0, __builtin_bit_cast(int, v), 0x120 + ROT, 0xf, 0xf, false));
}
__device__ __forceinline__ void ssm_pass1_unit(unsigned char* ws, const int grp, const int chunk, const int lane) {
    const int t = lane & 15, g = lane >> 4; const int m0 = chunk * CHUNK;
    const bf16* U = (const bf16*)(ws + WS_U); const unsigned char* T = ws + WS_SSMT;
    const bf16* ABAR = (const bf16*)(T + ST_ABAR); const float* CP = (const float*)(T + ST_CP);
    bf16x8 ub[8];
#pragma unroll
    for (int blk = 0; blk < 8; ++blk) { bf16x8 z = {0, 0, 0, 0, 0, 0, 0, 0}; if (g < 2) z = ld8(U + (size_t)(m0 + 16 * blk + t) * DSSM + 16 * grp + 8 * g); ub[blk] = z; }
#pragma unroll 1
    for (int pr = 0; pr < 4; ++pr) {
        const bf16x8 are = ld8(ABAR + ((size_t)(grp * 8 + 2 * pr) * 64 + lane) * 8), aim = ld8(ABAR + ((size_t)(grp * 8 + 2 * pr + 1) * 64 + lane) * 8);
        const int p0 = 16 * pr + 4 * g;
        float wr_[4], wi_[4], l16r[4], l16i[4], sr[4], si[4];
#pragma unroll
        for (int i = 0; i < 4; ++i) { const float* cp = CP + (size_t)(grp * 64 + p0 + i) * 32;
            const f32x2 w = *(const f32x2*)(cp + 2 * (t == 15 ? 0 : 14 - t)); wr_[i] = (t == 15) ? 1.0f : w.x; wi_[i] = (t == 15) ? 0.0f : w.y;
            const f32x2 l = *(const f32x2*)(cp + 30); l16r[i] = l.x; l16i[i] = l.y; sr[i] = 0.f; si[i] = 0.f; }
#pragma unroll
        for (int blk = 0; blk < 8; ++blk) {
            const f32x4 z4 = {0.f, 0.f, 0.f, 0.f};
            const f32x4 hre = MFMA16(are, ub[blk], z4), him = MFMA16(aim, ub[blk], z4);
#pragma unroll
            for (int i = 0; i < 4; ++i) {
                float pr_ = wr_[i] * hre[i] - wi_[i] * him[i], pi_ = wr_[i] * him[i] + wi_[i] * hre[i];
                pr_ += dpp_ror_t<8>(pr_); pi_ += dpp_ror_t<8>(pi_); pr_ += dpp_ror_t<4>(pr_); pi_ += dpp_ror_t<4>(pi_);
                pr_ += dpp_ror_t<2>(pr_); pi_ += dpp_ror_t<2>(pi_); pr_ += dpp_ror_t<1>(pr_); pi_ += dpp_ror_t<1>(pi_);
                const float nr = l16r[i] * sr[i] - l16i[i] * si[i] + pr_, ni = l16r[i] * si[i] + l16i[i] * sr[i] + pi_; sr[i] = nr; si[i] = ni;
            }
        }
        if (t == 0) { float* CS = (float*)(ws + WS_CS) + ((size_t)(chunk * NG + grp) * NP + p0) * 2;
            *(f32x4*)CS = (f32x4){sr[0], si[0], sr[1], si[1]}; *(f32x4*)(CS + 4) = (f32x4){sr[2], si[2], sr[3], si[3]}; }
    }
}
template <bool PASS2, bool SAMPLE, int NBLK>
__device__ __forceinline__ void ssm_unit(const Args& A, unsigned char* ws, const int grp, const int chunk, const LAS float* carr, const int lane) {
    const int t = lane & 15, g = lane >> 4, tt = SAMPLE ? (t & 7) : t;
    const int m0 = SAMPLE ? MP + chunk * (16 * NBLK) : chunk * (16 * NBLK);
    const bf16* U = (const bf16*)(ws + WS_U); bf16* GB = (bf16*)(ws + WS_GB);
    const unsigned char* T = ws + WS_SSMT;
    const bf16* ABAR = (const bf16*)(T + ST_ABAR); const bf16* CMt = (const bf16*)(T + ST_CM);
    const float* PW = (const float*)(T + ST_PW); const float* CP = (const float*)(T + ST_CP);
    bf16x8 ub[NBLK];
#pragma unroll
    for (int blk = 0; blk < NBLK; ++blk) { bf16x8 z = {0, 0, 0, 0, 0, 0, 0, 0}; if (g < 2) z = ld8(U + (size_t)(m0 + 16 * blk + t) * DSSM + 16 * grp + 8 * g); ub[blk] = z; }
    f32x4 yacc[NBLK];
#pragma unroll
    for (int blk = 0; blk < NBLK; ++blk) yacc[blk] = (f32x4){0.f, 0.f, 0.f, 0.f};
#pragma unroll 1
    for (int pr = 0; pr < 4; ++pr) {
        const bf16x8 are = ld8(ABAR + ((size_t)(grp * 8 + 2 * pr) * 64 + lane) * 8), aim = ld8(ABAR + ((size_t)(grp * 8 + 2 * pr + 1) * 64 + lane) * 8);
        bf16x8 cm = {0, 0, 0, 0, 0, 0, 0, 0}; if (PASS2) cm = ld8(CMt + ((size_t)(grp * 4 + pr) * 64 + lane) * 8);
        const int p0 = 16 * pr + 4 * g;
        float pwr[4][4], pwi[4][4], cpr[4], cpi[4];
#pragma unroll
        for (int i = 0; i < 4; ++i) { const f32x4 a = *(const f32x4*)(PW + (size_t)(grp * 64 + p0 + i) * 8), b = *(const f32x4*)(PW + (size_t)(grp * 64 + p0 + i) * 8 + 4);
            pwr[i][0] = a.x; pwi[i][0] = a.y; pwr[i][1] = a.z; pwi[i][1] = a.w; pwr[i][2] = b.x; pwi[i][2] = b.y; pwr[i][3] = b.z; pwi[i][3] = b.w;
            const f32x2 c = *(const f32x2*)(CP + (size_t)(grp * 64 + p0 + i) * 32 + 2 * tt); cpr[i] = c.x; cpi[i] = c.y; }
        float cre[4], cim[4];
#pragma unroll
        for (int i = 0; i < 4; ++i) { cre[i] = 0.f; cim[i] = 0.f; }
        if (!SAMPLE && PASS2) {
#pragma unroll
            for (int i = 0; i < 4; ++i) { const f32x2 c = *(const LAS f32x2*)(carr + (size_t)(chunk * 64 + p0 + i) * 2); cre[i] = c.x; cim[i] = c.y; }
        }
#pragma unroll
        for (int blk = 0; blk < NBLK; ++blk) {
            int bsm = 0;
            if (SAMPLE) { bsm = ((m0 - MP + 16 * blk) >> 3) + (t >> 3);
                const f32x4 hr = *(const f32x4*)(A.in[I_SRE] + (size_t)(bsm * NG + grp) * NP + p0), hi = *(const f32x4*)(A.in[I_SIM] + (size_t)(bsm * NG + grp) * NP + p0);
#pragma unroll
                for (int i = 0; i < 4; ++i) { cre[i] = hr[i]; cim[i] = hi[i]; } }
            const f32x4 z4 = {0.f, 0.f, 0.f, 0.f};
            f32x4 hre = MFMA16(are, ub[blk], z4), him = MFMA16(aim, ub[blk], z4);
#define SSM_STEP(K_, SH_) { const bool keep = !SAMPLE || (tt >= SH_); \
                _Pragma("unroll") for (int i = 0; i < 4; ++i) { float sr = dpp_shr_t<SH_>(hre[i]), si = dpp_shr_t<SH_>(him[i]); if (!keep) { sr = 0.f; si = 0.f; } \
                    const float nr = hre[i] + pwr[i][K_] * sr - pwi[i][K_] * si, ni = him[i] + pwr[i][K_] * si + pwi[i][K_] * sr; hre[i] = nr; him[i] = ni; } }
            SSM_STEP(0, 1) SSM_STEP(1, 2) SSM_STEP(2, 4)
            if (!SAMPLE) SSM_STEP(3, 8)
#undef SSM_STEP
#pragma unroll
            for (int i = 0; i < 4; ++i) { const float nr = hre[i] + cpr[i] * cre[i] - cpi[i] * cim[i], ni = him[i] + cpr[i] * cim[i] + cpi[i] * cre[i]; hre[i] = nr; him[i] = ni; }
            if (!SAMPLE) {
#pragma unroll
                for (int i = 0; i < 4; ++i) { cre[i] = __shfl(hre[i], (lane & 48) | 15); cim[i] = __shfl(him[i], (lane & 48) | 15); }
            } else if (tt == 7) {
                *(f32x4*)(A.out + O_HRS + (size_t)(bsm * NG + grp) * NP + p0) = hre; *(f32x4*)(A.out + O_HIS + (size_t)(bsm * NG + grp) * NP + p0) = him;
            }
            if (PASS2) { v4u hw; hw.x = pk2(hre[0], hre[1]); hw.y = pk2(hre[2], hre[3]); hw.z = pk2(him[0], him[1]); hw.w = pk2(him[2], him[3]);
                yacc[blk] = MFMA16(cm, __builtin_bit_cast(bf16x8, hw), yacc[blk]); }
        }
        if (!PASS2 && !SAMPLE && t == 15) {
            float* CS = (float*)(ws + WS_CS) + ((size_t)(chunk * NG + grp) * NP + p0) * 2;
            *(f32x4*)CS = (f32x4){cre[0], cim[0], cre[1], cim[1]}; *(f32x4*)(CS + 4) = (f32x4){cre[2], cim[2], cre[3], cim[3]};
        }
    }
    if (PASS2) {
        const f32x4 dv = *(const f32x4*)(A.in[I_SD] + 16 * grp + 4 * g);
#pragma unroll
        for (int blk = 0; blk < NBLK; ++blk) { const size_t off = (size_t)(m0 + 16 * blk + t) * DSSM + 16 * grp + 4 * g;
            const v2u uw = *(const v2u*)(U + off);
            const float u0 = __builtin_bit_cast(float, uw.x << 16), u1 = __builtin_bit_cast(float, uw.x & 0xffff0000u), u2 = __builtin_bit_cast(float, uw.y << 16), u3 = __builtin_bit_cast(float, uw.y & 0xffff0000u);
            const float y0 = gelu_tanh(yacc[blk][0] + dv[0] * u0), y1 = gelu_tanh(yacc[blk][1] + dv[1] * u1), y2 = gelu_tanh(yacc[blk][2] + dv[2] * u2), y3 = gelu_tanh(yacc[blk][3] + dv[3] * u3);
            v2u w; w.x = pk2(y0, y1); w.y = pk2(y2, y3); *(v2u*)(GB + pg8::blk_off(m0 + 16 * blk + t, 16 * grp + 4 * g, DSSM)) = w; }
    }
}

constexpr int N_PHASES = 15;
__global__ void __launch_bounds__(NWAVES * 64, 2) hymba_fwd(Args args) {
    extern __shared__ __attribute__((aligned(16))) unsigned char lds[];
    Frame F;
    F.lds = (LAS unsigned char*)lds;
    F.MISC = (volatile LAS unsigned*)(F.lds + MISC_OFF);
    F.tid = threadIdx.x; F.lane = F.tid & 63; F.wave = __builtin_amdgcn_readfirstlane(F.tid >> 6);
    F.G = gridDim.x; { const int bx = blockIdx.x; F.vcu = (F.G % 8 == 0) ? (bx % 8) * (F.G / 8) + bx / 8 : bx; }
    unsigned char* ws = args.ws;
    F.ctl = (gu32*)(ws + WS_CTL);
    for (int u = F.tid; u < (LDS_BYTES - LDSCTL_OFF) / 4; u += NWAVES * 64) ((LAS unsigned*)(F.lds + LDSCTL_OFF))[u] = 0u;
    __syncthreads();
    XcdBarrier bar = xcd_barrier_post((unsigned*)(F.ctl + CW_BAR), F.MISC + 8);
    const int lo = args.ph_lo, hi = args.ph_hi;
#ifndef PHASE_MASK
#define PHASE_MASK 0x7fff
#endif
#define IN(k) (((PHASE_MASK >> (k)) & 1) && lo <= (k) && (k) < hi)
#define SEAM(k) do { if (IN(k) && IN((k) + 1)) xcd_barrier(bar); } while (0)
#ifndef REPEAT_MASK
#define REPEAT_MASK 0
#endif
#define REP(k) for (int rep_ = 0; rep_ <= ((REPEAT_MASK >> (k)) & 1); ++rep_, ((rep_ <= ((REPEAT_MASK >> (k)) & 1)) ? xcd_barrier(bar) : (void)0))
    bf16* XN = (bf16*)(ws + WS_XN); bf16* HB = (bf16*)(ws + WS_H); float* X1 = (float*)(ws + WS_X1); float* X2 = (float*)(ws + WS_X2);
    float* ADA = (float*)(ws + WS_ADA); float* SLAB = (float*)(ws + WS_SLAB);
    const int gw = F.vcu * NWAVES + F.wave, NGW = F.G * NWAVES;
    const bool fastcopy = (F.G == 256);
    pg8::CopyJob CJ; { const int seg = (int)blockIdx.x & 255, kv = seg >> 7, b = seg & 127; const size_t eo = ((size_t)b * (WBUF * DATT)) * 4 + (size_t)F.wave * 1024;
        CJ.src = (const char*)args.in[kv ? I_CV : I_CK] + (size_t)DSEQ * DATT * 4 + eo; CJ.dst = (char*)(args.out + (kv ? O_VS : O_KS)) + eo; CJ.cur = 0; CJ.end = (fastcopy && !args.nocopy) ? 510 : 0; CJ.dummy = (unsigned*)(F.ctl + 2048 + 64 * F.wave); }

    if (IN(0)) REP(0) if ((F.lane = (int)__builtin_amdgcn_mbcnt_hi(~0u, __builtin_amdgcn_mbcnt_lo(~0u, 0u)), F.tid = F.wave * 64 + F.lane, true)) { p0_prologue(F, args); }
    SEAM(0);
    if (IN(1)) REP(1) if ((F.lane = (int)__builtin_amdgcn_mbcnt_hi(~0u, __builtin_amdgcn_mbcnt_lo(~0u, 0u)), F.tid = F.wave * 64 + F.lane, true)) {
        pg8::Gemm g{(const bf16*)(ws + WS_SC), (const bf16*)(ws + WS_WADA), 256, NADA, DM}; pg8::Order2 S; S.init(256, NADA, DM, F.G, (int)blockIdx.x);
        pg8::EpiF32 E{ADA, NADA, args.in[I_BADA]};
        pg8::gemm_phase2<pg8::EpiF32, pg8::Order2, true, false>(F.lds + RING_OFF, g, S, E, CJ, F.wave);
        const int nun = NADA / 256;
        const int nworker = (F.G > nun) ? (F.G - nun) : F.G, widx = (F.G > nun) ? ((int)blockIdx.x - nun) : (int)blockIdx.x;
        if (widx >= 0) p1_weights(F, args, widx * NWAVES + F.wave, nworker * NWAVES);
        if (!fastcopy && widx >= 0) copy_tiles(args, widx * NWAVES + F.wave, nworker * NWAVES, F.lane);
    }
    SEAM(1);
    if (IN(2)) REP(2) if ((F.lane = (int)__builtin_amdgcn_mbcnt_hi(~0u, __builtin_amdgcn_mbcnt_lo(~0u, 0u)), F.tid = F.wave * 64 + F.lane, true)) norm_mod_rows<true, 0, 8, false>(F, args.in[I_XP], args.in[I_XS], args.in[I_GF1], ADA, 0 * DM, 1 * DM, XN, Combine{nullptr, 0, nullptr, 0, 0.f, nullptr}, ws + WS_XN8, (float*)(ws + WS_SA));
    SEAM(2);
    if (IN(3)) REP(3) if ((F.lane = (int)__builtin_amdgcn_mbcnt_hi(~0u, __builtin_amdgcn_mbcnt_lo(~0u, 0u)), F.tid = F.wave * 64 + F.lane, true)) {
        pg8::Gemm g{(const bf16*)(ws + WS_XN8), (const bf16*)(ws + WS_W1T8), MTOT, 2 * DFF, DM / 2}; pg8::Order2 S; S.init(MTOT, 2 * DFF, DM / 2, F.G, (int)blockIdx.x);
        pg8::EpiGated8 E{HB, DFF, (const float*)(ws + WS_SA), (const unsigned*)(ws + WS_CTL) + CW_AMAX};
        pg8::gemm_phase2<pg8::EpiGated8, pg8::Order2, true, true, true>(F.lds + RING_OFF, g, S, E, CJ, F.wave);
        { const int mine_ = (S.so.nwg - S.so.c + S.so.G - 1) / S.so.G, mx_ = (S.so.nwg + S.so.G - 1) / S.so.G;
          if (mine_ < mx_) copy_back(CJ, (mx_ - mine_) * 2 * S.nt, F.lane); }
    }
    SEAM(3);
    if (IN(4)) REP(4) if ((F.lane = (int)__builtin_amdgcn_mbcnt_hi(~0u, __builtin_amdgcn_mbcnt_lo(~0u, 0u)), F.tid = F.wave * 64 + F.lane, true)) {
        pg8::Gemm g{HB, (const bf16*)(ws + WS_W1D), MTOT, DM, DFF}; pg8::SplitOrder S; S.init(MP, DM, DFF, 11, F.G, (int)blockIdx.x);
        pg8::EpiResid<false, true> E{args.in[I_XP], args.in[I_XS], X1, ADA, 2 * DM, 0.5f, SLAB};
        pg8::gemm_phase2<pg8::EpiResid<false, true>, pg8::SplitOrder, true, true>(F.lds + RING_OFF, g, S, E, CJ, F.wave);
        if (S.so.G == S.npre && S.npre + S.so.c >= S.ntot) copy_back(CJ, 2 * (S.nt / S.nsplit), F.lane);
    }
    SEAM(4);
    if (IN(5)) REP(5) if ((F.lane = (int)__builtin_amdgcn_mbcnt_hi(~0u, __builtin_amdgcn_mbcnt_lo(~0u, 0u)), F.tid = F.wave * 64 + F.lane, true)) norm_mod_rows<false, 11, 4, true>(F, X1, X1 + (size_t)MP * DM, args.in[I_GMIX], ADA, 3 * DM, 4 * DM, XN, Combine{SLAB, 11, args.in[I_XS], 2 * DM, 0.5f, X1 + (size_t)MP * DM}, nullptr, nullptr);
    SEAM(5);
    if (IN(6)) REP(6) if ((F.lane = (int)__builtin_amdgcn_mbcnt_hi(~0u, __builtin_amdgcn_mbcnt_lo(~0u, 0u)), F.tid = F.wave * 64 + F.lane, true)) {
        pg8::Gemm g{XN, (const bf16*)(ws + WS_WIN), MTOT, 2048, DM}; pg8::Order2 S; S.init(MTOT, 2048, DM, F.G, (int)blockIdx.x);
        pg8::EpiInProj E{(bf16*)(ws + WS_Q), (bf16*)(ws + WS_K), (bf16*)(ws + WS_VT), (bf16*)(ws + WS_U), (float*)(ws + WS_SQKV), args.out, (const _Float16*)(ws + WS_ROPE), args.in[I_GQ], args.in[I_GK]};
        pg8::gemm_phase2<pg8::EpiInProj, pg8::Order2, true, false>(F.lds + RING_OFF, g, S, E, CJ, F.wave);
    }
    SEAM(6);
    if (IN(7)) REP(7) if ((F.lane = (int)__builtin_amdgcn_mbcnt_hi(~0u, __builtin_amdgcn_mbcnt_lo(~0u, 0u)), F.tid = F.wave * 64 + F.lane, true)) {
#ifndef P7R1
#define P7R1 0
#endif
#ifndef P7R2
#define P7R2 0
#endif
#ifndef P7R3
#define P7R3 0
#endif
#ifndef P7_PARTS
#define P7_PARTS 7
#endif
        const int p7m = args.pad ? args.pad : P7_PARTS;
        { const int hw = F.vcu * 4 + (F.wave & 3), NHW = F.G * 4;
          if (F.wave < 4) {
              unsigned epoch = 0u; LAS unsigned* cnt = (LAS unsigned*)(F.MISC + 16);
              if (p7m & 1) attn_units4(ws, F.lds + RING_OFF, cnt, epoch, F.vcu, F.G, 3072 * (1 + P7R1), F.tid, F.wave, F.lane);
              if (p7m & 2) for (int u = hw; u < NCHUNK_P * NG * (1 + P7R2); u += NHW) ssm_pass1_unit(ws, u & 31, (u >> 5) & 127, F.lane);
          } else { __builtin_amdgcn_s_setprio(3);
              if (p7m & 4) for (int a = hw; a < NBAT * NH * DSEQ * (1 + P7R3); a += NHW) attn_sample_item(args, ws, a & 8191, F.lane);
              __builtin_amdgcn_s_setprio(0); } }
    }
    SEAM(7);
    if (IN(8)) REP(8) if ((F.lane = (int)__builtin_amdgcn_mbcnt_hi(~0u, __builtin_amdgcn_mbcnt_lo(~0u, 0u)), F.tid = F.wave * 64 + F.lane, true)) {
        for (int t = gw; t < SEQ; t += NGW) attn_combine(ws, t, F.lane);
        LAS float* carr = (LAS float*)(F.lds + RING_OFF);
        LAS float* segE = carr + NCHUNK_P * 64 * 2;
        for (int item = F.vcu; item < 256; item += F.G) {
            const int grp = item & 31, sub = item >> 5;
            {
                const float* CS = (const float*)(ws + WS_CS); const float* CL = (const float*)(ws + WS_SSMT + ST_CL);
                const f32x2 lam = *(const f32x2*)(CL + (size_t)(grp * 64 + F.lane) * 2);
                f32x2 sv[16];
#pragma unroll
                for (int j = 0; j < 16; ++j) sv[j] = *(const f32x2*)(CS + ((size_t)((16 * F.wave + j) * NG + grp) * NP + F.lane) * 2);
                float lr[16], li[16]; float cr = 0.f, ci = 0.f;
#pragma unroll
                for (int j = 0; j < 16; ++j) { lr[j] = cr; li[j] = ci; const float nr = lam.x * cr - lam.y * ci + sv[j].x, ni = lam.x * ci + lam.y * cr + sv[j].y; cr = nr; ci = ni; }
                *(LAS f32x2*)(segE + (size_t)(F.wave * 64 + F.lane) * 2) = (f32x2){cr, ci};
                float sr = lam.x, si = lam.y;
#pragma unroll
                for (int q = 0; q < 4; ++q) { const float nr = sr * sr - si * si, ni = 2.f * sr * si; sr = nr; si = ni; }
                LDS_WAIT(); __syncthreads();
                float Cr = 0.f, Ci = 0.f;
                float Tr = 0.f, Ti = 0.f;
#pragma unroll
                for (int w = 0; w < 8; ++w) { const f32x2 e = *(const LAS f32x2*)(segE + (size_t)(w * 64 + F.lane) * 2);
                    if (w == F.wave) { Cr = Tr; Ci = Ti; }
                    const float nr = sr * Tr - si * Ti + e.x, ni = sr * Ti + si * Tr + e.y; Tr = nr; Ti = ni; }
                float pr_ = 1.f, pi_ = 0.f;
#pragma unroll
                for (int j = 0; j < 16; ++j) { const float ar_ = lr[j] + pr_ * Cr - pi_ * Ci, ai_ = li[j] + pr_ * Ci + pi_ * Cr;
                    *(LAS f32x2*)(carr + (size_t)((16 * F.wave + j) * 64 + F.lane) * 2) = (f32x2){ar_, ai_};
                    const float nr = pr_ * lam.x - pi_ * lam.y, ni = pr_ * lam.y + pi_ * lam.x; pr_ = nr; pi_ = ni; }
                if (sub == 0 && F.wave == 0) { args.out[O_HRP + grp * 64 + F.lane] = Tr; args.out[O_HIP + grp * 64 + F.lane] = Ti; }
                LDS_WAIT(); __syncthreads();
            }
            for (int k = F.wave; k < 16; k += NWAVES) { ssm_unit<true, false, 8>(args, ws, grp, sub + 8 * k, carr, F.lane); copy_back(CJ, 32, F.lane); }
            ssm_unit<true, true, 1>(args, ws, grp, sub + 8 * F.wave, nullptr, F.lane);
            copy_back(CJ, 24, F.lane);
            __syncthreads();
        }
    }
    SEAM(8);
    if (IN(9)) REP(9) if ((F.lane = (int)__builtin_amdgcn_mbcnt_hi(~0u, __builtin_amdgcn_mbcnt_lo(~0u, 0u)), F.tid = F.wave * 64 + F.lane, true)) {
        pg8::Gemm g{(const bf16*)(ws + WS_GB), (const bf16*)(ws + WS_WGLU), MTOT, 1024, DSSM}; pg8::Order2 S; S.init(MTOT, 1024, DSSM, F.G, (int)blockIdx.x);
        pg8::EpiGated<1> E{(bf16*)(ws + WS_MIX), DM, DATT};
        pg8::gemm_phase2<pg8::EpiGated<1>, pg8::Order2, true, false>(F.lds + RING_OFF, g, S, E, CJ, F.wave);
    }
    SEAM(9);
    if (IN(10)) REP(10) if ((F.lane = (int)__builtin_amdgcn_mbcnt_hi(~0u, __builtin_amdgcn_mbcnt_lo(~0u, 0u)), F.tid = F.wave * 64 + F.lane, true)) {
        pg8::Gemm g{(const bf16*)(ws + WS_MIX), (const bf16*)(ws + WS_WOUT), MTOT, DM, DM}; pg8::SplitOrder S; S.init(MP, DM, DM, 4, F.G, (int)blockIdx.x);
        pg8::EpiResid<true, true> E{X1, X1 + (size_t)MP * DM, X2, ADA, 5 * DM, 1.0f, SLAB};
        pg8::gemm_phase2<pg8::EpiResid<true, true>, pg8::SplitOrder, true, true>(F.lds + RING_OFF, g, S, E, CJ, F.wave);
        if (S.so.G == S.npre && S.npre + S.so.c >= S.ntot) copy_back(CJ, 2 * (S.nt / S.nsplit), F.lane);
    }
    SEAM(10);
    if (IN(11)) REP(11) if ((F.lane = (int)__builtin_amdgcn_mbcnt_hi(~0u, __builtin_amdgcn_mbcnt_lo(~0u, 0u)), F.tid = F.wave * 64 + F.lane, true)) norm_mod_rows<true, 4, 5, true>(F, X2, X2 + (size_t)MP * DM, args.in[I_GF2], ADA, 6 * DM, 7 * DM, XN, Combine{SLAB, 4, X1 + (size_t)MP * DM, 5 * DM, 1.0f, X2 + (size_t)MP * DM}, ws + WS_XN8, (float*)(ws + WS_SA));
    SEAM(11);
    if (IN(12)) REP(12) if ((F.lane = (int)__builtin_amdgcn_mbcnt_hi(~0u, __builtin_amdgcn_mbcnt_lo(~0u, 0u)), F.tid = F.wave * 64 + F.lane, true)) {
        pg8::Gemm g{(const bf16*)(ws + WS_XN8), (const bf16*)(ws + WS_W2T8), MTOT, 2 * DFF, DM / 2}; pg8::Order2 S; S.init(MTOT, 2 * DFF, DM / 2, F.G, (int)blockIdx.x);
        pg8::EpiGated8 E{HB, DFF, (const float*)(ws + WS_SA), (const unsigned*)(ws + WS_CTL) + CW_AMAX + 2};
        pg8::gemm_phase2<pg8::EpiGated8, pg8::Order2, true, true, true>(F.lds + RING_OFF, g, S, E, CJ, F.wave);
        { const int mine_ = (S.so.nwg - S.so.c + S.so.G - 1) / S.so.G, mx_ = (S.so.nwg + S.so.G - 1) / S.so.G;
          if (mine_ < mx_) copy_back(CJ, (mx_ - mine_) * 2 * S.nt, F.lane); }
    }
    SEAM(12);
    if (IN(13)) REP(13) if ((F.lane = (int)__builtin_amdgcn_mbcnt_hi(~0u, __builtin_amdgcn_mbcnt_lo(~0u, 0u)), F.tid = F.wave * 64 + F.lane, true)) {
        pg8::Gemm g{HB, (const bf16*)(ws + WS_W2D), MTOT, DM, DFF}; pg8::SplitOrder S; S.init(MP, DM, DFF, 11, F.G, (int)blockIdx.x);
        pg8::EpiResid<true, false> E{X2, X2 + (size_t)MP * DM, args.out, ADA, 8 * DM, 0.5f, SLAB};
        pg8::gemm_phase2<pg8::EpiResid<true, false>, pg8::SplitOrder, true, true>(F.lds + RING_OFF, g, S, E, CJ, F.wave);
        copy_back(CJ, 1 << 20, F.lane);
    }
    SEAM(13);
    if (IN(14)) { F.lane = (int)__builtin_amdgcn_mbcnt_hi(~0u, __builtin_amdgcn_mbcnt_lo(~0u, 0u)); F.tid = F.wave * 64 + F.lane;
        const Combine C{SLAB, 11, X2 + (size_t)MP * DM, 8 * DM, 0.5f, args.out + O_YS};
        for (int u = gw; u < 2 * MS; u += NGW) { const int ms = u >> 1, j0 = (u & 1) * 2; const float* ar = ADA + (size_t)ada_row(MP + ms) * NADA;
            (void)combine_chunk<11>(C, ar, ms, F.lane, j0); (void)combine_chunk<11>(C, ar, ms, F.lane, j0 + 1); }
    }
#undef IN
#undef SEAM
}

#ifndef MK_N_LAUNCHES
#define MK_N_LAUNCHES 1
#endif
extern "C" void kernel_launch(void* const* d_in, const int* in_sizes, int n_in, void* d_out, int out_size, void* d_ws, size_t ws_size, hipStream_t stream) {
    static int grid = 0;
    if (grid == 0) {
        if (n_in != 32 || (size_t)out_size != O_END || ws_size < WS_END) { fprintf(stderr, "kernel_launch: unexpected shapes (n_in %d out %d ws %zu)\n", n_in, out_size, ws_size); grid = -1; return; }
        int dev = 0, cus = 0, per_cu = 0;
        if (hipGetDevice(&dev) != hipSuccess || hipDeviceGetAttribute(&cus, hipDeviceAttributeMultiprocessorCount, dev) != hipSuccess) { grid = -1; return; }
        if (hipFuncSetAttribute((const void*)hymba_fwd, hipFuncAttributeMaxDynamicSharedMemorySize, LDS_BYTES) != hipSuccess) { fprintf(stderr, "kernel_launch: hipFuncSetAttribute failed\n"); grid = -1; return; }
        if (hipOccupancyMaxActiveBlocksPerMultiprocessor(&per_cu, (const void*)hymba_fwd, NWAVES * 64, LDS_BYTES) != hipSuccess || per_cu < 1)
            fprintf(stderr, "kernel_launch: note: occupancy query reports %d workgroups per CU\n", per_cu);
        (void)hipGetLastError();
        grid = cus;
    }
    if (grid < 0) return;
    if (hipMemsetAsync((char*)d_ws + WS_CTL, 0, CTL_ZERO_BYTES, stream) != hipSuccess) return;
    Args a{};
    for (int i = 0; i < 32; ++i) a.in[i] = (const float*)d_in[i];
    a.out = (float*)d_out; a.ws = (unsigned char*)d_ws;
#if MK_N_LAUNCHES == 1
    a.ph_lo = 0; a.ph_hi = N_PHASES;
    hipLaunchKernelGGL(hymba_fwd, dim3(grid), dim3(NWAVES * 64), LDS_BYTES, stream, a);
#ifdef PROBE_LIST
    { const int pl[] = PROBE_LIST; for (int p : pl) { a.ph_lo = p % 100; a.ph_hi = p % 100 + 1; a.nocopy = (p % 1000) >= 100; a.pad = p / 1000; hipLaunchKernelGGL(hymba_fwd, dim3(grid), dim3(NWAVES * 64), LDS_BYTES, stream, a); } }
#endif
#else
    for (int p = 0; p < N_PHASES; ++p) { a.ph_lo = p; a.ph_hi = p + 1; hipLaunchKernelGGL(hymba_fwd, dim3(grid), dim3(NWAVES * 64), LDS_BYTES, stream, a); }
#endif
}
```

```cpp
#include <hip/hip_runtime.h>
#include <cstdio>
#include <cstdint>
namespace pg8 {
#define PG8_LAS __attribute__((address_space(3)))
typedef unsigned short bf16_t;
typedef short bf16x8 __attribute__((ext_vector_type(8)));
typedef float f32x4 __attribute__((ext_vector_type(4)));
typedef unsigned u32x4 __attribute__((ext_vector_type(4)));
constexpr int BM = 256, BK = 64, HALF = 128, HTB = HALF * BK * 2  , STAGE_BYTES = 8 * HTB, NXCD = 8, WGM = 8;

__host__ __device__ __forceinline__ int lds_byte(int r, int c) { const int st = (r >> 4) * 2 + (c >> 5), rr = r & 15, cc = c & 31, ob = rr * 64 + cc * 2; return st * 1024 + (ob ^ (((ob >> 9) & 1) << 5)); }
__host__ __device__ __forceinline__ void stage_rc(int b, int& R, int& C) { const int st = b / 1024, sb = b % 1024, swz = sb ^ (((sb >> 9) & 1) << 5); R = (st >> 1) * 16 + swz / 64; C = (st & 1) * 32 + (swz % 64) / 2; }
__host__ __device__ __forceinline__ int perm32(int rho) { const int n = rho >> 4, i = rho & 15; return 8 * (i >> 2) + 4 * n + (i & 3); }

__host__ __device__ __forceinline__ size_t blk_off(int row, int col, int K) { return ((size_t)(row >> 8) * (size_t)(K >> 6) + (size_t)(col >> 6)) * 16384 + (size_t)((row & 255) * 64 + (col & 63)); }
__host__ __device__ __forceinline__ size_t blk_byte(int row, int bcol, int Kbytes) { return ((size_t)(row >> 8) * (size_t)(Kbytes >> 7) + (size_t)(bcol >> 7)) * 32768 + (size_t)((row & 255) * 128 + (bcol & 127)); }
struct Unit { int pm, pn; };
struct Gemm { const bf16_t* A; const bf16_t* Bt; int M, N, K; };

struct StaticOrder {
    int nM, nN, nwg, G, c;
    __host__ __device__ void init(int M, int N, int G_, int c_) { nM = M / BM; nN = N / BM; nwg = nM * nN; G = G_; c = c_; }
    __host__ __device__ bool next(int i, Unit& u) const {
        const long L = (long)i * G + c; if (L >= nwg) return false;
        int wgid = (int)L; { const int q = nwg / NXCD, r = nwg % NXCD, xcd = wgid % NXCD, off = wgid / NXCD; wgid = (xcd < r ? xcd * (q + 1) : r * (q + 1) + (xcd - r) * q) + off; }
        const int nig = WGM * nN, gid = wgid / nig, fm = gid * WGM, gsz = (nM - fm) < WGM ? (nM - fm) : WGM;
        u.pm = fm + ((wgid % nig) % gsz); u.pn = (wgid % nig) / gsz; return true;
    }
    __device__ __forceinline__ void a_ready(const Unit&) const {}
    __device__ __forceinline__ void done(const Unit&) const {}
};

__device__ __forceinline__ unsigned cvt_pk_bf16(float lo, float hi) { unsigned r; asm volatile("v_cvt_pk_bf16_f32 %0, %1, %2" : "=v"(r) : "v"(lo), "v"(hi)); return r; }
typedef float f32x2 __attribute__((ext_vector_type(2)));
typedef unsigned u32x2v __attribute__((ext_vector_type(2)));
constexpr int CP_STAGE_OFF = STAGE_BYTES;
constexpr int CP_STRIDE = 8192;
struct CopyJob { const char* src; char* dst; int cur, end; unsigned* dummy; };
struct Unit2 { int pm, pn, k0, nt, split; };
typedef int i32x4 __attribute__((ext_vector_type(4)));
template <bool I8> struct AccSel { typedef f32x4 type; };
template <> struct AccSel<true> { typedef i32x4 type; };
template <class Epi, class Sched, bool ALIGN_EPI, bool COPY, bool I8 = false>
__device__ __forceinline__ void gemm_phase2(PG8_LAS unsigned char* lds, const Gemm g, const Sched& S, const Epi& E, CopyJob& C, const int wid  ) {
    const int lane = (int)__builtin_amdgcn_mbcnt_hi(~0u, __builtin_amdgcn_mbcnt_lo(~0u, 0u)), tid = wid * 64 + lane,
              wr = wid >> 2, wc = wid & 3, fr = lane & 15, fq = lane >> 4;
    const int K = g.K;
    unsigned voffA[2], voffB[2];
#pragma unroll
    for (int i = 0; i < 2; ++i) { int R, Cc; stage_rc(tid * 16 + i * 8192, R, Cc); const int Rb = Epi::PERM ? ((R & ~31) + perm32(R & 31)) : R;
        voffA[i] = (unsigned)(R * 64 + Cc) * 2u; voffB[i] = (unsigned)(Rb * 64 + Cc) * 2u; }
    const size_t kstep = (size_t)32768;
    const size_t hstep = (size_t)HALF * 64 * 2;
    const size_t tstep = (size_t)(K / BK) * kstep;
    const unsigned ldsw = (unsigned)wid * 1024u;
    const int aoff = lds_byte(wr * 64 + fr, fq * 8), boff = lds_byte(wc * 32 + fr, fq * 8);
#define PG8_SA(b, h) (((b) * 2 + (h)) * HTB)
#define PG8_SB(b, h) ((4 + (b) * 2 + (h)) * HTB)
#define PG8_STAGE(bufoff, gbase, voff) do { _Pragma("unroll") for (int _i = 0; _i < 2; ++_i) \
        __builtin_amdgcn_global_load_lds((const unsigned*)((const char*)(gbase) + (voff)[_i]), (PG8_LAS unsigned*)(lds + (bufoff) + ldsw + _i * 8192), 16, 0, 0); } while (0)
#define PG8_LDA(dst, b, h) do { _Pragma("unroll") for (int m = 0; m < 4; ++m) _Pragma("unroll") for (int k = 0; k < 2; ++k) dst[m][k] = *(const PG8_LAS bf16x8*)(lds + PG8_SA(b, h) + aoff + m * 2048 + k * 1024); } while (0)
#define PG8_LDB(dst, b, h) do { _Pragma("unroll") for (int n = 0; n < 2; ++n) _Pragma("unroll") for (int k = 0; k < 2; ++k) dst[n][k] = *(const PG8_LAS bf16x8*)(lds + PG8_SB(b, h) + boff + n * 2048 + k * 1024); } while (0)
#define PG8_MMA(ai, bj, At, Bt) do { __builtin_amdgcn_s_setprio(1); _Pragma("unroll") for (int m = 0; m < 4; ++m) _Pragma("unroll") for (int n = 0; n < 2; ++n) _Pragma("unroll") for (int k = 0; k < 2; ++k) \
        { if constexpr (I8) acc[ai][bj][m][n] = __builtin_amdgcn_mfma_i32_16x16x64_i8(__builtin_bit_cast(i32x4, Bt[n][k]), __builtin_bit_cast(i32x4, At[m][k]), acc[ai][bj][m][n], 0, 0, 0); \
          else acc[ai][bj][m][n] = __builtin_amdgcn_mfma_f32_16x16x32_bf16(Bt[n][k], At[m][k], acc[ai][bj][m][n], 0, 0, 0); } __builtin_amdgcn_s_setprio(0); } while (0)
#define PG8_WAIT_V(n) asm volatile("s_waitcnt vmcnt(" #n ")" ::: "memory")
#define PG8_WAIT_LOOP() do { if constexpr (COPY) asm volatile("s_waitcnt vmcnt(13)" ::: "memory"); else asm volatile("s_waitcnt vmcnt(8)" ::: "memory"); } while (0)
#define PG8_WAIT_L(n) asm volatile("s_waitcnt lgkmcnt(" #n ")" ::: "memory")
#define PG8_BAR __builtin_amdgcn_s_barrier()
#define PG8_SCHED __builtin_amdgcn_sched_barrier(0)
    typedef unsigned cp4 __attribute__((ext_vector_type(4)));
    const unsigned cp_voff = (unsigned)lane * 16u;
    int cp_n = 0, cp_sl = 0;
    const int cp_base = C.cur, cp_cnt = C.end - C.cur;
    const char* cp_s = C.src + (size_t)cp_base * CP_STRIDE; char* cp_d = C.dst + ((size_t)cp_base - 4) * CP_STRIDE;
    PG8_LAS unsigned char* const cp_stage = lds + CP_STAGE_OFF + wid * 3072;
    cp4 cp_r = {0u, 0u, 0u, 0u};
#define CP_STORE() do { if constexpr (COPY) { \
        if (cp_n >= 4 && cp_n - 4 < cp_cnt) __builtin_nontemporal_store(cp_r, (cp4*)(cp_d + cp_voff)); else C.dummy[lane] = cp_r.x; } } while (0)
#define CP_READ() do { if constexpr (COPY) { const unsigned la_ = (unsigned)(unsigned long)(cp_stage + cp_sl * 1024) + cp_voff; \
        asm volatile("ds_read_b128 %0, %1" : "=v"(cp_r) : "v"(la_) : "memory"); } } while (0)
#define CP_ISSUE() do { if constexpr (COPY) { asm volatile("s_waitcnt lgkmcnt(0)" ::: "memory"); \
        const char* sp_ = (cp_n < cp_cnt) ? cp_s : (const char*)C.src; \
        __builtin_amdgcn_global_load_lds((const unsigned*)(sp_ + cp_voff), (PG8_LAS unsigned*)(cp_stage + cp_sl * 1024), 16, 0, 2); \
        ++cp_n; cp_sl = (cp_sl == 2) ? 0 : cp_sl + 1; cp_s += CP_STRIDE; cp_d += CP_STRIDE; } } while (0)
    Unit2 cur, nxt; int ui = 0;
    if (!S.next(0, cur)) return;
    typedef typename AccSel<I8>::type acc_t; const acc_t acc_zero = {};
    acc_t acc[2][2][4][2];
#pragma unroll
    for (int a = 0; a < 2; ++a)
#pragma unroll
        for (int b = 0; b < 2; ++b)
#pragma unroll
            for (int m = 0; m < 4; ++m)
#pragma unroll
                for (int n = 0; n < 2; ++n) acc[a][b][m][n] = acc_zero;
    bf16x8 At[4][2], B0[2][2], B1[2][2];
    const char* cA = (const char*)g.A + (size_t)cur.pm * tstep + (size_t)cur.k0 * kstep; const char* cB = (const char*)g.Bt + (size_t)cur.pn * tstep + (size_t)cur.k0 * kstep;
    S.a_ready(cur);
    {
        PG8_STAGE(PG8_SB(0, 0), cB, voffB); PG8_STAGE(PG8_SB(0, 1), cB + hstep, voffB); PG8_STAGE(PG8_SA(0, 0), cA, voffA); PG8_STAGE(PG8_SA(0, 1), cA + hstep, voffA);
        if (wr == 1) PG8_BAR;
        PG8_WAIT_V(2); PG8_BAR;
        PG8_STAGE(PG8_SB(1, 0), cB + kstep, voffB); PG8_STAGE(PG8_SA(1, 0), cA + kstep, voffA); PG8_STAGE(PG8_SB(1, 1), cB + hstep + kstep, voffB);
        PG8_WAIT_V(6); PG8_BAR;
    }
    for (;;) {
        const bool has_next = S.next(ui + 1, nxt);
        const char* nA = has_next ? (const char*)g.A + (size_t)nxt.pm * tstep + (size_t)nxt.k0 * kstep : cA; const char* nB = has_next ? (const char*)g.Bt + (size_t)nxt.pn * tstep + (size_t)nxt.k0 * kstep : cB;
        const int nt = cur.nt;
        for (int t = 0; t < nt; t += 2) {
            const bool last = (t == nt - 2);
            const char* a1 = cA + (size_t)(t + 1) * kstep;
            const char* a2 = last ? nA : cA + (size_t)(t + 2) * kstep; const char* b2 = last ? nB : cB + (size_t)(t + 2) * kstep;
            const char* a3 = a2 + kstep; const char* b3 = b2 + kstep;
            if (last && has_next) S.a_ready(nxt);
            PG8_LDB(B0, 0, 0); PG8_LDB(B1, 0, 1); PG8_SCHED; PG8_LDA(At, 0, 0); PG8_STAGE(PG8_SA(1, 1), a1 + hstep, voffA);
            CP_STORE(); PG8_WAIT_LOOP(); PG8_WAIT_L(0); PG8_BAR; PG8_MMA(0, 0, At, B0); CP_READ(); PG8_MMA(0, 1, At, B1); CP_ISSUE(); PG8_BAR; PG8_SCHED;
            PG8_LDA(At, 0, 1); PG8_STAGE(PG8_SB(0, 0), b2, voffB); PG8_STAGE(PG8_SB(0, 1), b2 + hstep, voffB); PG8_STAGE(PG8_SA(0, 0), a2, voffA);
            CP_STORE(); PG8_WAIT_LOOP(); PG8_WAIT_L(0); PG8_BAR; PG8_MMA(1, 0, At, B0); CP_READ(); PG8_MMA(1, 1, At, B1); CP_ISSUE(); PG8_BAR; PG8_SCHED;
            PG8_LDB(B0, 1, 0); PG8_LDB(B1, 1, 1); PG8_SCHED; PG8_LDA(At, 1, 0); PG8_STAGE(PG8_SA(0, 1), a2 + hstep, voffA);
            CP_STORE(); PG8_WAIT_LOOP(); PG8_WAIT_L(0); PG8_BAR; PG8_MMA(0, 0, At, B0); CP_READ(); PG8_MMA(0, 1, At, B1); CP_ISSUE(); PG8_BAR; PG8_SCHED;
            PG8_LDA(At, 1, 1); PG8_STAGE(PG8_SB(1, 0), b3, voffB); PG8_STAGE(PG8_SB(1, 1), b3 + hstep, voffB); PG8_STAGE(PG8_SA(1, 0), a3, voffA);
            CP_STORE(); PG8_WAIT_LOOP(); PG8_WAIT_L(0); PG8_BAR; PG8_MMA(1, 0, At, B0); CP_READ(); PG8_MMA(1, 1, At, B1); CP_ISSUE(); PG8_BAR; PG8_SCHED;
        }
        if constexpr (ALIGN_EPI) { if (wr == 0) PG8_BAR; }
        { int l2_; asm volatile("v_mbcnt_lo_u32_b32 %0, -1, 0\n\tv_mbcnt_hi_u32_b32 %0, -1, %0" : "=v"(l2_)); E(acc, cur, wr, wc, l2_ & 15, l2_ >> 4); } S.done(cur);
        if (!has_next) break;
#pragma unroll
        for (int a = 0; a < 2; ++a)
#pragma unroll
            for (int b = 0; b < 2; ++b)
#pragma unroll
                for (int m = 0; m < 4; ++m)
#pragma unroll
                    for (int n = 0; n < 2; ++n) acc[a][b][m][n] = acc_zero;
        cur = nxt; cA = nA; cB = nB; ++ui;
        if constexpr (ALIGN_EPI) { if (wr == 1) PG8_BAR; }
    }
    PG8_WAIT_V(0);
    if constexpr (!ALIGN_EPI) { if (wr == 0) PG8_BAR; }
    PG8_BAR;
    if constexpr (COPY) {
        if (cp_n >= 4 && cp_n - 4 < cp_cnt) __builtin_nontemporal_store(cp_r, (cp4*)(C.dst + ((size_t)cp_base + cp_n - 4) * CP_STRIDE + cp_voff));
#pragma unroll
        for (int j = 3; j >= 1; --j) { const int k = cp_n - j;
            if (k >= 0 && k < cp_cnt) { const int sl = k % 3; const cp4 v = *(const PG8_LAS cp4*)(cp_stage + sl * 1024 + cp_voff);
                __builtin_nontemporal_store(v, (cp4*)(C.dst + ((size_t)cp_base + k) * CP_STRIDE + cp_voff)); } }
        C.cur = cp_base + (cp_n < cp_cnt ? cp_n : cp_cnt);
    }
#undef CP_ISSUE
#undef CP_READ
#undef CP_STORE
#undef PG8_SA
#undef PG8_SB
#undef PG8_STAGE
#undef PG8_LDA
#undef PG8_LDB
#undef PG8_MMA
#undef PG8_WAIT_V
#undef PG8_WAIT_LOOP
#undef PG8_WAIT_L
#undef PG8_BAR
#undef PG8_SCHED
}
struct Order2 {
    StaticOrder so; int nt;
    __device__ __forceinline__ void init(int M, int N, int K, int G, int c) { so.init(M, N, G, c); nt = K / BK; }
    __device__ __forceinline__ bool next(int i, Unit2& u) const { Unit v; if (!so.next(i, v)) return false; u.pm = v.pm; u.pn = v.pn; u.k0 = 0; u.nt = nt; u.split = 0; return true; }
    __device__ __forceinline__ void a_ready(const Unit2&) const {}
    __device__ __forceinline__ void done(const Unit2&) const {}
};
struct SplitOrder {
    StaticOrder so; int nt, nsplit, nN, npre, ntot;
    __device__ __forceinline__ void init(int Mp, int N, int K, int nsplit_, int G, int c) { so.init(Mp, N, G, c); nt = K / BK; nsplit = nsplit_; nN = N / BM; npre = so.nwg; ntot = npre + 4 * nN * nsplit; }
    __device__ __forceinline__ bool next(int i, Unit2& u) const {
        const long L = (long)i * so.G + so.c; if (L >= ntot) return false;
        Unit v; v.pm = 0; v.pn = 0; const bool pre = so.next(i, v);
        const int s = (int)L - npre, ks = s % nsplit, tile = s / nsplit, nts = nt / nsplit;
        u.pm = pre ? v.pm : so.nM + tile / nN; u.pn = pre ? v.pn : tile % nN; u.nt = pre ? nt : nts; u.k0 = pre ? 0 : ks * nts; u.split = pre ? 0 : 1; return true;
    }
    __device__ __forceinline__ void a_ready(const Unit2&) const {}
    __device__ __forceinline__ void done(const Unit2&) const {}
};
}

constexpr int NWAVES = 8;
constexpr int DM = 1024, SEQ = 16384, NBAT = 128, DSEQ = 8, MP = SEQ, MS = NBAT * DSEQ, MTOT = MP + MS;
constexpr int DFF = 2816, NH = 8, HD = 64, DATT = 512, DSSM = 512, NG = 32, NP = 64, NC = 16, WBUF = 2048, PAST = 8192;
constexpr int NADA = 9 * DM;
constexpr float EPS = 1e-6f;
constexpr float QSCALE = 0.125f * 1.44269504088896340736f;
constexpr int CHUNK = 128, NCHUNK_P = SEQ / CHUNK  , NCHUNK_S = MS / CHUNK  ;

constexpr size_t MiB = 1u << 20;
constexpr size_t WS_CTL = 0, CTL_ZERO_BYTES = 1 * MiB;
constexpr size_t WS_ADA = 1 * MiB;
constexpr size_t WS_SC = 10 * MiB;
constexpr size_t WS_ROPE = 11 * MiB;
constexpr size_t WS_SSMT = 13 * MiB;
constexpr size_t WS_WADA = 14 * MiB;
constexpr size_t WS_W1T = 32 * MiB;
constexpr size_t WS_W1D = 43 * MiB;
constexpr size_t WS_W2T = 49 * MiB;
constexpr size_t WS_W2D = 60 * MiB;
constexpr size_t WS_WIN = 66 * MiB;
constexpr size_t WS_WGLU = 70 * MiB;
constexpr size_t WS_WOUT = 71 * MiB;
constexpr size_t WS_XN = 74 * MiB;
constexpr size_t WS_H = 108 * MiB;
constexpr size_t WS_X1 = 202 * MiB;
constexpr size_t WS_X2 = 270 * MiB;
constexpr size_t WS_Q = 338 * MiB;
constexpr size_t WS_K = 355 * MiB;
constexpr size_t WS_VT = 372 * MiB;
constexpr size_t WS_U = 420 * MiB;
constexpr size_t WS_SQKV = 437 * MiB;
constexpr size_t WS_MIX = 443 * MiB;
constexpr size_t WS_GB = 477 * MiB;
constexpr size_t WS_CS = 494 * MiB;
constexpr size_t WS_SLAB = 496 * MiB;
constexpr size_t WS_OP = 540 * MiB;
constexpr size_t WS_ML = 588 * MiB;
constexpr size_t WS_XN8 = 592 * MiB;
constexpr size_t WS_W1T8 = 610 * MiB;
constexpr size_t WS_W2T8 = 616 * MiB;
constexpr size_t WS_SB = 622 * MiB;
constexpr size_t WS_SA = 623 * MiB;
constexpr size_t WS_END = 624 * MiB;
constexpr size_t ST_ABAR = 0;
constexpr size_t ST_CM = 256 * 1024;
constexpr size_t ST_PW = 384 * 1024;
constexpr size_t ST_CP = 448 * 1024;
constexpr size_t ST_CL = 704 * 1024;
constexpr size_t O_YP = 0, O_YS = 16777216, O_KP = 17825792, O_VP = 18874368, O_HRP = 19922944, O_HIP = 19924992,
                 O_KS = 19927040, O_VS = 154144768, O_HRS = 288362496, O_HIS = 288624640, O_END = 288886784;
constexpr int CW_TMO = 0, CW_BAR = 4096, CW_AMAX = 16384;

constexpr int RING_OFF = 0, RING_BYTES = 131072;
constexpr int CPSTAGE_BYTES = 24576;
constexpr int LDSCTL_OFF = RING_BYTES + CPSTAGE_BYTES, MISC_OFF = LDSCTL_OFF + 320;
constexpr int LDS_BYTES = 157696;

#define GAS __attribute__((address_space(1)))
#define LAS __attribute__((address_space(3)))
typedef unsigned short bf16;
typedef unsigned v4u __attribute__((ext_vector_type(4)));
typedef unsigned v2u __attribute__((ext_vector_type(2)));
typedef float f32x4 __attribute__((ext_vector_type(4)));
typedef float f32x2 __attribute__((ext_vector_type(2)));
typedef short bf16x8 __attribute__((ext_vector_type(8)));
typedef GAS unsigned gu32;
#define RLX_AGENT __ATOMIC_RELAXED, __HIP_MEMORY_SCOPE_AGENT
#define LDS_WAIT() asm volatile("s_waitcnt lgkmcnt(0)" ::: "memory")
#define VM_WAIT() asm volatile("s_waitcnt vmcnt(0)" ::: "memory")
__device__ __forceinline__ unsigned f2bf(float f) { unsigned u = __builtin_bit_cast(unsigned, f); return (u + 0x7fffu + ((u >> 16) & 1u)) >> 16; }
__device__ __forceinline__ unsigned pk2(float lo, float hi) { return pg8::cvt_pk_bf16(lo, hi); }
__device__ __forceinline__ float bf2f(unsigned short b) { return __builtin_bit_cast(float, (unsigned)b << 16); }
__device__ __forceinline__ float fast_sigmoid(float x) { return __builtin_amdgcn_rcpf(1.0f + __builtin_amdgcn_exp2f(-1.44269504088896f * x)); }
__device__ __forceinline__ float gelu_tanh(float x) { const float z = 1.5957691216057308f * (x + 0.044715f * x * x * x); return x * fast_sigmoid(z); }
#define XB_TMO      128
#define XB_XCNT(j)  (256  + 64 * (j))
#define XB_XSUB(j)  (1280 + 64 * (j))
#define XB_XGEN(j)  (2304 + 64 * (j))
#define XB_TOP      3328
#define XB_TOPGEN   3392
#define XCD_BAR_WORDS 3456
#define XB_SPIN_CAP (1u << 18)

__device__ __forceinline__ unsigned xb_ld(unsigned* p)              { return __hip_atomic_load(p, __ATOMIC_RELAXED, __HIP_MEMORY_SCOPE_AGENT); }
__device__ __forceinline__ unsigned xb_add(unsigned* p, unsigned v) { return __hip_atomic_fetch_add(p, v, __ATOMIC_RELAXED, __HIP_MEMORY_SCOPE_AGENT); }
__device__ __forceinline__ unsigned xb_xcc_id() { return (unsigned)__builtin_amdgcn_s_getreg((3 << 11) | 20) & 0xFu; }
#define XB_SPIN(cond, bar) do { unsigned _sp = 0; while (cond) { __builtin_amdgcn_s_sleep(1); \
    if ((++_sp & 255u) == 0u) { if (xb_ld(&(bar)[XB_TMO])) break; if (_sp > XB_SPIN_CAP) { atomicAdd(&(bar)[XB_TMO], 1u); break; } } } } while (0)

struct XcdBarrier {
    unsigned* bar; unsigned x;
    volatile LAS unsigned* st;
};

__device__ __forceinline__ XcdBarrier xcd_barrier_post(unsigned* bar, volatile LAS unsigned* st) {
    XcdBarrier b; b.bar = bar; b.x = xb_xcc_id(); b.st = st;
    if (threadIdx.x == 0) (void)xb_add(&bar[XB_XCNT(b.x)], 1u);
    return b;
}
__device__ __forceinline__ void xcd_barrier_complete(unsigned* bar, unsigned x, unsigned& nloc, unsigned& nx) {
    const unsigned G = gridDim.x * gridDim.y * gridDim.z;
    unsigned sum, cnt, mine, sp = 0u;
    for (;;) {
        sum = 0u; cnt = 0u; mine = 0u;
#pragma unroll
        for (unsigned j = 0; j < 16; ++j) { const unsigned c = xb_ld(&bar[XB_XCNT(j)]); sum += c; cnt += (c > 0u) ? 1u : 0u; mine = (j == x) ? c : mine; }
        if (sum == G) break;
        __builtin_amdgcn_s_sleep(1);
        if ((++sp & 255u) == 0u) { if (xb_ld(&bar[XB_TMO])) break; if (sp > XB_SPIN_CAP) { atomicAdd(&bar[XB_TMO], 1u); break; } }
    }
    nloc = mine > 0u ? mine : 1u; nx = cnt > 0u ? cnt : 1u;
}

__device__ __forceinline__ void xcd_barrier(const XcdBarrier& b) {
    asm volatile("s_waitcnt vmcnt(0)" ::: "memory");
    __syncthreads();
    if (threadIdx.x == 0) {
        unsigned* bar = b.bar;
        __builtin_amdgcn_s_waitcnt(0);
        unsigned nloc = b.st[0], nx = b.st[1];
        if (nloc == 0u) { xcd_barrier_complete(bar, b.x, nloc, nx); b.st[0] = nloc; b.st[1] = nx; }
        const unsigned old = xb_add(&bar[XB_XSUB(b.x)], 1u);
        const unsigned gen = old / nloc;
        if (old + 1u == (gen + 1u) * nloc) {
            __builtin_amdgcn_fence(__ATOMIC_RELEASE, "agent");
            asm volatile("s_waitcnt vmcnt(0)" ::: "memory");
            const unsigned og = xb_add(&bar[XB_TOP], 1u);
            if (og + 1u == (gen + 1u) * nx) xb_add(&bar[XB_TOPGEN], 1u);
        }
        XB_SPIN(xb_ld(&bar[XB_TOPGEN]) == gen, bar);
        __builtin_amdgcn_fence(__ATOMIC_ACQUIRE, "agent");
        asm volatile("s_waitcnt vmcnt(0)" ::: "memory");
    }
    __syncthreads();
}


struct Args { const float* in[32]; float* out; unsigned char* ws; int ph_lo, ph_hi, nocopy, pad; };
enum { I_XP = 0, I_XS, I_CP, I_CS, I_CK, I_CV, I_SRE, I_SIM, I_WADA, I_BADA, I_GF1, I_W1G, I_W1U, I_W1D, I_GMIX, I_WIN, I_GQ, I_GK,
       I_ARE, I_AIM, I_LDT, I_BRE, I_BIM, I_CRE, I_CIM, I_SD, I_WGLU, I_WOUT, I_GF2, I_W2G, I_W2U, I_W2D };
struct Frame {
    LAS unsigned char* lds;
    volatile LAS unsigned* MISC;
    gu32* ctl;
    int tid, lane, wave;
    int vcu, G;
};
__device__ __forceinline__ int ada_row(int m) { return m < MP ? 0 : 1 + ((m - MP) >> 3); }
__device__ __forceinline__ float wave_sum(float v) {
#pragma unroll
    for (int o = 1; o < 64; o <<= 1) v += __shfl_xor(v, o);
    return v;
}
__device__ __forceinline__ float wave_max(float v) {
#pragma unroll
    for (int o = 1; o < 64; o <<= 1) v = fmaxf(v, __shfl_xor(v, o));
    return v;
}

namespace pg8 {
struct EpiF32 {
    static constexpr bool PERM = false, AFTER_DRAIN = false;
    float* C; int ldc; const float* bias;
    __device__ __forceinline__ void operator()(const f32x4 (&acc)[2][2][4][2], const Unit2& u, int wr, int wc, int fr, int fq) const {
        const int row0 = u.pm * BM + wr * 64 + fr, col0 = u.pn * BM + wc * 32 + 4 * fq;
        f32x4 bv[2][2];
#pragma unroll
        for (int bj = 0; bj < 2; ++bj)
#pragma unroll
            for (int n = 0; n < 2; ++n) bv[bj][n] = *(const f32x4*)(bias + col0 + bj * HALF + n * 16);
#pragma unroll
        for (int ai = 0; ai < 2; ++ai)
#pragma unroll
            for (int m = 0; m < 4; ++m) { float* rowp = C + (size_t)(row0 + ai * HALF + m * 16) * ldc + col0;
#pragma unroll
                for (int bj = 0; bj < 2; ++bj)
#pragma unroll
                    for (int n = 0; n < 2; ++n) *(f32x4*)(rowp + bj * HALF + n * 16) = acc[ai][bj][m][n] + bv[bj][n]; }
    }
};
template <int ACT  > struct EpiGated {
    static constexpr bool PERM = true, AFTER_DRAIN = false;
    bf16_t* O; int ldo; int col_off;
    __device__ __forceinline__ void operator()(const f32x4 (&acc)[2][2][4][2], const Unit2& u, int wr, int wc, int fr, int fq) const {
        const int row0 = u.pm * BM + wr * 64 + fr, col = col_off + u.pn * HALF + wc * 32 + 8 * fq;
#pragma unroll
        for (int ai = 0; ai < 2; ++ai)
#pragma unroll
            for (int m = 0; m < 4; ++m) {
                float r[8];
#pragma unroll
                for (int n = 0; n < 2; ++n)
#pragma unroll
                    for (int e = 0; e < 4; ++e) { const float a = acc[ai][0][m][n][e], b = acc[ai][1][m][n][e];
                        r[n * 4 + e] = (ACT == 0) ? a * b * fast_sigmoid(a) : a * fast_sigmoid(b); }
                u32x4 w; w.x = cvt_pk_bf16(r[0], r[1]); w.y = cvt_pk_bf16(r[2], r[3]); w.z = cvt_pk_bf16(r[4], r[5]); w.w = cvt_pk_bf16(r[6], r[7]);
                *(u32x4*)(O + blk_off(row0 + ai * HALF + m * 16, col, ldo)) = w;
            }
    }
};
struct EpiGated8 {
    static constexpr bool PERM = true, AFTER_DRAIN = false;
    bf16_t* O; int ldo; const float* sA; const unsigned* amax;
    __device__ __forceinline__ void operator()(const i32x4 (&acc)[2][2][4][2], const Unit2& u, int wr, int wc, int fr, int fq) const {
        const int row0 = u.pm * BM + wr * 64 + fr, col = u.pn * HALF + wc * 32 + 8 * fq;
        const float sg = __builtin_bit_cast(float, amax[0]) * (1.0f / 127.0f), su = __builtin_bit_cast(float, amax[1]) * (1.0f / 127.0f);
        float ras[2][4];
#pragma unroll
        for (int ai = 0; ai < 2; ++ai)
#pragma unroll
            for (int m = 0; m < 4; ++m) ras[ai][m] = sA[row0 + ai * HALF + m * 16];
#pragma unroll
        for (int ai = 0; ai < 2; ++ai)
#pragma unroll
            for (int m = 0; m < 4; ++m) { const int row = row0 + ai * HALF + m * 16; const float ra = ras[ai][m]; const float fg = ra * sg, fu = ra * su;
                float r[8];
#pragma unroll
                for (int n = 0; n < 2; ++n)
#pragma unroll
                    for (int e = 0; e < 4; ++e) { const float a = (float)acc[ai][0][m][n][e] * fg, b = (float)acc[ai][1][m][n][e] * fu;
                        r[n * 4 + e] = a * b * fast_sigmoid(a); }
                u32x4 w; w.x = cvt_pk_bf16(r[0], r[1]); w.y = cvt_pk_bf16(r[2], r[3]); w.z = cvt_pk_bf16(r[4], r[5]); w.w = cvt_pk_bf16(r[6], r[7]);
                *(u32x4*)(O + blk_off(row, col, ldo)) = w;
                __builtin_amdgcn_sched_barrier(0);
            }
    }
};
template <bool BIN, bool BOUT>
struct EpiResid {
    static constexpr bool PERM = false, AFTER_DRAIN = false;
    const float* baseP; const float* baseS; float* out; const float* ada; int gate_off; float coef; float* slab;
    __device__ __forceinline__ void operator()(f32x4 (&acc)[2][2][4][2], const Unit2& u, int wr, int wc, int fr, int fq) const {
        const int row0 = u.pm * BM + wr * 64 + fr, col0 = u.pn * BM + wc * 32 + 4 * fq;
        if (u.split) {
#pragma unroll
            for (int ai = 0; ai < 2; ++ai)
#pragma unroll
                for (int m = 0; m < 4; ++m) { const int row = row0 + ai * HALF + m * 16;
                    unsigned short* sl = (unsigned short*)slab + ((size_t)(u.k0 / u.nt) * MS + (size_t)(row - MP)) * DM;
#pragma unroll
                    for (int bj = 0; bj < 2; ++bj)
#pragma unroll
                        for (int n = 0; n < 2; ++n) { const int c = col0 + bj * HALF + n * 16; const f32x4 a_ = acc[ai][bj][m][n];
                            *(u32x2v*)(sl + c) = (u32x2v){cvt_pk_bf16(a_.x, a_.y), cvt_pk_bf16(a_.z, a_.w)}; } }
        } else {
            f32x4 g00, g01, g10, g11;
#define RES_LDP(D0, D1, D2, D3, PTR) do { const float* p_ = (PTR); \
                asm volatile("global_load_dwordx4 %0, %4, off\n\tglobal_load_dwordx4 %1, %4, off offset:64\n\tglobal_load_dwordx4 %2, %4, off offset:512\n\tglobal_load_dwordx4 %3, %4, off offset:576" \
                             : "=&v"(D0), "=&v"(D1), "=&v"(D2), "=&v"(D3) : "v"(p_) : "memory"); } while (0)
#define RES_LDB(D0, D1, D2, D3, PTR) do { const unsigned short* p_ = (PTR); \
                asm volatile("global_load_dwordx2 %0, %4, off\n\tglobal_load_dwordx2 %1, %4, off offset:32\n\tglobal_load_dwordx2 %2, %4, off offset:256\n\tglobal_load_dwordx2 %3, %4, off offset:288" \
                             : "=&v"(D0), "=&v"(D1), "=&v"(D2), "=&v"(D3) : "v"(p_) : "memory"); } while (0)
#define RES_WAIT(N, C0, C1, C2, C3) asm volatile("s_waitcnt vmcnt(" #N ")" : "+v"(C0), "+v"(C1), "+v"(C2), "+v"(C3), "+v"(g00), "+v"(g01), "+v"(g10), "+v"(g11) :: "memory")
#define RES_FMA(Q, V0, V1, V2, V3) do { constexpr int ai_ = (Q) >> 2, m_ = (Q) & 3; \
                acc[ai_][0][m_][0] = (V0) + (g00 * coef) * acc[ai_][0][m_][0]; acc[ai_][0][m_][1] = (V1) + (g01 * coef) * acc[ai_][0][m_][1]; \
                acc[ai_][1][m_][0] = (V2) + (g10 * coef) * acc[ai_][1][m_][0]; acc[ai_][1][m_][1] = (V3) + (g11 * coef) * acc[ai_][1][m_][1]; } while (0)
            RES_LDP(g00, g01, g10, g11, ada + gate_off + col0);
            if constexpr (!BIN) {
                f32x4 b0, b1, b2, b3, n0, n1, n2, n3;
#define RES_LD(D0, D1, D2, D3, ROWOFF) RES_LDP(D0, D1, D2, D3, baseP + (ROWOFF))
                RES_LD(b0, b1, b2, b3, (size_t)row0 * DM + col0);
#define RES_STEP(Q, C0, C1, C2, C3, N0, N1, N2, N3) do { \
                    if ((Q) < 7) { constexpr int ai2_ = ((Q) + 1) >> 2, m2_ = ((Q) + 1) & 3; RES_LD(N0, N1, N2, N3, (size_t)(row0 + ai2_ * HALF + m2_ * 16) * DM + col0); RES_WAIT(4, C0, C1, C2, C3); } \
                    else RES_WAIT(0, C0, C1, C2, C3); \
                    RES_FMA(Q, C0, C1, C2, C3); } while (0)
                RES_STEP(0, b0, b1, b2, b3, n0, n1, n2, n3); RES_STEP(1, n0, n1, n2, n3, b0, b1, b2, b3); RES_STEP(2, b0, b1, b2, b3, n0, n1, n2, n3); RES_STEP(3, n0, n1, n2, n3, b0, b1, b2, b3);
                RES_STEP(4, b0, b1, b2, b3, n0, n1, n2, n3); RES_STEP(5, n0, n1, n2, n3, b0, b1, b2, b3); RES_STEP(6, b0, b1, b2, b3, n0, n1, n2, n3); RES_STEP(7, n0, n1, n2, n3, b0, b1, b2, b3);
#undef RES_STEP
#undef RES_LD
            } else {
                const unsigned short* bp = (const unsigned short*)baseP;
                u32x2v b0, b1, b2, b3, n0, n1, n2, n3;
#define RES_BF(W) ((f32x4){__builtin_bit_cast(float, (W).x << 16), __builtin_bit_cast(float, (W).x & 0xffff0000u), __builtin_bit_cast(float, (W).y << 16), __builtin_bit_cast(float, (W).y & 0xffff0000u)})
#define RES_LD(D0, D1, D2, D3, ROWOFF) RES_LDB(D0, D1, D2, D3, bp + (ROWOFF))
                RES_LD(b0, b1, b2, b3, (size_t)row0 * DM + col0);
#define RES_STEP(Q, C0, C1, C2, C3, N0, N1, N2, N3) do { \
                    if ((Q) < 7) { constexpr int ai2_ = ((Q) + 1) >> 2, m2_ = ((Q) + 1) & 3; RES_LD(N0, N1, N2, N3, (size_t)(row0 + ai2_ * HALF + m2_ * 16) * DM + col0); RES_WAIT(4, C0, C1, C2, C3); } \
                    else RES_WAIT(0, C0, C1, C2, C3); \
                    RES_FMA(Q, RES_BF(C0), RES_BF(C1), RES_BF(C2), RES_BF(C3)); } while (0)
                RES_STEP(0, b0, b1, b2, b3, n0, n1, n2, n3); RES_STEP(1, n0, n1, n2, n3, b0, b1, b2, b3); RES_STEP(2, b0, b1, b2, b3, n0, n1, n2, n3); RES_STEP(3, n0, n1, n2, n3, b0, b1, b2, b3);
                RES_STEP(4, b0, b1, b2, b3, n0, n1, n2, n3); RES_STEP(5, n0, n1, n2, n3, b0, b1, b2, b3); RES_STEP(6, b0, b1, b2, b3, n0, n1, n2, n3); RES_STEP(7, n0, n1, n2, n3, b0, b1, b2, b3);
#undef RES_STEP
#undef RES_LD
#undef RES_BF
            }
#undef RES_FMA
#undef RES_WAIT
#undef RES_LDB
#undef RES_LDP
            asm volatile("" ::: "memory");
            if constexpr (!BOUT) {
#pragma unroll
                for (int q = 0; q < 8; ++q) { const int ai = q >> 2, m = q & 3; const size_t ro = (size_t)(row0 + ai * HALF + m * 16) * DM + col0;
                    *(f32x4*)(out + ro) = acc[ai][0][m][0]; *(f32x4*)(out + ro + 16) = acc[ai][0][m][1]; *(f32x4*)(out + ro + HALF) = acc[ai][1][m][0]; *(f32x4*)(out + ro + HALF + 16) = acc[ai][1][m][1]; }
            } else {
                unsigned short* ob = (unsigned short*)out;
#define RES_PK(V) ((u32x2v){cvt_pk_bf16((V).x, (V).y), cvt_pk_bf16((V).z, (V).w)})
#pragma unroll
                for (int q = 0; q < 8; ++q) { const int ai = q >> 2, m = q & 3; const size_t ro = (size_t)(row0 + ai * HALF + m * 16) * DM + col0;
                    *(u32x2v*)(ob + ro) = RES_PK(acc[ai][0][m][0]); *(u32x2v*)(ob + ro + 16) = RES_PK(acc[ai][0][m][1]); *(u32x2v*)(ob + ro + HALF) = RES_PK(acc[ai][1][m][0]); *(u32x2v*)(ob + ro + HALF + 16) = RES_PK(acc[ai][1][m][1]); }
#undef RES_PK
            }
        }
    }
};
struct EpiInProj {
    static constexpr bool PERM = false, AFTER_DRAIN = false;
    bf16_t *Q, *K, *VT, *U; float* SQKV; float* out; const _Float16* rope16; const float* gq; const float* gk;
    __device__ __forceinline__ void operator()(const f32x4 (&acc)[2][2][4][2], const Unit2& u, int wr, int wc, int fr, int fq) const {
        const int row0 = u.pm * BM + wr * 64 + fr; const int pn = u.pn;
        if (pn < 4) {
            const bool isq = pn < 2; const int hh = 4 * (pn & 1) + wc; const float* gw = isq ? gq : gk;
            f32x4 gv[2][2];
#pragma unroll
            for (int bj = 0; bj < 2; ++bj)
#pragma unroll
                for (int n = 0; n < 2; ++n) gv[bj][n] = *(const f32x4*)(gw + 32 * bj + 16 * n + 4 * fq);
            typedef _Float16 h16x4 __attribute__((ext_vector_type(4)));
            h16x4 rcs[2][4], rsn[2][4];
#pragma unroll
            for (int ai = 0; ai < 2; ++ai)
#pragma unroll
                for (int m = 0; m < 4; ++m) { const size_t ro = (size_t)(row0 + ai * HALF + m * 16) * 16 + 4 * (fq & 1); rcs[ai][m] = *(const h16x4*)(rope16 + ro); rsn[ai][m] = *(const h16x4*)(rope16 + ro + 8); }
#pragma unroll
            for (int ai = 0; ai < 2; ++ai)
#pragma unroll
                for (int m = 0; m < 4; ++m) { const int row = row0 + ai * HALF + m * 16;
                    const f32x4 cs = {(float)rcs[ai][m][0], (float)rcs[ai][m][1], (float)rcs[ai][m][2], (float)rcs[ai][m][3]}, sn = {(float)rsn[ai][m][0], (float)rsn[ai][m][1], (float)rsn[ai][m][2], (float)rsn[ai][m][3]};
                    float ss = 0.f;
#pragma unroll
                    for (int bj = 0; bj < 2; ++bj)
#pragma unroll
                        for (int n = 0; n < 2; ++n) { const f32x4 x = acc[ai][bj][m][n]; ss += (x[0] * x[0] + x[1] * x[1]) + (x[2] * x[2] + x[3] * x[3]); }
                    ss += __shfl_xor(ss, 16); ss += __shfl_xor(ss, 32);
                    const float rs = 1.0f / sqrtf(ss * (1.0f / 64.0f) + EPS);
                    f32x4 y[2][2];
#pragma unroll
                    for (int bj = 0; bj < 2; ++bj)
#pragma unroll
                        for (int n = 0; n < 2; ++n) y[bj][n] = acc[ai][bj][m][n] * rs * gv[bj][n];
                    {

                        f32x4 w;
#pragma unroll
                        for (int e = 0; e < 4; ++e) w[e] = __shfl_xor(y[0][0][e], 32);
                        y[0][0] = (fq < 2) ? (y[0][0] * cs - w * sn) : (y[0][0] * cs + w * sn);
                    }
                    if (isq) {
#pragma unroll
                        for (int bj = 0; bj < 2; ++bj)
#pragma unroll
                            for (int n = 0; n < 2; ++n) { const f32x4 v = y[bj][n] * QSCALE; const int c = hh * 64 + 32 * bj + 16 * n + 4 * fq;
                                u32x2v w2; w2.x = cvt_pk_bf16(v[0], v[1]); w2.y = cvt_pk_bf16(v[2], v[3]); *(u32x2v*)(Q + (size_t)row * DATT + c) = w2;
                                if (row >= MP) *(f32x4*)(SQKV + (size_t)(row - MP) * 1536 + c) = v; }
                    } else {
#pragma unroll
                        for (int bj = 0; bj < 2; ++bj)
#pragma unroll
                            for (int n = 0; n < 2; ++n) { const f32x4 v = y[bj][n]; const int c = hh * 64 + 32 * bj + 16 * n + 4 * fq;
                                u32x2v w2; w2.x = cvt_pk_bf16(v[0], v[1]); w2.y = cvt_pk_bf16(v[2], v[3]); *(u32x2v*)(K + (size_t)row * DATT + c) = w2;
                                if (row >= MP) { const int rs_ = row - MP, b = rs_ >> 3, s = rs_ & 7;
                                    *(f32x4*)(SQKV + (size_t)rs_ * 1536 + 512 + c) = v;
                                    *(f32x4*)(out + O_KS + ((size_t)b * WBUF + (WBUF - DSEQ) + s) * DATT + c) = v; }
                                else if (row >= MP - WBUF) *(f32x4*)(out + O_KP + (size_t)(row - (MP - WBUF)) * DATT + c) = v; }
                    }
                }
        } else if (pn < 6) {
#pragma unroll
            for (int ai = 0; ai < 2; ++ai)
#pragma unroll
                for (int m = 0; m < 4; ++m) { const int row = row0 + ai * HALF + m * 16;
#pragma unroll
                    for (int bj = 0; bj < 2; ++bj)
#pragma unroll
                        for (int n = 0; n < 2; ++n) { const f32x4 v = acc[ai][bj][m][n]; const int c = (pn - 4) * 256 + bj * HALF + wc * 32 + n * 16 + 4 * fq;
                            if (row >= MP) { const int rs_ = row - MP, b = rs_ >> 3, s = rs_ & 7;
                                *(f32x4*)(SQKV + (size_t)rs_ * 1536 + 1024 + c) = v;
                                *(f32x4*)(out + O_VS + ((size_t)b * WBUF + (WBUF - DSEQ) + s) * DATT + c) = v; }
                            else {
                                if (row >= MP - WBUF) *(f32x4*)(out + O_VP + (size_t)(row - (MP - WBUF)) * DATT + c) = v;
                                u32x2v w2; w2.x = cvt_pk_bf16(v[0], v[1]); w2.y = cvt_pk_bf16(v[2], v[3]); *(u32x2v*)(VT + (size_t)row * DATT + c) = w2;
                            } }
                }
        } else {
#pragma unroll
            for (int ai = 0; ai < 2; ++ai)
#pragma unroll
                for (int m = 0; m < 4; ++m) { const int row = row0 + ai * HALF + m * 16;
#pragma unroll
                    for (int bj = 0; bj < 2; ++bj)
#pragma unroll
                        for (int n = 0; n < 2; ++n) { const f32x4 v = acc[ai][bj][m][n]; const int c = (pn - 6) * 256 + bj * HALF + wc * 32 + n * 16 + 4 * fq;
                            u32x2v w2; w2.x = cvt_pk_bf16(v[0], v[1]); w2.y = cvt_pk_bf16(v[2], v[3]); *(u32x2v*)(U + (size_t)row * DSSM + c) = w2; }
                }
        }
    }
};
}

__device__ __forceinline__ void p0_transpose_item(const float* W, int K, int N, bf16* WT, int k0, int n0, int dest_row0, LAS float* scr, int lane) {
    float tv[32];
#pragma unroll
    for (int i = 0; i < 32; ++i) tv[i] = __builtin_nontemporal_load(W + (size_t)(k0 + 2 * i + (lane >> 5)) * N + n0 + (lane & 31));
#pragma unroll
    for (int i = 0; i < 32; ++i) scr[(2 * i + (lane >> 5)) * 33 + (lane & 31)] = tv[i];
    LDS_WAIT(); asm volatile("" ::: "memory");
    const int c = lane & 7;
#pragma unroll
    for (int j = 0; j < 4; ++j) { const int n = (lane >> 3) + 8 * j; const LAS float* s = scr + (8 * c) * 33 + n;
        v4u o; o.x = pk2(s[0 * 33], s[1 * 33]); o.y = pk2(s[2 * 33], s[3 * 33]); o.z = pk2(s[4 * 33], s[5 * 33]); o.w = pk2(s[6 * 33], s[7 * 33]);
        *(GAS v4u*)(WT + pg8::blk_off(dest_row0 + n, k0 + 8 * c, K)) = o; }
    LDS_WAIT(); asm volatile("" ::: "memory");
}
__device__ __forceinline__ int dest_row_of(int mode, int half, int n0);
__device__ __forceinline__ void p0_transpose_item8(const float* W, int K, int N, unsigned char* WT8, int k0, int n0, int dest_row0, const unsigned* amax, LAS float* scr, int lane) {
    float tv[32];
#pragma unroll
    for (int i = 0; i < 32; ++i) tv[i] = __builtin_nontemporal_load(W + (size_t)(k0 + 2 * i + (lane >> 5)) * N + n0 + (lane & 31));
#pragma unroll
    for (int i = 0; i < 32; ++i) scr[(2 * i + (lane >> 5)) * 33 + (lane & 31)] = tv[i];
    LDS_WAIT(); asm volatile("" ::: "memory");
    const int c = lane & 7; const float am = __builtin_bit_cast(float, amax[0]); const float qs = am > 0.f ? 127.0f / am : 0.f;
#pragma unroll
    for (int j = 0; j < 4; ++j) { const int n = (lane >> 3) + 8 * j; const LAS float* s = scr + (8 * c) * 33 + n;
        unsigned lo = 0u, hi = 0u;
#pragma unroll
        for (int q = 0; q < 4; ++q) { const int a = (int)__builtin_rintf(s[q * 33] * qs), b = (int)__builtin_rintf(s[(q + 4) * 33] * qs); lo |= ((unsigned)a & 0xffu) << (8 * q); hi |= ((unsigned)b & 0xffu) << (8 * q); }
        *(GAS v2u*)(WT8 + pg8::blk_byte(dest_row0 + n, k0 + 8 * c, K)) = (v2u){lo, hi}; }
    LDS_WAIT(); asm volatile("" ::: "memory");
}
__device__ __forceinline__ bool p0_mat8(const float* W, int K, int N, unsigned char* WT8, int half, const unsigned* amax, int& r, LAS float* scr, int lane) {
    const int nblk = N / 32, items = (K / 64) * nblk;
    if (r < items) { const int kb = r / nblk, nb = r % nblk; p0_transpose_item8(W, K, N, WT8, 64 * kb, 32 * nb, dest_row_of(1, half, 32 * nb), amax, scr, lane); return true; }
    r -= items; return false;
}
__device__ __forceinline__ int dest_row_of(int mode, int half, int n0) {
    if (mode == 1) return 256 * (n0 >> 7) + 128 * half + (n0 & 127);
    if (mode == 3) { const int hf = n0 >> 9, n = n0 & 511; return 256 * (n >> 7) + 128 * hf + (n & 127); }
    if (mode == 2 && n0 < 1024) { const int tile = n0 >> 8, hd = (n0 & 255) >> 6, e = n0 & 63; return 256 * tile + 128 * (e >> 5) + 32 * hd + (e & 31); }
    return n0;
}
__device__ __forceinline__ bool p0_mat(const float* W, int K, int N, bf16* WT, int mode, int half, int& r, LAS float* scr, int lane) {
    const int nblk = N / 32, items = (K / 64) * nblk;
    if (r < items) { const int kb = r / nblk, nb = r % nblk; p0_transpose_item(W, K, N, WT, 64 * kb, 32 * nb, dest_row_of(mode, half, 32 * nb), scr, lane); return true; }
    r -= items; return false;
}
__device__ __forceinline__ void p1_weights(Frame& F, const Args& A, int widx, int nworker) {
    LAS float* scr = (LAS float*)(F.lds + RING_OFF + F.wave * 16384);
    unsigned char* ws = A.ws;
    constexpr int NITEMS = 6 * 1408 + 1024 + 256 + 512;
    const unsigned* amax = (const unsigned*)(ws + WS_CTL) + CW_AMAX;
    for (int it = widx; it < NITEMS; it += nworker) {
        int r = it;
        if (p0_mat8(A.in[I_W1G], DM, DFF, ws + WS_W1T8, 0, amax + 0, r, scr, F.lane)) continue;
        if (p0_mat8(A.in[I_W1U], DM, DFF, ws + WS_W1T8, 1, amax + 1, r, scr, F.lane)) continue;
        if (p0_mat(A.in[I_W1D], DFF, DM, (bf16*)(ws + WS_W1D), 0, 0, r, scr, F.lane)) continue;
        if (p0_mat(A.in[I_WIN], DM, 2048, (bf16*)(ws + WS_WIN), 2, 0, r, scr, F.lane)) continue;
        if (p0_mat(A.in[I_WGLU], DSSM, 1024, (bf16*)(ws + WS_WGLU), 3, 0, r, scr, F.lane)) continue;
        if (p0_mat(A.in[I_WOUT], DM, DM, (bf16*)(ws + WS_WOUT), 0, 0, r, scr, F.lane)) continue;
        if (p0_mat8(A.in[I_W2G], DM, DFF, ws + WS_W2T8, 0, amax + 2, r, scr, F.lane)) continue;
        if (p0_mat8(A.in[I_W2U], DM, DFF, ws + WS_W2T8, 1, amax + 3, r, scr, F.lane)) continue;
        p0_mat(A.in[I_W2D], DFF, DM, (bf16*)(ws + WS_W2D), 0, 0, r, scr, F.lane);
    }
}
__device__ __forceinline__ void p0_prologue(Frame& F, const Args& A) {
    LAS float* scr = (LAS float*)(F.lds + RING_OFF + F.wave * 16384);
    const int gw = F.vcu * NWAVES + F.wave, NGW = F.G * NWAVES;
    unsigned char* ws = A.ws;
    for (int it = gw; it < 4608; it += NGW) { int r = it; p0_mat(A.in[I_WADA], DM, NADA, (bf16*)(ws + WS_WADA), 0, 0, r, scr, F.lane); }
    { unsigned* amax = (unsigned*)(ws + WS_CTL) + CW_AMAX;
      for (int it = gw; it < 4 * 44 * 8; it += NGW) { const int mat = it / 352, rem = it % 352, cb = rem >> 3, kb = rem & 7;
          const float* W = A.in[mat == 0 ? I_W1G : (mat == 1 ? I_W1U : (mat == 2 ? I_W2G : I_W2U))] + (size_t)(128 * kb) * DFF + 64 * cb + F.lane;
          float mx = 0.f;
#pragma unroll 16
          for (int k = 0; k < 128; ++k) mx = fmaxf(mx, fabsf(W[(size_t)k * DFF]));
          mx = wave_max(mx); if (F.lane == 0) atomicMax(amax + mat, __builtin_bit_cast(unsigned, mx)); } }
    const int gt = gw * 64 + F.lane, NGT = NGW * 64;
    { bf16* SC = (bf16*)(ws + WS_SC);
      for (int i = gt; i < 256 * DM / 2; i += NGT) { const int row = (2 * i) / DM, col = (2 * i) % DM; unsigned w = 0u;
          if (row < 129) { const float* c = row == 0 ? A.in[I_CP] : A.in[I_CS] + (size_t)(row - 1) * DM; const float a = c[col], b = c[col + 1]; w = pk2(a * fast_sigmoid(a), b * fast_sigmoid(b)); }
          *(GAS unsigned*)(SC + pg8::blk_off(row, col, DM)) = w; } }
    { _Float16* R = (_Float16*)(ws + WS_ROPE);
      for (int i = gt; i < MTOT * 8; i += NGT) { const int m = i >> 3, j = i & 7; const int pos = m < MP ? m : PAST + ((m - MP) & 7);
          const double inv = exp(-(double)j * (1.0 / 8.0) * 13.122363377404328  ); const double ang = (double)((float)pos * (float)inv);
          R[(size_t)m * 16 + j] = (_Float16)(float)cos(ang); R[(size_t)m * 16 + 8 + j] = (_Float16)(float)sin(ang); } }
    { unsigned char* T = ws + WS_SSMT;
      for (int id = gt; id < 83968; id += NGT) {
          if (id < 43008) {
              int gp, n; float* dst;
              if (id < 32768) { gp = id >> 4; n = (id & 15) + 1; dst = (float*)(T + ST_CP) + (size_t)gp * 32 + 2 * (id & 15); }
              else if (id < 40960) { const int i = id - 32768; gp = i >> 2; n = 1 << (i & 3); dst = (float*)(T + ST_PW) + (size_t)gp * 8 + 2 * (i & 3); }
              else { gp = id - 40960; n = CHUNK; dst = (float*)(T + ST_CL) + (size_t)gp * 2; }
              const double dt = exp((double)A.in[I_LDT][gp >> 6]); const double zr = (double)A.in[I_ARE][gp] * dt, zi = (double)A.in[I_AIM][gp] * dt;
              const double mg = exp((double)n * zr); dst[0] = (float)(mg * cos((double)n * zi)); dst[1] = (float)(mg * sin((double)n * zi));
          } else if (id < 75776) {
              const int i = id - 43008, gp = i >> 4, c = i & 15, grp = gp >> 6, p = gp & 63, pr = p >> 4, rho = p & 15;
              const double dt = exp((double)A.in[I_LDT][grp]); const double lre = (double)A.in[I_ARE][gp], lim = (double)A.in[I_AIM][gp];
              const double zr = lre * dt, zi = lim * dt; const double mg1 = exp(zr), br = mg1 * cos(zi) - 1.0, bi = mg1 * sin(zi); const double den = lre * lre + lim * lim;
              const double fr_ = (br * lre + bi * lim) / den, fi_ = (bi * lre - br * lim) / den;
              const double b_r = (double)A.in[I_BRE][(size_t)gp * 16 + c], b_i = (double)A.in[I_BIM][(size_t)gp * 16 + c];
              bf16* AB = (bf16*)(T + ST_ABAR) + (size_t)grp * 8 * 64 * 8; const int gq = c >> 3, j = c & 7;
              AB[((size_t)(2 * pr + 0) * 64 + rho + 16 * gq) * 8 + j] = (bf16)f2bf((float)(fr_ * b_r - fi_ * b_i));
              AB[((size_t)(2 * pr + 1) * 64 + rho + 16 * gq) * 8 + j] = (bf16)f2bf((float)(fr_ * b_i + fi_ * b_r));
              AB[((size_t)(2 * pr + 0) * 64 + rho + 16 * (gq + 2)) * 8 + j] = 0; AB[((size_t)(2 * pr + 1) * 64 + rho + 16 * (gq + 2)) * 8 + j] = 0;
          } else {
              const int i = id - 75776, grp = i >> 8, prc = (i >> 6) & 3, ln = i & 63, c = ln & 15, gq = ln >> 4;
              bf16* CMt = (bf16*)(T + ST_CM) + ((size_t)(grp * 4 + prc) * 64 + ln) * 8;
#pragma unroll
              for (int j = 0; j < 8; ++j) { const int ps = 16 * prc + 4 * gq + (j & 3);
                  const float v = (j < 4) ? A.in[I_CRE][((size_t)grp * 16 + c) * 64 + ps] : -A.in[I_CIM][((size_t)grp * 16 + c) * 64 + ps];
                  CMt[j] = (bf16)f2bf(v); }
          }
      } }
}

__device__ __forceinline__ void copy_tiles(const Args& A, int widx, int nworker, int lane) {
    constexpr int TPB = 255, NT = 2 * NBAT * TPB;
    for (int t = widx; t < NT; t += nworker) {
        const int kv = t / (NBAT * TPB), r = t % (NBAT * TPB), b = r / TPB, tl = r % TPB;
        const f32x4* src = (const f32x4*)(A.in[kv ? I_CV : I_CK] + (size_t)b * (WBUF * DATT) + DSEQ * DATT) + (size_t)tl * 1024 + lane;
        f32x4* dst = (f32x4*)(A.out + (kv ? O_VS : O_KS) + (size_t)b * (WBUF * DATT)) + (size_t)tl * 1024 + lane;
        f32x4 v[16];
#pragma unroll
        for (int j = 0; j < 16; ++j) v[j] = __builtin_nontemporal_load(src + 64 * j);
#pragma unroll
        for (int j = 0; j < 16; ++j) __builtin_nontemporal_store(v[j], dst + 64 * j);
    }
}

struct Combine { const float* slab; int nsl; const float* cbase; int gate_off; float ccoef; float* cres; };
__device__ __forceinline__ f32x4 bf4(const v2u w) { return (f32x4){__builtin_bit_cast(float, w.x << 16), __builtin_bit_cast(float, w.x & 0xffff0000u), __builtin_bit_cast(float, w.y << 16), __builtin_bit_cast(float, w.y & 0xffff0000u)}; }
template <int NSL>
__device__ __forceinline__ f32x4 combine_chunk(const Combine& C, const float* ar, int ms, int lane, int j) {
    v2u sl[NSL];
#pragma unroll
    for (int k = 0; k < NSL; ++k) sl[k] = ((const v2u*)((const bf16*)C.slab + ((size_t)k * MS + ms) * DM))[lane + 64 * j];
    const f32x4 gv = ((const f32x4*)(ar + C.gate_off))[lane + 64 * j], bv = ((const f32x4*)(C.cbase + (size_t)ms * DM))[lane + 64 * j];
    f32x4 acc = bf4(sl[0]);
#pragma unroll
    for (int k = 1; k < NSL; ++k) acc += bf4(sl[k]);
    const f32x4 r = bv + C.ccoef * gv * acc;
    ((f32x4*)(C.cres + (size_t)ms * DM))[lane + 64 * j] = r;
    return r;
}
template <int NSL>
__device__ __forceinline__ void combine_row(const Combine& C, const float* ar, int ms, int lane, f32x4 (&v)[4]) {
#pragma unroll
    for (int j = 0; j < 4; ++j) v[j] = combine_chunk<NSL>(C, ar, ms, lane, j);
}
template <bool PBF>
__device__ __forceinline__ f32x4 ld_prow(const float* srcP, const int m, const int i) {
    if constexpr (!PBF) return ((const f32x4*)(srcP + (size_t)m * DM))[i];
    else { const v2u w = ((const v2u*)((const bf16*)srcP + (size_t)m * DM))[i];
        return (f32x4){__builtin_bit_cast(float, w.x << 16), __builtin_bit_cast(float, w.x & 0xffff0000u), __builtin_bit_cast(float, w.y << 16), __builtin_bit_cast(float, w.y & 0xffff0000u)}; }
}
template <bool Q8>
__device__ __forceinline__ void norm_row(const f32x4 (&v)[4], const f32x4 (&gv)[4], const f32x4 (&sh)[4], const f32x4 (&sc)[4], const int m, const int lane, bf16* XN, unsigned char* XN8, float* sA) {
    float s = 0.f;
#pragma unroll
    for (int j = 0; j < 4; ++j) s += (v[j].x * v[j].x + v[j].y * v[j].y) + (v[j].z * v[j].z + v[j].w * v[j].w);
    const float rstd = 1.f / sqrtf(wave_sum(s) * (1.f / DM) + EPS);
    f32x4 y[4]; float am = 0.f;
#pragma unroll
    for (int j = 0; j < 4; ++j) { y[j] = (v[j] * rstd * gv[j]) * (1.0f + sc[j]) + sh[j];
        am = fmaxf(am, fmaxf(fmaxf(fabsf(y[j].x), fabsf(y[j].y)), fmaxf(fabsf(y[j].z), fabsf(y[j].w)))); }
    if constexpr (Q8) {
        am = wave_max(am); const float qs = am > 0.f ? 127.0f / am : 0.f;
#pragma unroll
        for (int j = 0; j < 4; ++j) { const int a = (int)__builtin_rintf(y[j].x * qs), b = (int)__builtin_rintf(y[j].y * qs), c = (int)__builtin_rintf(y[j].z * qs), d = (int)__builtin_rintf(y[j].w * qs);
            *(GAS unsigned*)(XN8 + pg8::blk_byte(m, 4 * lane + 256 * j, DM)) = ((unsigned)a & 0xffu) | (((unsigned)b & 0xffu) << 8) | (((unsigned)c & 0xffu) << 16) | (((unsigned)d & 0xffu) << 24); }
        if (lane == 0) sA[m] = am * (1.0f / 127.0f);
    } else {
#pragma unroll
        for (int j = 0; j < 4; ++j) *(GAS unsigned long long*)(XN + pg8::blk_off(m, 4 * lane + 256 * j, DM)) = (unsigned long long)pk2(y[j].x, y[j].y) | ((unsigned long long)pk2(y[j].z, y[j].w) << 32);
    }
}
template <bool Q8, int NSL, int PE, bool PBF>
__device__ __forceinline__ void norm_mod_rows(Frame& F, const float* srcP, const float* srcS, const float* g, const float* ada, int sh_off, int sc_off, bf16* XN, const Combine C, unsigned char* XN8, float* sA) {
    f32x4 gv[4];
#pragma unroll
    for (int j = 0; j < 4; ++j) gv[j] = ((const f32x4*)g)[F.lane + 64 * j];
    if (F.G == 256) {
        const int pair = F.wave >> 1, odd = F.wave & 1;
        const int np = odd ? 16 - PE : PE, p0 = F.vcu * 64 + pair * 16 + (odd ? PE : 0);
        f32x4 vn[4], sh[4], sc[4];
#pragma unroll
        for (int j = 0; j < 4; ++j) vn[j] = ld_prow<PBF>(srcP, p0, F.lane + 64 * j);
        if (!odd) {
            const int ms = F.vcu * 4 + pair, m = MP + ms; const float* ar = ada + (size_t)ada_row(m) * NADA;
            f32x4 v[4];
#pragma unroll
            for (int j = 0; j < 4; ++j) { sh[j] = ((const f32x4*)(ar + sh_off))[F.lane + 64 * j]; sc[j] = ((const f32x4*)(ar + sc_off))[F.lane + 64 * j]; }
            if constexpr (NSL > 0) combine_row<NSL>(C, ar, ms, F.lane, v);
            else {
#pragma unroll
                for (int j = 0; j < 4; ++j) v[j] = ((const f32x4*)(srcS + (size_t)ms * DM))[F.lane + 64 * j]; }
            norm_row<Q8>(v, gv, sh, sc, m, F.lane, XN, XN8, sA);
        }
#pragma unroll
        for (int j = 0; j < 4; ++j) { sh[j] = ((const f32x4*)(ada + sh_off))[F.lane + 64 * j]; sc[j] = ((const f32x4*)(ada + sc_off))[F.lane + 64 * j]; }
#pragma unroll 1
        for (int i = 0; i < np; ++i) {
            f32x4 v[4];
#pragma unroll
            for (int j = 0; j < 4; ++j) v[j] = vn[j];
            const int nx = p0 + (i + 1 < np ? i + 1 : i);
#pragma unroll
            for (int j = 0; j < 4; ++j) vn[j] = ld_prow<PBF>(srcP, nx, F.lane + 64 * j);
            norm_row<Q8>(v, gv, sh, sc, p0 + i, F.lane, XN, XN8, sA);
        }
        return;
    }
    const int gw = F.vcu * NWAVES + F.wave, NGW = F.G * NWAVES;
    for (int m = gw; m < MTOT; m += NGW) {
        const float* ar = ada + (size_t)ada_row(m) * NADA;
        f32x4 v[4], sh[4], sc[4];
#pragma unroll
        for (int j = 0; j < 4; ++j) { sh[j] = ((const f32x4*)(ar + sh_off))[F.lane + 64 * j]; sc[j] = ((const f32x4*)(ar + sc_off))[F.lane + 64 * j]; }
        bool done = false;
        if constexpr (NSL > 0) { if (m >= MP) { combine_row<NSL>(C, ar, m - MP, F.lane, v); done = true; } }
        if (!done) {
#pragma unroll
            for (int j = 0; j < 4; ++j) v[j] = m < MP ? ld_prow<PBF>(srcP, m, F.lane + 64 * j) : ((const f32x4*)(srcS + (size_t)(m - MP) * DM))[F.lane + 64 * j]; }
        norm_row<Q8>(v, gv, sh, sc, m, F.lane, XN, XN8, sA);
    }
}

__device__ __forceinline__ void copy_back(pg8::CopyJob& C, int nops, const int lane) {
    while (nops > 0 && C.end > C.cur) {
        int nb = C.end - C.cur; nb = nb < 8 ? nb : 8; nb = nb < nops ? nb : nops;
        v4u v[8];
#pragma unroll
        for (int j = 0; j < 8; ++j) if (j < nb) v[j] = __builtin_nontemporal_load((const v4u*)(C.src + (size_t)(C.end - 1 - j) * pg8::CP_STRIDE) + lane);
#pragma unroll
        for (int j = 0; j < 8; ++j) if (j < nb) __builtin_nontemporal_store(v[j], (v4u*)(C.dst + (size_t)(C.end - 1 - j) * pg8::CP_STRIDE) + lane);
        C.end -= nb; nops -= nb;
    }
}

__device__ __forceinline__ bf16x8 ld8(const bf16* p) { return *(const bf16x8*)p; }
#define MFMA16(a, b, c) __builtin_amdgcn_mfma_f32_16x16x32_bf16((a), (b), (c), 0, 0, 0)

constexpr int AT_ROWB = 144, AT_VOFF = 384 * AT_ROWB;
typedef short s16x4 __attribute__((ext_vector_type(4)));
__device__ __forceinline__ s16x4 lds_tr(const LAS unsigned char* p) { return __builtin_amdgcn_ds_read_tr16_b64_v4i16((LAS s16x4*)p); }
__device__ __forceinline__ void attn_unit(unsigned char* ws, LAS unsigned char* lds, const int unit, const int tid, const int wave, const int lane) {
    const int G = unit >> 9, u = unit & 511, h = u >> 6;
    int r, sb, d, L;
    if (G == 0) { d = 1; L = 16384; r = 0; sb = u & 63; } else if (G == 1) { d = 4; L = 4096; r = (u >> 4) & 3; sb = u & 15; } else { d = 16; L = 1024; r = (u >> 2) & 15; sb = u & 3; }
    const int q0 = sb * 256, k0 = q0 - 128;
    const bf16* Q = (const bf16*)(ws + WS_Q); const bf16* Kb = (const bf16*)(ws + WS_K) + h * 64; const bf16* Vb = (const bf16*)(ws + WS_VT) + h * 64;
#pragma unroll
    for (int i = 0; i < 6; ++i) { const int c = tid + 512 * i, row = c >> 3, ch = c & 7; int kk = k0 + row; kk = kk < 0 ? 0 : (kk > L - 1 ? L - 1 : kk);
        const size_t off = (size_t)(r + d * kk) * DATT + ch * 8;
        const v4u kv = *(const v4u*)(Kb + off), vv = *(const v4u*)(Vb + off);
        *(LAS v4u*)(lds + row * AT_ROWB + ch * 16) = kv; *(LAS v4u*)(lds + AT_VOFF + row * AT_ROWB + ch * 16) = vv; }
    __syncthreads();
    const int l15 = lane & 15, g = lane >> 4, kb0 = 32 * wave;
    bf16x8 qf[2][2];
#pragma unroll
    for (int cb = 0; cb < 2; ++cb) { const size_t tq = (size_t)r + (size_t)d * (q0 + 32 * wave + 16 * cb + l15); const bf16* qp = Q + tq * DATT + h * 64 + 8 * g; qf[cb][0] = ld8(qp); qf[cb][1] = ld8(qp + 32); }
    f32x4 s[2][10];
#pragma unroll
    for (int pp = 0; pp < 5; ++pp)
#pragma unroll
        for (int hb = 0; hb < 2; ++hb) {
            const int kw = kb0 + 32 * pp + 8 * (l15 >> 2) + 4 * hb + (l15 & 3);
            const LAS unsigned char* kp = lds + kw * AT_ROWB + 16 * g;
            const bf16x8 a0 = *(const LAS bf16x8*)kp, a1 = *(const LAS bf16x8*)(kp + 64);
#pragma unroll
            for (int cb = 0; cb < 2; ++cb) { f32x4 z = {0.f, 0.f, 0.f, 0.f}; z = MFMA16(a0, qf[cb][0], z); z = MFMA16(a1, qf[cb][1], z); s[cb][2 * pp + hb] = z; }
        }
    float mx[2], ls[2];
#pragma unroll
    for (int cb = 0; cb < 2; ++cb) {
        const int qi = 32 * wave + 16 * cb + l15; float m = -1e30f;
#pragma unroll
        for (int i = 0; i < 10; ++i)
#pragma unroll
            for (int e = 0; e < 4; ++e) { const int kw = kb0 + 32 * (i >> 1) + 8 * g + 4 * (i & 1) + e; const bool valid = (kw >= qi) && (kw <= qi + 128) && (k0 + kw >= 0);
                const float v = valid ? s[cb][i][e] : -1e30f; s[cb][i][e] = v; m = fmaxf(m, v); }
        m = fmaxf(m, __shfl_xor(m, 16)); m = fmaxf(m, __shfl_xor(m, 32));
        float l = 0.f;
#pragma unroll
        for (int i = 0; i < 10; ++i)
#pragma unroll
            for (int e = 0; e < 4; ++e) { const float p = __builtin_amdgcn_exp2f(s[cb][i][e] - m); s[cb][i][e] = p; l += p; }
        l += __shfl_xor(l, 16); l += __shfl_xor(l, 32);
        mx[cb] = m; ls[cb] = l;
    }
    f32x4 o[2][4];
#pragma unroll
    for (int cb = 0; cb < 2; ++cb)
#pragma unroll
        for (int nb = 0; nb < 4; ++nb) o[cb][nb] = (f32x4){0.f, 0.f, 0.f, 0.f};
#pragma unroll
    for (int pp = 0; pp < 5; ++pp) {
        bf16x8 pb[2];
#pragma unroll
        for (int cb = 0; cb < 2; ++cb) { v4u pw; pw.x = pk2(s[cb][2 * pp][0], s[cb][2 * pp][1]); pw.y = pk2(s[cb][2 * pp][2], s[cb][2 * pp][3]); pw.z = pk2(s[cb][2 * pp + 1][0], s[cb][2 * pp + 1][1]); pw.w = pk2(s[cb][2 * pp + 1][2], s[cb][2 * pp + 1][3]);
            pb[cb] = __builtin_bit_cast(bf16x8, pw); }
        const LAS unsigned char* vp = lds + AT_VOFF + (kb0 + 32 * pp + 8 * g + (l15 >> 2)) * AT_ROWB + 8 * (l15 & 3);
#pragma unroll
        for (int nb = 0; nb < 4; ++nb) { const s16x4 t0 = lds_tr(vp + 32 * nb), t1 = lds_tr(vp + 4 * AT_ROWB + 32 * nb);
            const bf16x8 av = {t0[0], t0[1], t0[2], t0[3], t1[0], t1[1], t1[2], t1[3]};
#pragma unroll
            for (int cb = 0; cb < 2; ++cb) o[cb][nb] = MFMA16(av, pb[cb], o[cb][nb]); }
    }
    bf16* OP = (bf16*)(ws + WS_OP); float* ML = (float*)(ws + WS_ML);
#pragma unroll
    for (int cb = 0; cb < 2; ++cb) { const size_t tq = (size_t)r + (size_t)d * (q0 + 32 * wave + 16 * cb + l15); const size_t rowi = ((size_t)G * SEQ + tq) * NH + h; const float inv = 1.0f / ls[cb];
#pragma unroll
        for (int nb = 0; nb < 4; ++nb) { const f32x4 v = o[cb][nb] * inv; v2u w; w.x = pk2(v[0], v[1]); w.y = pk2(v[2], v[3]); *(v2u*)(OP + rowi * 64 + 16 * nb + 4 * g) = w; }
        if (g == 0) *(f32x2*)(ML + rowi * 2) = (f32x2){mx[cb], ls[cb]}; }
    __syncthreads();
}
constexpr int AT4_VOFF = 256 * AT_ROWB;
__device__ __forceinline__ void sync4(LAS unsigned* cnt, unsigned& epoch, const int lane) {
    asm volatile("s_waitcnt vmcnt(0) lgkmcnt(0)" ::: "memory");
    epoch += 4u;
    if (lane == 0) __hip_atomic_fetch_add(cnt, 1u, __ATOMIC_RELAXED, __HIP_MEMORY_SCOPE_WORKGROUP);
    for (unsigned sp = 0; __hip_atomic_load(cnt, __ATOMIC_RELAXED, __HIP_MEMORY_SCOPE_WORKGROUP) < epoch && sp < (1u << 22); ++sp) __builtin_amdgcn_s_sleep(1);
    asm volatile("s_waitcnt lgkmcnt(0)" ::: "memory");
}
struct AttU { int G, h, r, d, q0, k0, edge; };
__device__ __forceinline__ AttU att_decode(const int unit) {
    AttU a; a.G = unit >> 10; const int u = unit & 1023, rest = u & 127; a.h = u >> 7; int sb;
    if (a.G == 0) { a.d = 1; a.r = 0; sb = rest; } else if (a.G == 1) { a.d = 4; a.r = rest >> 5; sb = rest & 31; } else { a.d = 16; a.r = rest >> 3; sb = rest & 7; }
    a.q0 = sb * 128; a.k0 = a.q0 - 128; a.edge = (sb == 0); return a;
}
__device__ __forceinline__ void att_load(unsigned char* ws, const AttU& a, const int tid4, v4u (&kv)[8], v4u (&vv)[8]) {
    const bf16* Kb = (const bf16*)(ws + WS_K) + a.h * 64; const bf16* Vb = (const bf16*)(ws + WS_VT) + a.h * 64;
#pragma unroll
    for (int i = 0; i < 8; ++i) { const int c = tid4 + 256 * i, row = c >> 3, ch = c & 7; int kk = a.k0 + row; kk = kk < 0 ? 0 : kk;
        const size_t off = (size_t)(a.r + a.d * kk) * DATT + ch * 8; kv[i] = *(const v4u*)(Kb + off); vv[i] = *(const v4u*)(Vb + off); }
}
__device__ __forceinline__ void att_store(LAS unsigned char* lds, const int tid4, const v4u (&kv)[8], const v4u (&vv)[8]) {
#pragma unroll
    for (int i = 0; i < 8; ++i) { const int c = tid4 + 256 * i, row = c >> 3, ch = c & 7;
        *(LAS v4u*)(lds + row * AT_ROWB + ch * 16) = kv[i]; *(LAS v4u*)(lds + AT4_VOFF + row * AT_ROWB + ch * 16) = vv[i]; }
}
__device__ __forceinline__ void attn_unit4_compute(unsigned char* ws, LAS unsigned char* lds, const AttU& au, const int wave, const int lane, const bool pf, const AttU& nxt, const int tid4, v4u (&kv)[8], v4u (&vv)[8]) {
    const int G = au.G, h = au.h, r = au.r, d = au.d, q0 = au.q0, k0 = au.k0; const bool edge = au.edge != 0;
    const bf16* Q = (const bf16*)(ws + WS_Q);
    const int l15 = lane & 15, g = lane >> 4, kb0 = 32 * wave;
    bf16x8 qf[2][2];
#pragma unroll
    for (int cb = 0; cb < 2; ++cb) { const size_t tq = (size_t)r + (size_t)d * (q0 + 32 * wave + 16 * cb + l15); const bf16* qp = Q + tq * DATT + h * 64 + 8 * g; qf[cb][0] = ld8(qp); qf[cb][1] = ld8(qp + 32); }
    float mx[2], ls[2]; bf16x8 pb[2][5];
#pragma unroll
    for (int cb = 0; cb < 2; ++cb) {
        f32x4 s[10];
#pragma unroll
        for (int pp = 0; pp < 5; ++pp)
#pragma unroll
            for (int hb = 0; hb < 2; ++hb) {
                const int kw = kb0 + 32 * pp + 8 * (l15 >> 2) + 4 * hb + (l15 & 3);
                const LAS unsigned char* kp = lds + kw * AT_ROWB + 16 * g;
                const bf16x8 a0 = *(const LAS bf16x8*)kp, a1 = *(const LAS bf16x8*)(kp + 64);
                f32x4 z = {0.f, 0.f, 0.f, 0.f}; z = MFMA16(a0, qf[cb][0], z); z = MFMA16(a1, qf[cb][1], z); s[2 * pp + hb] = z;
            }
        const int qi = 32 * wave + 16 * cb + l15; float m = -1e30f;
#pragma unroll
        for (int i = 0; i < 10; ++i) {
            const bool interior = (i >= 2 && i < 8);
            if (!interior || edge) {
#pragma unroll
                for (int e = 0; e < 4; ++e) { const int kw = kb0 + 32 * (i >> 1) + 8 * g + 4 * (i & 1) + e; const bool valid = (kw >= qi) && (kw <= qi + 128) && (k0 + kw >= 0);
                    s[i][e] = valid ? s[i][e] : -1e30f; }
            }
#pragma unroll
            for (int e = 0; e < 4; ++e) m = fmaxf(m, s[i][e]);
        }
        m = fmaxf(m, __shfl_xor(m, 16)); m = fmaxf(m, __shfl_xor(m, 32));
        float l = 0.f;
#pragma unroll
        for (int i = 0; i < 10; ++i)
#pragma unroll
            for (int e = 0; e < 4; ++e) { const float p = __builtin_amdgcn_exp2f(s[i][e] - m); s[i][e] = p; l += p; }
        l += __shfl_xor(l, 16); l += __shfl_xor(l, 32);
        mx[cb] = m; ls[cb] = l;
#pragma unroll
        for (int pp = 0; pp < 5; ++pp) { v4u pw; pw.x = pk2(s[2 * pp][0], s[2 * pp][1]); pw.y = pk2(s[2 * pp][2], s[2 * pp][3]); pw.z = pk2(s[2 * pp + 1][0], s[2 * pp + 1][1]); pw.w = pk2(s[2 * pp + 1][2], s[2 * pp + 1][3]);
            pb[cb][pp] = __builtin_bit_cast(bf16x8, pw); }
    }
    if (pf) att_load(ws, nxt, tid4, kv, vv);
    f32x4 o[2][4];
#pragma unroll
    for (int cb = 0; cb < 2; ++cb)
#pragma unroll
        for (int nb = 0; nb < 4; ++nb) o[cb][nb] = (f32x4){0.f, 0.f, 0.f, 0.f};
#pragma unroll
    for (int pp = 0; pp < 5; ++pp) {
        const LAS unsigned char* vp = lds + AT4_VOFF + (kb0 + 32 * pp + 8 * g + (l15 >> 2)) * AT_ROWB + 8 * (l15 & 3);
#pragma unroll
        for (int nb = 0; nb < 4; ++nb) { const s16x4 t0 = lds_tr(vp + 32 * nb), t1 = lds_tr(vp + 4 * AT_ROWB + 32 * nb);
            const bf16x8 av = {t0[0], t0[1], t0[2], t0[3], t1[0], t1[1], t1[2], t1[3]};
#pragma unroll
            for (int cb = 0; cb < 2; ++cb) o[cb][nb] = MFMA16(av, pb[cb][pp], o[cb][nb]); }
    }
    bf16* OP = (bf16*)(ws + WS_OP); float* ML = (float*)(ws + WS_ML);
#pragma unroll
    for (int cb = 0; cb < 2; ++cb) { const size_t tq = (size_t)r + (size_t)d * (q0 + 32 * wave + 16 * cb + l15); const size_t rowi = ((size_t)G * SEQ + tq) * NH + h; const float inv = 1.0f / ls[cb];
#pragma unroll
        for (int nb = 0; nb < 4; ++nb) { const f32x4 v = o[cb][nb] * inv; v2u w; w.x = pk2(v[0], v[1]); w.y = pk2(v[2], v[3]); *(v2u*)(OP + rowi * 64 + 16 * nb + 4 * g) = w; }
        if (g == 0) *(f32x2*)(ML + rowi * 2) = (f32x2){mx[cb], ls[cb]}; }
}
__device__ __forceinline__ void attn_units4(unsigned char* ws, LAS unsigned char* lds, LAS unsigned* cnt, unsigned& epoch, const int u0, const int ustride, const int nunits, const int tid4, const int wave, const int lane) {
    if (u0 >= nunits) return;
    v4u kv[8], vv[8];
    AttU cur = att_decode(u0 % 3072); att_load(ws, cur, tid4, kv, vv);
    for (int u = u0; u < nunits; u += ustride) {
        sync4(cnt, epoch, lane);
        att_store(lds, tid4, kv, vv);
        sync4(cnt, epoch, lane);
        const int un = u + ustride; AttU nxt = cur; const bool pf = un < nunits;
        if (pf) nxt = att_decode(un % 3072);
        attn_unit4_compute(ws, lds, cur, wave, lane, pf, nxt, tid4, kv, vv);
        cur = nxt;
    }
}
__device__ __forceinline__ void attn_combine(unsigned char* ws, const int t, const int lane) {
    const bf16* OP = (const bf16*)(ws + WS_OP); const float* ML = (const float*)(ws + WS_ML); bf16* MIX = (bf16*)(ws + WS_MIX);
    const int h = lane >> 3, dg = lane & 7;
    f32x2 ml[3]; v4u ov[3];
#pragma unroll
    for (int G = 0; G < 3; ++G) { const size_t rowi = ((size_t)G * SEQ + t) * NH + h; ml[G] = *(const f32x2*)(ML + rowi * 2); ov[G] = *(const v4u*)(OP + rowi * 64 + 8 * dg); }
    const float M = fmaxf(ml[0].x, fmaxf(ml[1].x, ml[2].x));
    float w[3], ws_ = 0.f;
#pragma unroll
    for (int G = 0; G < 3; ++G) { w[G] = ml[G].y * __builtin_amdgcn_exp2f(ml[G].x - M); ws_ += w[G]; }
    const float inv = 1.0f / ws_;
    float acc[8];
#pragma unroll
    for (int i = 0; i < 8; ++i) acc[i] = 0.f;
#pragma unroll
    for (int G = 0; G < 3; ++G) { const float wg = w[G] * inv;
#pragma unroll
        for (int i = 0; i < 4; ++i) { const unsigned x = ov[G][i]; acc[2 * i] += wg * __builtin_bit_cast(float, x << 16); acc[2 * i + 1] += wg * __builtin_bit_cast(float, x & 0xffff0000u); } }
    v4u o; o.x = pk2(acc[0], acc[1]); o.y = pk2(acc[2], acc[3]); o.z = pk2(acc[4], acc[5]); o.w = pk2(acc[6], acc[7]);
    *(v4u*)(MIX + pg8::blk_off(t, h * 64 + 8 * dg, DM)) = o;
}
__device__ __forceinline__ void attn_sample_item(const Args& A, unsigned char* ws, const int item, const int lane) {
    const int s = item & 7, h = (item >> 3) & 7, b = item >> 6; const int part = lane & 3, ks = lane >> 2;
    const float* SQ = (const float*)(ws + WS_SQKV); bf16* MIX = (bf16*)(ws + WS_MIX);
    f32x4 qv[4];
#pragma unroll
    for (int i = 0; i < 4; ++i) qv[i] = *(const f32x4*)(SQ + (size_t)(b * 8 + s) * 1536 + h * 64 + 16 * i + 4 * part);
    float m = -1e30f, l = 0.f; f32x4 o[4];
#pragma unroll
    for (int i = 0; i < 4; ++i) o[i] = (f32x4){0.f, 0.f, 0.f, 0.f};
#define SMP_LOAD(RND, KV, VV) do { const int e_ = 16 * (RND) + ks; const int ec_ = e_ < 387 ? e_ : 0; const int G_ = ec_ / 129, j_ = ec_ - 129 * G_; const int idx_ = WBUF + s - (j_ << (2 * G_)); \
        const bool inb_ = idx_ < WBUF; \
        const size_t coff_ = (((size_t)b * WBUF + (inb_ ? idx_ : 0)) * NH + h) * HD + 4 * part, noff_ = (size_t)(b * 8 + (inb_ ? 0 : idx_ - WBUF)) * 1536 + h * 64 + 4 * part; \
        const float* kp_ = inb_ ? A.in[I_CK] + coff_ : SQ + noff_ + 512; const float* vp_ = inb_ ? A.in[I_CV] + coff_ : SQ + noff_ + 1024; \
        if ((RND) >= 17) { _Pragma("unroll") for (int i = 0; i < 4; ++i) { KV[i] = __builtin_nontemporal_load((const f32x4*)(kp_ + 16 * i)); VV[i] = __builtin_nontemporal_load((const f32x4*)(vp_ + 16 * i)); } }     \
        else { _Pragma("unroll") for (int i = 0; i < 4; ++i) { KV[i] = *(const f32x4*)(kp_ + 16 * i); VV[i] = *(const f32x4*)(vp_ + 16 * i); } } } while (0)
    f32x4 kc[4], vc[4], kn[4], vn[4];
    SMP_LOAD(0, kc, vc);
#pragma unroll 1
    for (int rnd = 0; rnd < 25; ++rnd) {
        const int rn = rnd + 1 < 25 ? rnd + 1 : 24;
        SMP_LOAD(rn, kn, vn);
        const bool valid = 16 * rnd + ks < 387;
        float d = 0.f;
#pragma unroll
        for (int i = 0; i < 4; ++i) d += (qv[i].x * kc[i].x + qv[i].y * kc[i].y) + (qv[i].z * kc[i].z + qv[i].w * kc[i].w);
        d += __shfl_xor(d, 1); d += __shfl_xor(d, 2);
        d = valid ? d : -1e30f;
        const float mn = fmaxf(m, d), alpha = __builtin_amdgcn_exp2f(m - mn), p = __builtin_amdgcn_exp2f(d - mn);
        l = l * alpha + p; m = mn;
#pragma unroll
        for (int i = 0; i < 4; ++i) { o[i] = o[i] * alpha + p * vc[i]; kc[i] = kn[i]; vc[i] = vn[i]; }
    }
#undef SMP_LOAD
    float M = m;
#pragma unroll
    for (int off = 4; off < 64; off <<= 1) M = fmaxf(M, __shfl_xor(M, off));
    const float scl = __builtin_amdgcn_exp2f(m - M); l *= scl;
#pragma unroll
    for (int off = 4; off < 64; off <<= 1) l += __shfl_xor(l, off);
    const float inv = 1.0f / l;
#pragma unroll
    for (int i = 0; i < 4; ++i) { f32x4 v = o[i] * scl;
#pragma unroll
        for (int off = 4; off < 64; off <<= 1)
#pragma unroll
            for (int e = 0; e < 4; ++e) v[e] += __shfl_xor(v[e], off);
        if (ks == 0) { v2u w; w.x = pk2(v[0] * inv, v[1] * inv); w.y = pk2(v[2] * inv, v[3] * inv);
            *(v2u*)(MIX + pg8::blk_off(MP + b * 8 + s, h * 64 + 16 * i + 4 * part, DM)) = w; } }
}


template <int SH> __device__ __forceinline__ float dpp_shr_t(float v) {
    return __builtin_bit_cast(float, __builtin_amdgcn_update_dpp(0, __builtin_bit_cast(int, v), 0x110 + SH, 0xf, 0xf, true));
}
template <int ROT> __device__ __forceinline__ float dpp_ror_t(float v) {
    return __builtin_bit_cast(float, __builtin_amdgcn_update_dpp(0, __builtin_bit_cast(int, v), 0x120 + ROT, 0xf, 0xf, false));
}
__device__ __forceinline__ void ssm_pass1_unit(unsigned char* ws, const int grp, const int chunk, const int lane) {
    const int t = lane & 15, g = lane >> 4; const int m0 = chunk * CHUNK;
    const bf16* U = (const bf16*)(ws + WS_U); const unsigned char* T = ws + WS_SSMT;
    const bf16* ABAR = (const bf16*)(T + ST_ABAR); const float* CP = (const float*)(T + ST_CP);
    bf16x8 ub[8];
#pragma unroll
    for (int blk = 0; blk < 8; ++blk) { bf16x8 z = {0, 0, 0, 0, 0, 0, 0, 0}; if (g < 2) z = ld8(U + (size_t)(m0 + 16 * blk + t) * DSSM + 16 * grp + 8 * g); ub[blk] = z; }
#pragma unroll 1
    for (int pr = 0; pr < 4; ++pr) {
        const bf16x8 are = ld8(ABAR + ((size_t)(grp * 8 + 2 * pr) * 64 + lane) * 8), aim = ld8(ABAR + ((size_t)(grp * 8 + 2 * pr + 1) * 64 + lane) * 8);
        const int p0 = 16 * pr + 4 * g;
        float wr_[4], wi_[4], l16r[4], l16i[4], sr[4], si[4];
#pragma unroll
        for (int i = 0; i < 4; ++i) { const float* cp = CP + (size_t)(grp * 64 + p0 + i) * 32;
            const f32x2 w = *(const f32x2*)(cp + 2 * (t == 15 ? 0 : 14 - t)); wr_[i] = (t == 15) ? 1.0f : w.x; wi_[i] = (t == 15) ? 0.0f : w.y;
            const f32x2 l = *(const f32x2*)(cp + 30); l16r[i] = l.x; l16i[i] = l.y; sr[i] = 0.f; si[i] = 0.f; }
#pragma unroll
        for (int blk = 0; blk < 8; ++blk) {
            const f32x4 z4 = {0.f, 0.f, 0.f, 0.f};
            const f32x4 hre = MFMA16(are, ub[blk], z4), him = MFMA16(aim, ub[blk], z4);
#pragma unroll
            for (int i = 0; i < 4; ++i) {
                float pr_ = wr_[i] * hre[i] - wi_[i] * him[i], pi_ = wr_[i] * him[i] + wi_[i] * hre[i];
                pr_ += dpp_ror_t<8>(pr_); pi_ += dpp_ror_t<8>(pi_); pr_ += dpp_ror_t<4>(pr_); pi_ += dpp_ror_t<4>(pi_);
                pr_ += dpp_ror_t<2>(pr_); pi_ += dpp_ror_t<2>(pi_); pr_ += dpp_ror_t<1>(pr_); pi_ += dpp_ror_t<1>(pi_);
                const float nr = l16r[i] * sr[i] - l16i[i] * si[i] + pr_, ni = l16r[i] * si[i] + l16i[i] * sr[i] + pi_; sr[i] = nr; si[i] = ni;
            }
        }
        if (t == 0) { float* CS = (float*)(ws + WS_CS) + ((size_t)(chunk * NG + grp) * NP + p0) * 2;
            *(f32x4*)CS = (f32x4){sr[0], si[0], sr[1], si[1]}; *(f32x4*)(CS + 4) = (f32x4){sr[2], si[2], sr[3], si[3]}; }
    }
}
template <bool PASS2, bool SAMPLE, int NBLK>
__device__ __forceinline__ void ssm_unit(const Args& A, unsigned char* ws, const int grp, const int chunk, const LAS float* carr, const int lane) {
    const int t = lane & 15, g = lane >> 4, tt = SAMPLE ? (t & 7) : t;
    const int m0 = SAMPLE ? MP + chunk * (16 * NBLK) : chunk * (16 * NBLK);
    const bf16* U = (const bf16*)(ws + WS_U); bf16* GB = (bf16*)(ws + WS_GB);
    const unsigned char* T = ws + WS_SSMT;
    const bf16* ABAR = (const bf16*)(T + ST_ABAR); const bf16* CMt = (const bf16*)(T + ST_CM);
    const float* PW = (const float*)(T + ST_PW); const float* CP = (const float*)(T + ST_CP);
    bf16x8 ub[NBLK];
#pragma unroll
    for (int blk = 0; blk < NBLK; ++blk) { bf16x8 z = {0, 0, 0, 0, 0, 0, 0, 0}; if (g < 2) z = ld8(U + (size_t)(m0 + 16 * blk + t) * DSSM + 16 * grp + 8 * g); ub[blk] = z; }
    f32x4 yacc[NBLK];
#pragma unroll
    for (int blk = 0; blk < NBLK; ++blk) yacc[blk] = (f32x4){0.f, 0.f, 0.f, 0.f};
#pragma unroll 1
    for (int pr = 0; pr < 4; ++pr) {
        const bf16x8 are = ld8(ABAR + ((size_t)(grp * 8 + 2 * pr) * 64 + lane) * 8), aim = ld8(ABAR + ((size_t)(grp * 8 + 2 * pr + 1) * 64 + lane) * 8);
        bf16x8 cm = {0, 0, 0, 0, 0, 0, 0, 0}; if (PASS2) cm = ld8(CMt + ((size_t)(grp * 4 + pr) * 64 + lane) * 8);
        const int p0 = 16 * pr + 4 * g;
        float pwr[4][4], pwi[4][4], cpr[4], cpi[4];
#pragma unroll
        for (int i = 0; i < 4; ++i) { const f32x4 a = *(const f32x4*)(PW + (size_t)(grp * 64 + p0 + i) * 8), b = *(const f32x4*)(PW + (size_t)(grp * 64 + p0 + i) * 8 + 4);
            pwr[i][0] = a.x; pwi[i][0] = a.y; pwr[i][1] = a.z; pwi[i][1] = a.w; pwr[i][2] = b.x; pwi[i][2] = b.y; pwr[i][3] = b.z; pwi[i][3] = b.w;
            const f32x2 c = *(const f32x2*)(CP + (size_t)(grp * 64 + p0 + i) * 32 + 2 * tt); cpr[i] = c.x; cpi[i] = c.y; }
        float cre[4], cim[4];
#pragma unroll
        for (int i = 0; i < 4; ++i) { cre[i] = 0.f; cim[i] = 0.f; }
        if (!SAMPLE && PASS2) {
#pragma unroll
            for (int i = 0; i < 4; ++i) { const f32x2 c = *(const LAS f32x2*)(carr + (size_t)(chunk * 64 + p0 + i) * 2); cre[i] = c.x; cim[i] = c.y; }
        }
#pragma unroll
        for (int blk = 0; blk < NBLK; ++blk) {
            int bsm = 0;
            if (SAMPLE) { bsm = ((m0 - MP + 16 * blk) >> 3) + (t >> 3);
                const f32x4 hr = *(const f32x4*)(A.in[I_SRE] + (size_t)(bsm * NG + grp) * NP + p0), hi = *(const f32x4*)(A.in[I_SIM] + (size_t)(bsm * NG + grp) * NP + p0);
#pragma unroll
                for (int i = 0; i < 4; ++i) { cre[i] = hr[i]; cim[i] = hi[i]; } }
            const f32x4 z4 = {0.f, 0.f, 0.f, 0.f};
            f32x4 hre = MFMA16(are, ub[blk], z4), him = MFMA16(aim, ub[blk], z4);
#define SSM_STEP(K_, SH_) { const bool keep = !SAMPLE || (tt >= SH_); \
                _Pragma("unroll") for (int i = 0; i < 4; ++i) { float sr = dpp_shr_t<SH_>(hre[i]), si = dpp_shr_t<SH_>(him[i]); if (!keep) { sr = 0.f; si = 0.f; } \
                    const float nr = hre[i] + pwr[i][K_] * sr - pwi[i][K_] * si, ni = him[i] + pwr[i][K_] * si + pwi[i][K_] * sr; hre[i] = nr; him[i] = ni; } }
            SSM_STEP(0, 1) SSM_STEP(1, 2) SSM_STEP(2, 4)
            if (!SAMPLE) SSM_STEP(3, 8)
#undef SSM_STEP
#pragma unroll
            for (int i = 0; i < 4; ++i) { const float nr = hre[i] + cpr[i] * cre[i] - cpi[i] * cim[i], ni = him[i] + cpr[i] * cim[i] + cpi[i] * cre[i]; hre[i] = nr; him[i] = ni; }
            if (!SAMPLE) {
#pragma unroll
                for (int i = 0; i < 4; ++i) { cre[i] = __shfl(hre[i], (lane & 48) | 15); cim[i] = __shfl(him[i], (lane & 48) | 15); }
            } else if (tt == 7) {
                *(f32x4*)(A.out + O_HRS + (size_t)(bsm * NG + grp) * NP + p0) = hre; *(f32x4*)(A.out + O_HIS + (size_t)(bsm * NG + grp) * NP + p0) = him;
            }
            if (PASS2) { v4u hw; hw.x = pk2(hre[0], hre[1]); hw.y = pk2(hre[2], hre[3]); hw.z = pk2(him[0], him[1]); hw.w = pk2(him[2], him[3]);
                yacc[blk] = MFMA16(cm, __builtin_bit_cast(bf16x8, hw), yacc[blk]); }
        }
        if (!PASS2 && !SAMPLE && t == 15) {
            float* CS = (float*)(ws + WS_CS) + ((size_t)(chunk * NG + grp) * NP + p0) * 2;
            *(f32x4*)CS = (f32x4){cre[0], cim[0], cre[1], cim[1]}; *(f32x4*)(CS + 4) = (f32x4){cre[2], cim[2], cre[3], cim[3]};
        }
    }
    if (PASS2) {
        const f32x4 dv = *(const f32x4*)(A.in[I_SD] + 16 * grp + 4 * g);
#pragma unroll
        for (int blk = 0; blk < NBLK; ++blk) { const size_t off = (size_t)(m0 + 16 * blk + t) * DSSM + 16 * grp + 4 * g;
            const v2u uw = *(const v2u*)(U + off);
            const float u0 = __builtin_bit_cast(float, uw.x << 16), u1 = __builtin_bit_cast(float, uw.x & 0xffff0000u), u2 = __builtin_bit_cast(float, uw.y << 16), u3 = __builtin_bit_cast(float, uw.y & 0xffff0000u);
            const float y0 = gelu_tanh(yacc[blk][0] + dv[0] * u0), y1 = gelu_tanh(yacc[blk][1] + dv[1] * u1), y2 = gelu_tanh(yacc[blk][2] + dv[2] * u2), y3 = gelu_tanh(yacc[blk][3] + dv[3] * u3);
            v2u w; w.x = pk2(y0, y1); w.y = pk2(y2, y3); *(v2u*)(GB + pg8::blk_off(m0 + 16 * blk + t, 16 * grp + 4 * g, DSSM)) = w; }
    }
}

constexpr int N_PHASES = 15;
__global__ void __launch_bounds__(NWAVES * 64, 2) hymba_fwd(Args args) {
    extern __shared__ __attribute__((aligned(16))) unsigned char lds[];
    Frame F;
    F.lds = (LAS unsigned char*)lds;
    F.MISC = (volatile LAS unsigned*)(F.lds + MISC_OFF);
    F.tid = threadIdx.x; F.lane = F.tid & 63; F.wave = __builtin_amdgcn_readfirstlane(F.tid >> 6);
    F.G = gridDim.x; { const int bx = blockIdx.x; F.vcu = (F.G % 8 == 0) ? (bx % 8) * (F.G / 8) + bx / 8 : bx; }
    unsigned char* ws = args.ws;
    F.ctl = (gu32*)(ws + WS_CTL);
    for (int u = F.tid; u < (LDS_BYTES - LDSCTL_OFF) / 4; u += NWAVES * 64) ((LAS unsigned*)(F.lds + LDSCTL_OFF))[u] = 0u;
    __syncthreads();
    XcdBarrier bar = xcd_barrier_post((unsigned*)(F.ctl + CW_BAR), F.MISC + 8);
    const int lo = args.ph_lo, hi = args.ph_hi;
#ifndef PHASE_MASK
#define PHASE_MASK 0x7fff
#endif
#define IN(k) (((PHASE_MASK >> (k)) & 1) && lo <= (k) && (k) < hi)
#define SEAM(k) do { if (IN(k) && IN((k) + 1)) xcd_barrier(bar); } while (0)
#ifndef REPEAT_MASK
#define REPEAT_MASK 0
#endif
#define REP(k) for (int rep_ = 0; rep_ <= ((REPEAT_MASK >> (k)) & 1); ++rep_, ((rep_ <= ((REPEAT_MASK >> (k)) & 1)) ? xcd_barrier(bar) : (void)0))
    bf16* XN = (bf16*)(ws + WS_XN); bf16* HB = (bf16*)(ws + WS_H); float* X1 = (float*)(ws + WS_X1); float* X2 = (float*)(ws + WS_X2);
    float* ADA = (float*)(ws + WS_ADA); float* SLAB = (float*)(ws + WS_SLAB);
    const int gw = F.vcu * NWAVES + F.wave, NGW = F.G * NWAVES;
    const bool fastcopy = (F.G == 256);
    pg8::CopyJob CJ; { const int seg = (int)blockIdx.x & 255, kv = seg >> 7, b = seg & 127; const size_t eo = ((size_t)b * (WBUF * DATT)) * 4 + (size_t)F.wave * 1024;
        CJ.src = (const char*)args.in[kv ? I_CV : I_CK] + (size_t)DSEQ * DATT * 4 + eo; CJ.dst = (char*)(args.out + (kv ? O_VS : O_KS)) + eo; CJ.cur = 0; CJ.end = (fastcopy && !args.nocopy) ? 510 : 0; CJ.dummy = (unsigned*)(F.ctl + 2048 + 64 * F.wave); }

    if (IN(0)) REP(0) if ((F.lane = (int)__builtin_amdgcn_mbcnt_hi(~0u, __builtin_amdgcn_mbcnt_lo(~0u, 0u)), F.tid = F.wave * 64 + F.lane, true)) { p0_prologue(F, args); }
    SEAM(0);
    if (IN(1)) REP(1) if ((F.lane = (int)__builtin_amdgcn_mbcnt_hi(~0u, __builtin_amdgcn_mbcnt_lo(~0u, 0u)), F.tid = F.wave * 64 + F.lane, true)) {
        pg8::Gemm g{(const bf16*)(ws + WS_SC), (const bf16*)(ws + WS_WADA), 256, NADA, DM}; pg8::Order2 S; S.init(256, NADA, DM, F.G, (int)blockIdx.x);
        pg8::EpiF32 E{ADA, NADA, args.in[I_BADA]};
        pg8::gemm_phase2<pg8::EpiF32, pg8::Order2, true, false>(F.lds + RING_OFF, g, S, E, CJ, F.wave);
        const int nun = NADA / 256;
        const int nworker = (F.G > nun) ? (F.G - nun) : F.G, widx = (F.G > nun) ? ((int)blockIdx.x - nun) : (int)blockIdx.x;
        if (widx >= 0) p1_weights(F, args, widx * NWAVES + F.wave, nworker * NWAVES);
        if (!fastcopy && widx >= 0) copy_tiles(args, widx * NWAVES + F.wave, nworker * NWAVES, F.lane);
    }
    SEAM(1);
    if (IN(2)) REP(2) if ((F.lane = (int)__builtin_amdgcn_mbcnt_hi(~0u, __builtin_amdgcn_mbcnt_lo(~0u, 0u)), F.tid = F.wave * 64 + F.lane, true)) norm_mod_rows<true, 0, 8, false>(F, args.in[I_XP], args.in[I_XS], args.in[I_GF1], ADA, 0 * DM, 1 * DM, XN, Combine{nullptr, 0, nullptr, 0, 0.f, nullptr}, ws + WS_XN8, (float*)(ws + WS_SA));
    SEAM(2);
    if (IN(3)) REP(3) if ((F.lane = (int)__builtin_amdgcn_mbcnt_hi(~0u, __builtin_amdgcn_mbcnt_lo(~0u, 0u)), F.tid = F.wave * 64 + F.lane, true)) {
        pg8::Gemm g{(const bf16*)(ws + WS_XN8), (const bf16*)(ws + WS_W1T8), MTOT, 2 * DFF, DM / 2}; pg8::Order2 S; S.init(MTOT, 2 * DFF, DM / 2, F.G, (int)blockIdx.x);
        pg8::EpiGated8 E{HB, DFF, (const float*)(ws + WS_SA), (const unsigned*)(ws + WS_CTL) + CW_AMAX};
        pg8::gemm_phase2<pg8::EpiGated8, pg8::Order2, true, true, true>(F.lds + RING_OFF, g, S, E, CJ, F.wave);
        { const int mine_ = (S.so.nwg - S.so.c + S.so.G - 1) / S.so.G, mx_ = (S.so.nwg + S.so.G - 1) / S.so.G;
          if (mine_ < mx_) copy_back(CJ, (mx_ - mine_) * 2 * S.nt, F.lane); }
    }
    SEAM(3);
    if (IN(4)) REP(4) if ((F.lane = (int)__builtin_amdgcn_mbcnt_hi(~0u, __builtin_amdgcn_mbcnt_lo(~0u, 0u)), F.tid = F.wave * 64 + F.lane, true)) {
        pg8::Gemm g{HB, (const bf16*)(ws + WS_W1D), MTOT, DM, DFF}; pg8::SplitOrder S; S.init(MP, DM, DFF, 11, F.G, (int)blockIdx.x);
        pg8::EpiResid<false, true> E{args.in[I_XP], args.in[I_XS], X1, ADA, 2 * DM, 0.5f, SLAB};
        pg8::gemm_phase2<pg8::EpiResid<false, true>, pg8::SplitOrder, true, true>(F.lds + RING_OFF, g, S, E, CJ, F.wave);
        if (S.so.G == S.npre && S.npre + S.so.c >= S.ntot) copy_back(CJ, 2 * (S.nt / S.nsplit), F.lane);
    }
    SEAM(4);
    if (IN(5)) REP(5) if ((F.lane = (int)__builtin_amdgcn_mbcnt_hi(~0u, __builtin_amdgcn_mbcnt_lo(~0u, 0u)), F.tid = F.wave * 64 + F.lane, true)) norm_mod_rows<false, 11, 4, true>(F, X1, X1 + (size_t)MP * DM, args.in[I_GMIX], ADA, 3 * DM, 4 * DM, XN, Combine{SLAB, 11, args.in[I_XS], 2 * DM, 0.5f, X1 + (size_t)MP * DM}, nullptr, nullptr);
    SEAM(5);
    if (IN(6)) REP(6) if ((F.lane = (int)__builtin_amdgcn_mbcnt_hi(~0u, __builtin_amdgcn_mbcnt_lo(~0u, 0u)), F.tid = F.wave * 64 + F.lane, true)) {
        pg8::Gemm g{XN, (const bf16*)(ws + WS_WIN), MTOT, 2048, DM}; pg8::Order2 S; S.init(MTOT, 2048, DM, F.G, (int)blockIdx.x);
        pg8::EpiInProj E{(bf16*)(ws + WS_Q), (bf16*)(ws + WS_K), (bf16*)(ws + WS_VT), (bf16*)(ws + WS_U), (float*)(ws + WS_SQKV), args.out, (const _Float16*)(ws + WS_ROPE), args.in[I_GQ], args.in[I_GK]};
        pg8::gemm_phase2<pg8::EpiInProj, pg8::Order2, true, false>(F.lds + RING_OFF, g, S, E, CJ, F.wave);
    }
    SEAM(6);
    if (IN(7)) REP(7) if ((F.lane = (int)__builtin_amdgcn_mbcnt_hi(~0u, __builtin_amdgcn_mbcnt_lo(~0u, 0u)), F.tid = F.wave * 64 + F.lane, true)) {
#ifndef P7R1
#define P7R1 0
#endif
#ifndef P7R2
#define P7R2 0
#endif
#ifndef P7R3
#define P7R3 0
#endif
#ifndef P7_PARTS
#define P7_PARTS 7
#endif
        const int p7m = args.pad ? args.pad : P7_PARTS;
        { const int hw = F.vcu * 4 + (F.wave & 3), NHW = F.G * 4;
          if (F.wave < 4) {
              unsigned epoch = 0u; LAS unsigned* cnt = (LAS unsigned*)(F.MISC + 16);
              if (p7m & 1) attn_units4(ws, F.lds + RING_OFF, cnt, epoch, F.vcu, F.G, 3072 * (1 + P7R1), F.tid, F.wave, F.lane);
              if (p7m & 2) for (int u = hw; u < NCHUNK_P * NG * (1 + P7R2); u += NHW) ssm_pass1_unit(ws, u & 31, (u >> 5) & 127, F.lane);
          } else { __builtin_amdgcn_s_setprio(3);
              if (p7m & 4) for (int a = hw; a < NBAT * NH * DSEQ * (1 + P7R3); a += NHW) attn_sample_item(args, ws, a & 8191, F.lane);
              __builtin_amdgcn_s_setprio(0); } }
    }
    SEAM(7);
    if (IN(8)) REP(8) if ((F.lane = (int)__builtin_amdgcn_mbcnt_hi(~0u, __builtin_amdgcn_mbcnt_lo(~0u, 0u)), F.tid = F.wave * 64 + F.lane, true)) {
        for (int t = gw; t < SEQ; t += NGW) attn_combine(ws, t, F.lane);
        LAS float* carr = (LAS float*)(F.lds + RING_OFF);
        LAS float* segE = carr + NCHUNK_P * 64 * 2;
        for (int item = F.vcu; item < 256; item += F.G) {
            const int grp = item & 31, sub = item >> 5;
            {
                const float* CS = (const float*)(ws + WS_CS); const float* CL = (const float*)(ws + WS_SSMT + ST_CL);
                const f32x2 lam = *(const f32x2*)(CL + (size_t)(grp * 64 + F.lane) * 2);
                f32x2 sv[16];
#pragma unroll
                for (int j = 0; j < 16; ++j) sv[j] = *(const f32x2*)(CS + ((size_t)((16 * F.wave + j) * NG + grp) * NP + F.lane) * 2);
                float lr[16], li[16]; float cr = 0.f, ci = 0.f;
#pragma unroll
                for (int j = 0; j < 16; ++j) { lr[j] = cr; li[j] = ci; const float nr = lam.x * cr - lam.y * ci + sv[j].x, ni = lam.x * ci + lam.y * cr + sv[j].y; cr = nr; ci = ni; }
                *(LAS f32x2*)(segE + (size_t)(F.wave * 64 + F.lane) * 2) = (f32x2){cr, ci};
                float sr = lam.x, si = lam.y;
#pragma unroll
                for (int q = 0; q < 4; ++q) { const float nr = sr * sr - si * si, ni = 2.f * sr * si; sr = nr; si = ni; }
                LDS_WAIT(); __syncthreads();
                float Cr = 0.f, Ci = 0.f;
                float Tr = 0.f, Ti = 0.f;
#pragma unroll
                for (int w = 0; w < 8; ++w) { const f32x2 e = *(const LAS f32x2*)(segE + (size_t)(w * 64 + F.lane) * 2);
                    if (w == F.wave) { Cr = Tr; Ci = Ti; }
                    const float nr = sr * Tr - si * Ti + e.x, ni = sr * Ti + si * Tr + e.y; Tr = nr; Ti = ni; }
                float pr_ = 1.f, pi_ = 0.f;
#pragma unroll
                for (int j = 0; j < 16; ++j) { const float ar_ = lr[j] + pr_ * Cr - pi_ * Ci, ai_ = li[j] + pr_ * Ci + pi_ * Cr;
                    *(LAS f32x2*)(carr + (size_t)((16 * F.wave + j) * 64 + F.lane) * 2) = (f32x2){ar_, ai_};
                    const float nr = pr_ * lam.x - pi_ * lam.y, ni = pr_ * lam.y + pi_ * lam.x; pr_ = nr; pi_ = ni; }
                if (sub == 0 && F.wave == 0) { args.out[O_HRP + grp * 64 + F.lane] = Tr; args.out[O_HIP + grp * 64 + F.lane] = Ti; }
                LDS_WAIT(); __syncthreads();
            }
            for (int k = F.wave; k < 16; k += NWAVES) { ssm_unit<true, false, 8>(args, ws, grp, sub + 8 * k, carr, F.lane); copy_back(CJ, 32, F.lane); }
            ssm_unit<true, true, 1>(args, ws, grp, sub + 8 * F.wave, nullptr, F.lane);
            copy_back(CJ, 32, F.lane);
            __syncthreads();
        }
    }
    SEAM(8);
    if (IN(9)) REP(9) if ((F.lane = (int)__builtin_amdgcn_mbcnt_hi(~0u, __builtin_amdgcn_mbcnt_lo(~0u, 0u)), F.tid = F.wave * 64 + F.lane, true)) {
        pg8::Gemm g{(const bf16*)(ws + WS_GB), (const bf16*)(ws + WS_WGLU), MTOT, 1024, DSSM}; pg8::Order2 S; S.init(MTOT, 1024, DSSM, F.G, (int)blockIdx.x);
        pg8::EpiGated<1> E{(bf16*)(ws + WS_MIX), DM, DATT};
        pg8::gemm_phase2<pg8::EpiGated<1>, pg8::Order2, true, true>(F.lds + RING_OFF, g, S, E, CJ, F.wave);
        { const int mine_ = (S.so.nwg - S.so.c + S.so.G - 1) / S.so.G, mx_ = (S.so.nwg + S.so.G - 1) / S.so.G;
          if (mine_ < mx_) copy_back(CJ, (mx_ - mine_) * 2 * S.nt, F.lane); }
    }
    SEAM(9);
    if (IN(10)) REP(10) if ((F.lane = (int)__builtin_amdgcn_mbcnt_hi(~0u, __builtin_amdgcn_mbcnt_lo(~0u, 0u)), F.tid = F.wave * 64 + F.lane, true)) {
        pg8::Gemm g{(const bf16*)(ws + WS_MIX), (const bf16*)(ws + WS_WOUT), MTOT, DM, DM}; pg8::SplitOrder S; S.init(MP, DM, DM, 4, F.G, (int)blockIdx.x);
        pg8::EpiResid<true, true> E{X1, X1 + (size_t)MP * DM, X2, ADA, 5 * DM, 1.0f, SLAB};
        pg8::gemm_phase2<pg8::EpiResid<true, true>, pg8::SplitOrder, true, false>(F.lds + RING_OFF, g, S, E, CJ, F.wave);
    }
    SEAM(10);
    if (IN(11)) REP(11) if ((F.lane = (int)__builtin_amdgcn_mbcnt_hi(~0u, __builtin_amdgcn_mbcnt_lo(~0u, 0u)), F.tid = F.wave * 64 + F.lane, true)) norm_mod_rows<true, 4, 5, true>(F, X2, X2 + (size_t)MP * DM, args.in[I_GF2], ADA, 6 * DM, 7 * DM, XN, Combine{SLAB, 4, X1 + (size_t)MP * DM, 5 * DM, 1.0f, X2 + (size_t)MP * DM}, ws + WS_XN8, (float*)(ws + WS_SA));
    SEAM(11);
    if (IN(12)) REP(12) if ((F.lane = (int)__builtin_amdgcn_mbcnt_hi(~0u, __builtin_amdgcn_mbcnt_lo(~0u, 0u)), F.tid = F.wave * 64 + F.lane, true)) {
        pg8::Gemm g{(const bf16*)(ws + WS_XN8), (const bf16*)(ws + WS_W2T8), MTOT, 2 * DFF, DM / 2}; pg8::Order2 S; S.init(MTOT, 2 * DFF, DM / 2, F.G, (int)blockIdx.x);
        pg8::EpiGated8 E{HB, DFF, (const float*)(ws + WS_SA), (const unsigned*)(ws + WS_CTL) + CW_AMAX + 2};
        pg8::gemm_phase2<pg8::EpiGated8, pg8::Order2, true, true, true>(F.lds + RING_OFF, g, S, E, CJ, F.wave);
        { const int mine_ = (S.so.nwg - S.so.c + S.so.G - 1) / S.so.G, mx_ = (S.so.nwg + S.so.G - 1) / S.so.G;
          if (mine_ < mx_) copy_back(CJ, (mx_ - mine_) * 2 * S.nt, F.lane); }
    }
    SEAM(12);
    if (IN(13)) REP(13) if ((F.lane = (int)__builtin_amdgcn_mbcnt_hi(~0u, __builtin_amdgcn_mbcnt_lo(~0u, 0u)), F.tid = F.wave * 64 + F.lane, true)) {
        pg8::Gemm g{HB, (const bf16*)(ws + WS_W2D), MTOT, DM, DFF}; pg8::SplitOrder S; S.init(MP, DM, DFF, 11, F.G, (int)blockIdx.x);
        pg8::EpiResid<true, false> E{X2, X2 + (size_t)MP * DM, args.out, ADA, 8 * DM, 0.5f, SLAB};
        pg8::gemm_phase2<pg8::EpiResid<true, false>, pg8::SplitOrder, true, true>(F.lds + RING_OFF, g, S, E, CJ, F.wave);
        copy_back(CJ, 1 << 20, F.lane);
    }
    SEAM(13);
    if (IN(14)) { F.lane = (int)__builtin_amdgcn_mbcnt_hi(~0u, __builtin_amdgcn_mbcnt_lo(~0u, 0u)); F.tid = F.wave * 64 + F.lane;
        const Combine C{SLAB, 11, X2 + (size_t)MP * DM, 8 * DM, 0.5f, args.out + O_YS};
        for (int u = gw; u < 2 * MS; u += NGW) { const int ms = u >> 1, j0 = (u & 1) * 2; const float* ar = ADA + (size_t)ada_row(MP + ms) * NADA;
            (void)combine_chunk<11>(C, ar, ms, F.lane, j0); (void)combine_chunk<11>(C, ar, ms, F.lane, j0 + 1); }
    }
#undef IN
#undef SEAM
}

#ifndef MK_N_LAUNCHES
#define MK_N_LAUNCHES 1
#endif
extern "C" void kernel_launch(void* const* d_in, const int* in_sizes, int n_in, void* d_out, int out_size, void* d_ws, size_t ws_size, hipStream_t stream) {
    static int grid = 0;
    if (grid == 0) {
        if (n_in != 32 || (size_t)out_size != O_END || ws_size < WS_END) { fprintf(stderr, "kernel_launch: unexpected shapes (n_in %d out %d ws %zu)\n", n_in, out_size, ws_size); grid = -1; return; }
        int dev = 0, cus = 0, per_cu = 0;
        if (hipGetDevice(&dev) != hipSuccess || hipDeviceGetAttribute(&cus, hipDeviceAttributeMultiprocessorCount, dev) != hipSuccess) { grid = -1; return; }
        if (hipFuncSetAttribute((const void*)hymba_fwd, hipFuncAttributeMaxDynamicSharedMemorySize, LDS_BYTES) != hipSuccess) { fprintf(stderr, "kernel_launch: hipFuncSetAttribute failed\n"); grid = -1; return; }
        if (hipOccupancyMaxActiveBlocksPerMultiprocessor(&per_cu, (const void*)hymba_fwd, NWAVES * 64, LDS_BYTES) != hipSuccess || per_cu < 1)
            fprintf(stderr, "kernel_launch: note: occupancy query reports %d workgroups per CU\n", per_cu);
        (void)hipGetLastError();
        grid = cus;
    }
    if (grid < 0) return;
    if (hipMemsetAsync((char*)d_ws + WS_CTL, 0, CTL_ZERO_BYTES, stream) != hipSuccess) return;
    Args a{};
    for (int i = 0; i < 32; ++i) a.in[i] = (const float*)d_in[i];
    a.out = (float*)d_out; a.ws = (unsigned char*)d_ws;
#if MK_N_LAUNCHES == 1
    a.ph_lo = 0; a.ph_hi = N_PHASES;
    hipLaunchKernelGGL(hymba_fwd, dim3(grid), dim3(NWAVES * 64), LDS_BYTES, stream, a);
#ifdef PROBE_LIST
    { const int pl[] = PROBE_LIST; for (int p : pl) { a.ph_lo = p % 100; a.ph_hi = p % 100 + 1; a.nocopy = (p % 1000) >= 100; a.pad = p / 1000; hipLaunchKernelGGL(hymba_fwd, dim3(grid), dim3(NWAVES * 64), LDS_BYTES, stream, a); } }
#endif
#else
    for (int p = 0; p < N_PHASES; ++p) { a.ph_lo = p; a.ph_hi = p + 1; hipLaunchKernelGGL(hymba_fwd, dim3(grid), dim3(NWAVES * 64), LDS_BYTES, stream, a); }
#endif
}
```
